# Optimizing an MI355X kernel written in HIP

```python
import math
import jax
import jax.numpy as jnp
from jax import lax
import numpy as np

D_MODEL = 1024
BATCH = 4
SEQ = 8192
DEPTH = 2

GRID_W = 64
CTX_LEN = 256

SSM_GROUP_CH = 16
SSM_GROUPS = 16
SSM_WIDTH = SSM_GROUPS * SSM_GROUP_CH
SSM_STATE = 64
DT_MIN = 0.001
DT_MAX = 0.1
FNET_GROUPS = 4
FNET_GROUP_CH = 64
FNET_WIDTH = FNET_GROUPS * FNET_GROUP_CH
NA_HEADS = 8
NA_HEAD_DIM = 64
NA_WIDTH = NA_HEADS * NA_HEAD_DIM
WIN_ROWS = 8
WIN_COLS = 16
ROPE_THETA = 10000.0
N_BRANCH = 3
D_FF = 2816
N_MOD = 9
LN_EPS = 1e-6
DN_ALPHA = (2 * DEPTH) ** 0.25
DN_BETA = (8 * DEPTH) ** -0.25

COL_SSM = 0
COL_K = COL_SSM + SSM_WIDTH
COL_V = COL_K + NA_WIDTH
COL_CTX_END = COL_V + NA_WIDTH
COL_FNET = COL_CTX_END
COL_Q = COL_FNET + FNET_WIDTH
COL_GATE = COL_Q + NA_WIDTH
W_IN = COL_GATE + N_BRANCH * D_MODEL

kernel_name = 'hybrid_s5_fnet_natten_macaron_deepnorm'


def _ln(x):
    xf = x.astype(jnp.float32)
    mu = jnp.mean(xf, axis=-1, keepdims=True)
    var = jnp.mean(jnp.square(xf - mu), axis=-1, keepdims=True)
    return ((xf - mu) * lax.rsqrt(var + LN_EPS)).astype(x.dtype)


def _post_norm(x, res, g, b):
    return _ln(DN_ALPHA * x + res) * g + b


def _modulate(x, shift, scale):
    return _ln(x) * (1.0 + scale) + shift


def _swiglu(u, w_gate, w_up, w_down):
    return (jax.nn.silu(u @ w_gate) * (u @ w_up)) @ w_down


def _heads(t):
    return t.reshape(t.shape[0], t.shape[1], NA_HEADS, NA_HEAD_DIM)


def _cmul(ar, ai, br, bi):
    return ar * br - ai * bi, ar * bi + ai * br


def _scan_combine(e1, e2):
    a1r, a1i, b1r, b1i = e1
    a2r, a2i, b2r, b2i = e2
    ar, ai = _cmul(a2r, a2i, a1r, a1i)
    br, bi = _cmul(a2r, a2i, b1r, b1i)
    return ar, ai, br + b2r, bi + b2i


def _zoh(log_dt, a_re, a_im, b_re, b_im):
    dt = jnp.exp(log_dt.astype(jnp.float32))[:, None]
    a_re = a_re.astype(jnp.float32)
    a_im = a_im.astype(jnp.float32)
    mag = jnp.exp(a_re * dt)
    ab_re = mag * jnp.cos(a_im * dt)
    ab_im = mag * jnp.sin(a_im * dt)
    den = a_re * a_re + a_im * a_im
    nr = ab_re - 1.0
    ni = ab_im
    fr = (nr * a_re + ni * a_im) / den
    fi = (ni * a_re - nr * a_im) / den
    b_re = b_re.astype(jnp.float32)
    b_im = b_im.astype(jnp.float32)
    bb_re = fr[..., None] * b_re - fi[..., None] * b_im
    bb_im = fr[..., None] * b_im + fi[..., None] * b_re
    return ab_re, ab_im, bb_re, bb_im


def _s5_scan(u, disc, h0, reverse):
    ab_re, ab_im, bb_re, bb_im = disc
    uf = u.astype(jnp.float32)
    bu_re = jnp.einsum('blgc,gpc->blgp', uf, bb_re)
    bu_im = jnp.einsum('blgc,gpc->blgp', uf, bb_im)
    if h0 is not None:
        ah_re, ah_im = _cmul(ab_re, ab_im, h0[0], h0[1])
        first = -1 if reverse else 0
        bu_re = bu_re.at[:, first].add(ah_re)
        bu_im = bu_im.at[:, first].add(ah_im)
    a_re = jnp.broadcast_to(ab_re, bu_re.shape)
    a_im = jnp.broadcast_to(ab_im, bu_re.shape)
    _, _, h_re, h_im = lax.associative_scan(_scan_combine, (a_re, a_im, bu_re, bu_im), reverse=reverse, axis=1)
    return h_re, h_im


def _s5_readout(u, h_fwd, h_bwd, c_re, c_im, d, w_glu, b_glu):
    B, L, _ = u.shape
    cr = c_re.astype(jnp.float32)
    ci = c_im.astype(jnp.float32)
    y = (jnp.einsum('blgp,gcp->blgc', h_fwd[0], cr[0]) - jnp.einsum('blgp,gcp->blgc', h_fwd[1], ci[0])
         + jnp.einsum('blgp,gcp->blgc', h_bwd[0], cr[1]) - jnp.einsum('blgp,gcp->blgc', h_bwd[1], ci[1]))
    y = y.reshape(B, L, SSM_WIDTH).astype(u.dtype) + d * u
    y = jax.nn.gelu(y)
    return y * jax.nn.sigmoid(y @ w_glu + b_glu)


def _fourier_mix(f):
    B, L, _ = f.shape
    fg = f.reshape(B, L, FNET_GROUPS, FNET_GROUP_CH).astype(jnp.float32)
    y = jnp.fft.fft2(fg, axes=(1, 3), norm='ortho').real
    return y.reshape(B, L, FNET_WIDTH).astype(f.dtype)


def _axial_rope(x):
    B, L, H, hd = x.shape
    nf = hd // 4
    t = jnp.arange(L, dtype=jnp.int32)
    pos = jnp.stack([t // GRID_W, t % GRID_W], axis=-1).astype(jnp.float32)
    inv_freq = ROPE_THETA ** (-jnp.arange(nf, dtype=jnp.float32) / nf)
    ang = pos[:, :, None] * inv_freq
    cos = jnp.cos(ang)[None, :, None].astype(x.dtype)
    sin = jnp.sin(ang)[None, :, None].astype(x.dtype)
    xr = x.reshape(B, L, H, 2, 2, nf)
    x1 = xr[..., 0, :]
    x2 = xr[..., 1, :]
    out = jnp.stack([x1 * cos - x2 * sin, x2 * cos + x1 * sin], axis=-2)
    return out.reshape(B, L, H, hd)


def _neighbourhood_attention(q, k, v, kc, vc, rpb):
    B, L, H, hd = q.shape
    rows = L // GRID_W
    wr = min(WIN_ROWS, rows)
    wc = WIN_COLS
    scale = hd ** -0.5
    qg = q.reshape(B, rows, GRID_W, H, hd)
    kg = k.reshape(B, rows, GRID_W, H, hd)
    vg = v.reshape(B, rows, GRID_W, H, hd)
    col = jnp.arange(GRID_W, dtype=jnp.int32)
    col_start = jnp.clip(col - wc // 2, 0, GRID_W - wc)
    col_idx = col_start[:, None] + jnp.arange(wc, dtype=jnp.int32)[None, :]
    dc_idx = col_idx - col[:, None] + (WIN_COLS - 1)

    def row_block(r):
        r0 = jnp.clip(r - wr // 2, 0, rows - wr)
        k_rows = lax.dynamic_slice_in_dim(kg, r0, wr, axis=1)
        v_rows = lax.dynamic_slice_in_dim(vg, r0, wr, axis=1)
        k_win = k_rows[:, :, col_idx].transpose(0, 2, 1, 3, 4, 5).reshape(B, GRID_W, wr * wc, H, hd)
        v_win = v_rows[:, :, col_idx].transpose(0, 2, 1, 3, 4, 5).reshape(B, GRID_W, wr * wc, H, hd)
        q_r = lax.dynamic_index_in_dim(qg, r, axis=1, keepdims=False)
        dr_idx = r0 + jnp.arange(wr, dtype=jnp.int32) - r + (WIN_ROWS - 1)
        bias = rpb[:, dr_idx[None, :, None], dc_idx[:, None, :]].reshape(H, GRID_W, wr * wc)
        s_loc = jnp.einsum('bqhd,bqkhd->bhqk', q_r, k_win).astype(jnp.float32) * scale + bias[None].astype(jnp.float32)
        s_ctx = jnp.einsum('bqhd,bkhd->bhqk', q_r, kc).astype(jnp.float32) * scale
        p = jax.nn.softmax(jnp.concatenate([s_loc, s_ctx], axis=-1), axis=-1).astype(v.dtype)
        n_loc = wr * wc
        out = (jnp.einsum('bhqk,bqkhd->bqhd', p[..., :n_loc], v_win)
               + jnp.einsum('bhqk,bkhd->bqhd', p[..., n_loc:], vc))
        return out

    out = lax.map(row_block, jnp.arange(rows, dtype=jnp.int32))
    return out.transpose(1, 0, 2, 3, 4).reshape(B, L, H * hd)


def _context_attention(qc, kc, vc):
    B, Lc, H, hd = qc.shape
    s = jnp.einsum('bqhd,bkhd->bhqk', qc, kc).astype(jnp.float32) * (hd ** -0.5)
    p = jax.nn.softmax(s, axis=-1).astype(vc.dtype)
    return jnp.einsum('bhqk,bkhd->bqhd', p, vc).reshape(B, Lc, H * hd)


def _merge(y_s, y_f, y_n, gates, w_br_ssm, w_br_fnet, w_br_na, w_out):
    B, L, _ = gates.shape
    g = jax.nn.sigmoid(gates).reshape(B, L, N_BRANCH, D_MODEL)
    y = (g[:, :, 0] * (y_s @ w_br_ssm) + g[:, :, 1] * (y_f @ w_br_fnet) + g[:, :, 2] * (y_n @ w_br_na))
    return y @ w_out


def _mixer(u, uc, w_in, log_dt, a_re, a_im, b_re, b_im, c_re, c_im, d, w_glu, b_glu, rpb,
           w_br_ssm, w_br_fnet, w_br_na, w_out, ctx_out):
    B, L, _ = u.shape
    Lc = uc.shape[1]
    z = u @ w_in
    zc = uc @ (w_in if ctx_out else w_in[:, :COL_CTX_END])
    disc_f = _zoh(log_dt[0], a_re[0], a_im[0], b_re[0], b_im[0])
    disc_b = _zoh(log_dt[1], a_re[1], a_im[1], b_re[1], b_im[1])
    us = z[..., COL_SSM:COL_K]
    usc = zc[..., COL_SSM:COL_K]
    usg = us.reshape(B, L, SSM_GROUPS, SSM_GROUP_CH)
    uscg = usc.reshape(B, Lc, SSM_GROUPS, SSM_GROUP_CH)
    hcf = _s5_scan(uscg, disc_f, None, False)
    hcb = _s5_scan(uscg, disc_b, None, True)
    hf = _s5_scan(usg, disc_f, (hcf[0][:, -1], hcf[1][:, -1]), False)
    hb = _s5_scan(usg, disc_b, (hcb[0][:, 0], hcb[1][:, 0]), True)
    y_s = _s5_readout(us, hf, hb, c_re, c_im, d, w_glu, b_glu)
    y_f = _fourier_mix(z[..., COL_FNET:COL_Q])
    q = _axial_rope(_heads(z[..., COL_Q:COL_GATE]))
    k = _axial_rope(_heads(z[..., COL_K:COL_V]))
    v = _heads(z[..., COL_V:COL_CTX_END])
    kc = _heads(zc[..., COL_K:COL_V])
    vc = _heads(zc[..., COL_V:COL_CTX_END])
    y_n = _neighbourhood_attention(q, k, v, kc, vc, rpb)
    y = _merge(y_s, y_f, y_n, z[..., COL_GATE:], w_br_ssm, w_br_fnet, w_br_na, w_out)
    if not ctx_out:
        return y, None
    y_s_c = _s5_readout(usc, hcf, hcb, c_re, c_im, d, w_glu, b_glu)
    y_f_c = _fourier_mix(zc[..., COL_FNET:COL_Q])
    y_n_c = _context_attention(_heads(zc[..., COL_Q:COL_GATE]), kc, vc)
    yc = _merge(y_s_c, y_f_c, y_n_c, zc[..., COL_GATE:], w_br_ssm, w_br_fnet, w_br_na, w_out)
    return y, yc


def setup_inputs(seed: int = 0) -> dict:
    key = jax.random.key(seed)
    ks = jax.random.split(key, 27)
    f32 = jnp.float32

    def nrm(k, shape, scale):
        return jax.random.normal(k, shape, f32) * scale

    G, P, C = SSM_GROUPS, SSM_STATE, SSM_GROUP_CH
    n = jnp.arange(P, dtype=f32)
    return {
        'x': nrm(ks[0], (BATCH, SEQ, D_MODEL), 1.0),
        'c': nrm(ks[1], (BATCH, D_MODEL), 1.0),
        'ctx': nrm(ks[2], (BATCH, CTX_LEN, D_MODEL), 1.0),
        'c_ctx': nrm(ks[3], (D_MODEL,), 1.0),
        'w_mod': nrm(ks[4], (DEPTH, D_MODEL, N_MOD * D_MODEL), D_MODEL ** -0.5),
        'b_mod': nrm(ks[5], (DEPTH, N_MOD * D_MODEL), 0.02),
        'ln_g': 1.0 + nrm(ks[6], (DEPTH, 3, D_MODEL), 0.02),
        'ln_b': nrm(ks[7], (DEPTH, 3, D_MODEL), 0.02),
        'ffn_w_gate': nrm(ks[8], (DEPTH, 2, D_MODEL, D_FF), D_MODEL ** -0.5),
        'ffn_w_up': nrm(ks[9], (DEPTH, 2, D_MODEL, D_FF), D_MODEL ** -0.5),
        'ffn_w_down': nrm(ks[10], (DEPTH, 2, D_FF, D_MODEL), DN_BETA * D_FF ** -0.5),
        'w_in': nrm(ks[11], (DEPTH, D_MODEL, W_IN), D_MODEL ** -0.5),
        'ssm_log_dt': jax.random.uniform(ks[12], (DEPTH, 2, G), f32, math.log(DT_MIN), math.log(DT_MAX)),
        'ssm_a_re': -0.5 + nrm(ks[13], (DEPTH, 2, G, P), 0.01),
        'ssm_a_im': jnp.pi * n + nrm(ks[14], (DEPTH, 2, G, P), 0.01),
        'ssm_b_re': nrm(ks[15], (DEPTH, 2, G, P, C), (2 * C) ** -0.5),
        'ssm_b_im': nrm(ks[16], (DEPTH, 2, G, P, C), (2 * C) ** -0.5),
        'ssm_c_re': nrm(ks[17], (DEPTH, 2, G, C, P), P ** -0.5),
        'ssm_c_im': nrm(ks[18], (DEPTH, 2, G, C, P), P ** -0.5),
        'ssm_d': 1.0 + nrm(ks[19], (DEPTH, SSM_WIDTH), 0.1),
        'ssm_w_glu': nrm(ks[20], (DEPTH, SSM_WIDTH, SSM_WIDTH), SSM_WIDTH ** -0.5),
        'ssm_b_glu': nrm(ks[21], (DEPTH, SSM_WIDTH), 0.02),
        'na_rpb': nrm(ks[22], (DEPTH, NA_HEADS, 2 * WIN_ROWS - 1, 2 * WIN_COLS - 1), 0.02),
        'w_br_ssm': nrm(ks[23], (DEPTH, SSM_WIDTH, D_MODEL), SSM_WIDTH ** -0.5),
        'w_br_fnet': nrm(ks[24], (DEPTH, FNET_WIDTH, D_MODEL), FNET_WIDTH ** -0.5),
        'w_br_na': nrm(ks[25], (DEPTH, NA_WIDTH, D_MODEL), NA_WIDTH ** -0.5),
        'w_out': nrm(ks[26], (DEPTH, D_MODEL, D_MODEL), DN_BETA * D_MODEL ** -0.5),
    }


def reference(x, c, ctx, c_ctx, w_mod, b_mod, ln_g, ln_b, ffn_w_gate, ffn_w_up, ffn_w_down, w_in,
              ssm_log_dt, ssm_a_re, ssm_a_im, ssm_b_re, ssm_b_im, ssm_c_re, ssm_c_im, ssm_d,
              ssm_w_glu, ssm_b_glu, na_rpb, w_br_ssm, w_br_fnet, w_br_na, w_out):
    h, hc = x, ctx
    for l in range(DEPTH):
        last = l == DEPTH - 1
        mod = jax.nn.silu(c) @ w_mod[l] + b_mod[l]
        mod_c = jax.nn.silu(c_ctx) @ w_mod[l] + b_mod[l]
        m = [mod[:, None, i * D_MODEL:(i + 1) * D_MODEL] for i in range(N_MOD)]
        mc = [mod_c[i * D_MODEL:(i + 1) * D_MODEL] for i in range(N_MOD)]
        h = _post_norm(h, 0.5 * m[2] * _swiglu(_modulate(h, m[0], m[1]), ffn_w_gate[l, 0], ffn_w_up[l, 0], ffn_w_down[l, 0]),
                       ln_g[l, 0], ln_b[l, 0])
        hc = _post_norm(hc, 0.5 * mc[2] * _swiglu(_modulate(hc, mc[0], mc[1]), ffn_w_gate[l, 0], ffn_w_up[l, 0], ffn_w_down[l, 0]),
                        ln_g[l, 0], ln_b[l, 0])
        y, yc = _mixer(_modulate(h, m[3], m[4]), _modulate(hc, mc[3], mc[4]), w_in[l],
                       ssm_log_dt[l], ssm_a_re[l], ssm_a_im[l], ssm_b_re[l], ssm_b_im[l], ssm_c_re[l], ssm_c_im[l],
                       ssm_d[l], ssm_w_glu[l], ssm_b_glu[l], na_rpb[l], w_br_ssm[l], w_br_fnet[l], w_br_na[l], w_out[l],
                       not last)
        h = _post_norm(h, m[5] * y, ln_g[l, 1], ln_b[l, 1])
        h = _post_norm(h, 0.5 * m[8] * _swiglu(_modulate(h, m[6], m[7]), ffn_w_gate[l, 1], ffn_w_up[l, 1], ffn_w_down[l, 1]),
                       ln_g[l, 2], ln_b[l, 2])
        if not last:
            hc = _post_norm(hc, mc[5] * yc, ln_g[l, 1], ln_b[l, 1])
            hc = _post_norm(hc, 0.5 * mc[8] * _swiglu(_modulate(hc, mc[6], mc[7]), ffn_w_gate[l, 1], ffn_w_up[l, 1], ffn_w_down[l, 1]),
                            ln_g[l, 2], ln_b[l, 2])
    return h
```

```cpp
#define DIAG_SANITIZE 1
#define DIAG_STOP 0
#define DIAG_TX0 0
#define DIAG_TX1 5
#define DIAG_TC0 1
#define DIAG_TC1 2
#include <hip/hip_runtime.h>
#include <hip/hip_cooperative_groups.h>
#include <cstdio>
#include <cstdint>
namespace pg8 {
#define PG8_LAS __attribute__((address_space(3)))
typedef unsigned short bf16_t;
typedef short bf16x8 __attribute__((ext_vector_type(8)));
typedef float f32x4 __attribute__((ext_vector_type(4)));
typedef unsigned u32x4 __attribute__((ext_vector_type(4)));
constexpr int BM = 256, BK = 64, HALF = 128, HTB = HALF * BK * 2  , STAGE_BYTES = 8 * HTB, NXCD = 8, WGM = 8;

__host__ __device__ __forceinline__ int lds_byte(int r, int c) { const int st = (r >> 4) * 2 + (c >> 5), rr = r & 15, cc = c & 31, ob = rr * 64 + cc * 2; return st * 1024 + (ob ^ (((ob >> 9) & 1) << 5)); }
__host__ __device__ __forceinline__ void stage_rc(int b, int& R, int& C) { const int st = b / 1024, sb = b % 1024, swz = sb ^ (((sb >> 9) & 1) << 5); R = (st >> 1) * 16 + swz / 64; C = (st & 1) * 32 + (swz % 64) / 2; }
__host__ __device__ __forceinline__ int perm32(int rho) { const int n = rho >> 4, i = rho & 15; return 8 * (i >> 2) + 4 * n + (i & 3); }

struct Unit { int pm, pn; };
struct Gemm { const bf16_t* A; const bf16_t* Bt; int M, N, K; };

struct StaticOrder {
    int nM, nN, nwg, G, c;
    __host__ __device__ void init(int M, int N, int G_, int c_) { nM = M / BM; nN = N / BM; nwg = nM * nN; G = G_; c = c_; }
    __host__ __device__ bool next(int i, Unit& u) const {
        const long L = (long)i * G + c; if (L >= nwg) return false;
        int wgid = (int)L; { const int q = nwg / NXCD, r = nwg % NXCD, xcd = wgid % NXCD, off = wgid / NXCD; wgid = (xcd < r ? xcd * (q + 1) : r * (q + 1) + (xcd - r) * q) + off; }
        const int nig = WGM * nN, gid = wgid / nig, fm = gid * WGM, gsz = (nM - fm) < WGM ? (nM - fm) : WGM;
        u.pm = fm + ((wgid % nig) % gsz); u.pn = (wgid % nig) / gsz; return true;
    }
    __device__ __forceinline__ void a_ready(const Unit&) const {}
    __device__ __forceinline__ void done(const Unit&) const {}
};

__device__ __forceinline__ unsigned cvt_pk_bf16(float lo, float hi) { unsigned r; asm volatile("v_cvt_pk_bf16_f32 %0, %1, %2" : "=v"(r) : "v"(lo), "v"(hi)); return r; }
typedef float f32x2 __attribute__((ext_vector_type(2)));
template <class Epi, class Sched, bool ALIGN_EPI = false, bool SP2 = false>
__device__ __forceinline__ void gemm_phase(PG8_LAS unsigned char* lds, const Gemm g, const Sched& S, const Epi& E, int tid_in) {
    int tid_l = tid_in; asm volatile("" : "+v"(tid_l));
    const int tid = tid_l, wid = __builtin_amdgcn_readfirstlane(tid >> 6), lane = tid & 63, wr = wid >> 2, wc = wid & 3, fr = lane & 15, fq = lane >> 4;
    const int K = g.K, nt = K / BK;
    unsigned voffA[2], voffB[2];
#pragma unroll
    for (int i = 0; i < 2; ++i) { int R, C; stage_rc(tid * 16 + i * 8192, R, C); const int Rb = Epi::PERM ? ((R & ~31) + perm32(R & 31)) : R;
        voffA[i] = (unsigned)(R * K + C) * 2u; voffB[i] = (unsigned)(Rb * K + C) * 2u; }
    const size_t kstep = (size_t)(BK * 2);
    const size_t hstep = (size_t)HALF * K * 2;
    const size_t tstep = 2 * hstep;
    const unsigned ldsw = (unsigned)wid * 1024u;
    const int aoff = lds_byte(wr * 64 + fr, fq * 8), boff = lds_byte(wc * 32 + fr, fq * 8);
#define PG8_SA(b, h) (((b) * 2 + (h)) * HTB)
#define PG8_SB(b, h) ((4 + (b) * 2 + (h)) * HTB)
#define PG8_STAGE(bufoff, gbase, voff) do { _Pragma("unroll") for (int _i = 0; _i < 2; ++_i) \
        __builtin_amdgcn_global_load_lds((const unsigned*)((const char*)(gbase) + (voff)[_i]), (PG8_LAS unsigned*)(lds + (bufoff) + ldsw + _i * 8192), 16, 0, 0); } while (0)
#define PG8_LDA(dst, b, h) do { _Pragma("unroll") for (int m = 0; m < 4; ++m) _Pragma("unroll") for (int k = 0; k < 2; ++k) dst[m][k] = *(const PG8_LAS bf16x8*)(lds + PG8_SA(b, h) + aoff + m * 2048 + k * 1024); } while (0)
#define PG8_LDB(dst, b, h) do { _Pragma("unroll") for (int n = 0; n < 2; ++n) _Pragma("unroll") for (int k = 0; k < 2; ++k) dst[n][k] = *(const PG8_LAS bf16x8*)(lds + PG8_SB(b, h) + boff + n * 2048 + k * 1024); } while (0)
#define PG8_MMA(ai, bj, At, Bt) do { __builtin_amdgcn_s_setprio(1); _Pragma("unroll") for (int m = 0; m < 4; ++m) _Pragma("unroll") for (int n = 0; n < 2; ++n) _Pragma("unroll") for (int k = 0; k < 2; ++k) \
        acc[ai][bj][m][n] = __builtin_amdgcn_mfma_f32_16x16x32_bf16(Bt[n][k], At[m][k], acc[ai][bj][m][n], 0, 0, 0); __builtin_amdgcn_s_setprio(0); } while (0)
#define PG8_WAIT_V(n) asm volatile("s_waitcnt vmcnt(" #n ")" ::: "memory")
#define PG8_WAIT_L(n) asm volatile("s_waitcnt lgkmcnt(" #n ")" ::: "memory")
#define PG8_BAR __builtin_amdgcn_s_barrier()
#define PG8_SCHED __builtin_amdgcn_sched_barrier(0)
    Unit cur, nxt; int ui = 0;
    if (!S.next(0, cur)) return;
    f32x4 acc[2][2][4][2];
#pragma unroll
    for (int a = 0; a < 2; ++a)
#pragma unroll
        for (int b = 0; b < 2; ++b)
#pragma unroll
            for (int m = 0; m < 4; ++m)
#pragma unroll
                for (int n = 0; n < 2; ++n) acc[a][b][m][n] = (f32x4){0.f, 0.f, 0.f, 0.f};
    bf16x8 At[4][2], B0[2][2], B1[2][2];
    const char* cA = (const char*)g.A + (size_t)cur.pm * tstep; const char* cB = (const char*)g.Bt + (size_t)cur.pn * tstep;
    S.a_ready(cur);
    if constexpr (SP2) {
        PG8_STAGE(PG8_SB(0, 0), cB, voffB); PG8_STAGE(PG8_SB(0, 1), cB + hstep, voffB); PG8_STAGE(PG8_SA(0, 0), cA, voffA); PG8_STAGE(PG8_SA(0, 1), cA + hstep, voffA);
        if (wr == 1) PG8_BAR;
        PG8_WAIT_V(2); PG8_BAR;
        PG8_STAGE(PG8_SB(1, 0), cB + kstep, voffB); PG8_STAGE(PG8_SA(1, 0), cA + kstep, voffA); PG8_STAGE(PG8_SB(1, 1), cB + hstep + kstep, voffB);
        PG8_WAIT_V(6); PG8_BAR;
    } else {
        PG8_STAGE(PG8_SB(0, 0), cB, voffB); PG8_STAGE(PG8_SA(0, 0), cA, voffA); PG8_STAGE(PG8_SB(0, 1), cB + hstep, voffB); PG8_STAGE(PG8_SA(0, 1), cA + hstep, voffA);
        if (wr == 1) PG8_BAR;
        PG8_WAIT_V(4); PG8_BAR;
        PG8_STAGE(PG8_SB(1, 0), cB + kstep, voffB); PG8_STAGE(PG8_SA(1, 0), cA + kstep, voffA); PG8_STAGE(PG8_SB(1, 1), cB + hstep + kstep, voffB);
        PG8_WAIT_V(6); PG8_BAR;
    }
#pragma unroll 1
    for (;;) {
        const bool has_next = S.next(ui + 1, nxt);
        const char* nA = has_next ? (const char*)g.A + (size_t)nxt.pm * tstep : cA; const char* nB = has_next ? (const char*)g.Bt + (size_t)nxt.pn * tstep : cB;
#pragma unroll 1
        for (int t = 0; t < nt; t += 2) {
            const bool last = (t == nt - 2);
            const char* a1 = cA + (size_t)(t + 1) * kstep;
            const char* a2 = last ? nA : cA + (size_t)(t + 2) * kstep; const char* b2 = last ? nB : cB + (size_t)(t + 2) * kstep;
            const char* a3 = a2 + kstep; const char* b3 = b2 + kstep;
            if (last && has_next) S.a_ready(nxt);
            if constexpr (SP2) {
            PG8_LDB(B0, 0, 0); PG8_LDB(B1, 0, 1); PG8_SCHED; PG8_LDA(At, 0, 0); PG8_STAGE(PG8_SA(1, 1), a1 + hstep, voffA);
            PG8_WAIT_V(8); PG8_WAIT_L(0); PG8_BAR; PG8_MMA(0, 0, At, B0); PG8_MMA(0, 1, At, B1); PG8_BAR; PG8_SCHED;
            PG8_LDA(At, 0, 1); PG8_STAGE(PG8_SB(0, 0), b2, voffB); PG8_STAGE(PG8_SB(0, 1), b2 + hstep, voffB); PG8_STAGE(PG8_SA(0, 0), a2, voffA);
            PG8_WAIT_V(8); PG8_WAIT_L(0); PG8_BAR; PG8_MMA(1, 0, At, B0); PG8_MMA(1, 1, At, B1); PG8_BAR; PG8_SCHED;
            PG8_LDB(B0, 1, 0); PG8_LDB(B1, 1, 1); PG8_SCHED; PG8_LDA(At, 1, 0); PG8_STAGE(PG8_SA(0, 1), a2 + hstep, voffA);
            PG8_WAIT_V(8); PG8_WAIT_L(0); PG8_BAR; PG8_MMA(0, 0, At, B0); PG8_MMA(0, 1, At, B1); PG8_BAR; PG8_SCHED;
            PG8_LDA(At, 1, 1); PG8_STAGE(PG8_SB(1, 0), b3, voffB); PG8_STAGE(PG8_SB(1, 1), b3 + hstep, voffB); PG8_STAGE(PG8_SA(1, 0), a3, voffA);
            PG8_WAIT_V(8); PG8_WAIT_L(0); PG8_BAR; PG8_MMA(1, 0, At, B0); PG8_MMA(1, 1, At, B1); PG8_BAR; PG8_SCHED;
            } else {
            PG8_LDB(B0, 0, 0); PG8_SCHED; PG8_LDA(At, 0, 0); PG8_STAGE(PG8_SA(1, 1), a1 + hstep, voffA);
            PG8_WAIT_L(8); PG8_BAR; PG8_WAIT_L(0); PG8_MMA(0, 0, At, B0); PG8_BAR; PG8_SCHED;
            PG8_LDB(B1, 0, 1); PG8_STAGE(PG8_SB(0, 0), b2, voffB);
            PG8_BAR; PG8_WAIT_L(0); PG8_MMA(0, 1, At, B1); PG8_BAR;
            PG8_LDA(At, 0, 1); PG8_STAGE(PG8_SA(0, 0), a2, voffA);
            PG8_BAR; PG8_WAIT_L(0); PG8_MMA(1, 0, At, B0); PG8_BAR; PG8_SCHED;
            PG8_STAGE(PG8_SB(0, 1), b2 + hstep, voffB);
            PG8_WAIT_V(6); PG8_BAR; PG8_MMA(1, 1, At, B1); PG8_BAR;
            PG8_LDB(B0, 1, 0); PG8_SCHED; PG8_LDA(At, 1, 0); PG8_STAGE(PG8_SA(0, 1), a2 + hstep, voffA);
            PG8_WAIT_L(8); PG8_BAR; PG8_WAIT_L(0); PG8_MMA(0, 0, At, B0); PG8_BAR; PG8_SCHED;
            PG8_LDB(B1, 1, 1); PG8_STAGE(PG8_SB(1, 0), b3, voffB);
            PG8_BAR; PG8_WAIT_L(0); PG8_MMA(0, 1, At, B1); PG8_BAR;
            PG8_LDA(At, 1, 1); PG8_STAGE(PG8_SA(1, 0), a3, voffA);
            PG8_BAR; PG8_WAIT_L(0); PG8_MMA(1, 0, At, B0); PG8_BAR; PG8_SCHED;
            PG8_STAGE(PG8_SB(1, 1), b3 + hstep, voffB);
            PG8_WAIT_V(6); PG8_BAR; PG8_MMA(1, 1, At, B1); PG8_BAR;
            }
        }
        if constexpr (ALIGN_EPI) { if (wr == 0) PG8_BAR; }
        if constexpr (!Epi::AFTER_DRAIN) { E(acc, cur, wr, wc, fr, fq); S.done(cur); }
        if (!has_next) break;
#pragma unroll
        for (int a = 0; a < 2; ++a)
#pragma unroll
            for (int b = 0; b < 2; ++b)
#pragma unroll
                for (int m = 0; m < 4; ++m)
#pragma unroll
                    for (int n = 0; n < 2; ++n) acc[a][b][m][n] = (f32x4){0.f, 0.f, 0.f, 0.f};
        cur = nxt; cA = nA; cB = nB; ++ui;
        if constexpr (ALIGN_EPI) { if (wr == 1) PG8_BAR; }
    }
    PG8_WAIT_V(0);
    if constexpr (!ALIGN_EPI) { if (wr == 0) PG8_BAR; }
    PG8_BAR;
    if constexpr (Epi::AFTER_DRAIN) { E.fused(acc, cur, wr, wc, fr, fq, lds, wid, lane); S.done(cur); }
#undef PG8_SA
#undef PG8_SB
#undef PG8_STAGE
#undef PG8_LDA
#undef PG8_LDB
#undef PG8_MMA
#undef PG8_WAIT_V
#undef PG8_WAIT_L
#undef PG8_BAR
#undef PG8_SCHED
}
}
namespace cg = cooperative_groups;
#define LAS __attribute__((address_space(3)))
typedef unsigned short bf16;
typedef short bf16x8 __attribute__((ext_vector_type(8)));
typedef float f32x4 __attribute__((ext_vector_type(4)));
typedef unsigned u32x4 __attribute__((ext_vector_type(4)));
typedef unsigned u32x2 __attribute__((ext_vector_type(2)));

constexpr int DM = 1024, NB = 4, SEQ = 8192, DEPTH = 2, CTXL = 256;
constexpr int MLAT = NB * SEQ, MCTX = NB * CTXL, MT = MLAT + MCTX;
constexpr int DFF = 2816, NMOD = 9, WIN = 5120;
constexpr int NTHREADS = 512, NWAVES = 8;
constexpr float LN_EPS = 1e-6f;
constexpr float DN_ALPHA = 1.41421356237309515f;
constexpr int NCHUNK = 132;
constexpr float TWO_PI = 6.283185307179586f;

constexpr size_t al256(size_t x) { return (x + 255) & ~(size_t)255; }
constexpr size_t WS_CTL = 0, CTL_BYTES = 65536;
constexpr size_t WS_MOD = WS_CTL + CTL_BYTES;
constexpr size_t WS_HC = al256(WS_MOD + (size_t)DEPTH * 5 * 9216 * 4);
constexpr size_t WS_TBL = WS_HC + (size_t)MCTX * DM * 4;
constexpr size_t T_PNEG = 0;
constexpr size_t T_PPOS = T_PNEG + 2 * 16 * 2 * 64 * 64 * 4;
constexpr size_t T_BBT = T_PPOS + 2 * 16 * 2 * 64 * 64 * 4;
constexpr size_t T_CCT = T_BBT + 2 * 16 * 128 * 16 * 2;
constexpr size_t T_APOW = T_CCT + 2 * 16 * 4 * 16 * 32 * 2;
constexpr size_t T_WCB = T_APOW + 3 * 2 * 16 * 2 * 64 * 4;
constexpr size_t T_FA64 = T_WCB + 128 * 64 * 2;
constexpr size_t T_FA16 = T_FA64 + 2 * 64 * 4 * 32 * 2;
constexpr size_t T_FC128 = T_FA16 + 2 * 16 * 32 * 2;
constexpr size_t T_FC16 = T_FC128 + 128 * 256 * 2;
constexpr size_t T_ROPE = T_FC16 + 16 * 32 * 2;
constexpr size_t T_END = T_ROPE + 2 * 128 * 16 * 4;
constexpr size_t WS_SLOC = al256(WS_TBL + T_END);
constexpr size_t WS_WA = al256(WS_SLOC + (size_t)4 * 16 * 2 * NCHUNK * 128 * 4);
constexpr size_t WA_GU = 0, WA_DN = (size_t)5632 * 1024 * 2, WA_BYTES = WA_DN + (size_t)1024 * 2816 * 2;
constexpr size_t WS_WB = al256(WS_WA + WA_BYTES);
constexpr size_t WB_IN = 0, WB_GLU = WB_IN + (size_t)WIN * 1024 * 2, WB_BRS = WB_GLU + 256 * 256 * 2, WB_BRF = WB_BRS + 1024 * 256 * 2,
                 WB_BRN = WB_BRF + 1024 * 256 * 2, WB_OUT = WB_BRN + 1024 * 512 * 2, WB_BYTES = WB_OUT + 1024 * 1024 * 2;
constexpr size_t WS_U = al256(WS_WB + WB_BYTES);
constexpr size_t SZ_U = (size_t)MT * 1024 * 2;
constexpr size_t WS_RES = WS_U + SZ_U;
constexpr size_t WS_Z = WS_RES + SZ_U;
constexpr size_t SZ_256 = (size_t)MT * 256 * 2, SZ_512 = (size_t)MT * 512 * 2;
constexpr size_t Z_K = 0, Z_Q = Z_K + SZ_512, Z_VT = Z_Q + SZ_512, Z_SSMU = Z_VT + SZ_512, Z_F = Z_SSMU + SZ_256, Z_G = Z_F + SZ_256, Z_END = Z_G + (size_t)MT * 3072 * 2;
constexpr size_t WS_END = WS_Z + Z_END;
constexpr size_t OV_YPRE = 0, OV_TBL = SZ_256, OV_TBC = OV_TBL + (size_t)16 * 64 * 2 * 64 * 128 * 2;
static_assert(OV_TBC + (size_t)16 * 16 * 2 * 64 * 16 * 2 <= SZ_U, "U overlay");
static_assert(SZ_256 * 2 + SZ_512 == SZ_U, "RES overlay");
static_assert((size_t)MT * 2816 * 2 <= Z_END, "ACT overlay");
static_assert(WS_END <= (size_t)536870912, "d_ws map exceeds 512 MiB");

#define QCTR(l, s) (4096 + 64 * (1 + (l) * 3 + (s)))

__device__ __forceinline__ unsigned f2bf(float f) { unsigned u = __builtin_bit_cast(unsigned, f); return (u + 0x7fffu + ((u >> 16) & 1u)) >> 16; }
__device__ __forceinline__ float bf2f(unsigned b) { return __builtin_bit_cast(float, b << 16); }
typedef __bf16 bf16x2_t __attribute__((ext_vector_type(2)));
typedef float f32x2_t __attribute__((ext_vector_type(2)));
__device__ __forceinline__ unsigned pk2(float lo, float hi) { const f32x2_t v = {lo, hi}; const bf16x2_t r = __builtin_convertvector(v, bf16x2_t); return __builtin_bit_cast(unsigned, r); }
__device__ __forceinline__ float bflo(unsigned w) { return __builtin_bit_cast(float, w << 16); }
__device__ __forceinline__ float bfhi(unsigned w) { return __builtin_bit_cast(float, w & 0xffff0000u); }
__device__ __forceinline__ float fsigmoid(float x) { return __builtin_amdgcn_rcpf(1.f + __expf(-x)); }
__device__ __forceinline__ float fsilu(float x) { return x * fsigmoid(x); }
__device__ __forceinline__ float gelu_tanh(float x) { const float z = 0.7978845608028654f * (x + 0.044715f * x * x * x); return x * fsigmoid(2.f * z); }
__device__ __forceinline__ f32x4 mfma16(bf16x8 a, bf16x8 b, f32x4 c) { return __builtin_amdgcn_mfma_f32_16x16x32_bf16(a, b, c, 0, 0, 0); }
__device__ __forceinline__ bf16x8 as_bf16x8(u32x4 v) { return __builtin_bit_cast(bf16x8, v); }
__device__ __forceinline__ bf16x8 pack8(f32x4 a, f32x4 b) { u32x4 w; w.x = pk2(a[0], a[1]); w.y = pk2(a[2], a[3]); w.z = pk2(b[0], b[1]); w.w = pk2(b[2], b[3]); return as_bf16x8(w); }
__device__ __forceinline__ float wave_sum(float v) {
#pragma unroll
    for (int o = 1; o < 64; o <<= 1) v += __shfl_xor(v, o);
    return v;
}
constexpr f32x4 F4Z = {0.f, 0.f, 0.f, 0.f};

struct Params {
    const float* in[27];
    float* out;
    unsigned char* ws;
};

struct Frame {
    LAS unsigned char* lds;
    int tid, lane, wave, gw, ngw;
};

__device__ __forceinline__ void tr_item(const float* __restrict__ W, int N, int k0, int n0, bf16* __restrict__ WT, int ldk, int drow0, LAS float* scr, int lane) {
#pragma unroll 8
    for (int i = 0; i < 32; ++i) { const int kk = 2 * i + (lane >> 5); scr[kk * 33 + (lane & 31)] = W[(size_t)(k0 + kk) * N + n0 + (lane & 31)]; }
    asm volatile("s_waitcnt lgkmcnt(0)" ::: "memory");
    const int c = lane & 7;
#pragma unroll
    for (int j = 0; j < 4; ++j) { const int n = (lane >> 3) + 8 * j; const LAS float* s = scr + (8 * c) * 33 + n;
        u32x4 o; o.x = pk2(s[0 * 33], s[1 * 33]); o.y = pk2(s[2 * 33], s[3 * 33]); o.z = pk2(s[4 * 33], s[5 * 33]); o.w = pk2(s[6 * 33], s[7 * 33]);
        *(u32x4*)(WT + (size_t)(drow0 + n) * ldk + k0 + 8 * c) = o; }
    asm volatile("s_waitcnt lgkmcnt(0)" ::: "memory");
}

__device__ __forceinline__ void convert_ffn(const Frame& F, const Params& P, int l, int f) {
    LAS float* scr = (LAS float*)(F.lds + F.wave * 16384);
    const float* wg = P.in[8] + (size_t)(l * 2 + f) * DM * DFF;
    const float* wu = P.in[9] + (size_t)(l * 2 + f) * DM * DFF;
    const float* wd = P.in[10] + (size_t)(l * 2 + f) * DFF * DM;
    bf16* gu = (bf16*)(P.ws + WS_WA + WA_GU); bf16* dn = (bf16*)(P.ws + WS_WA + WA_DN);
    constexpr int I_G = (DM / 64) * (DFF / 32), I_D = (DFF / 64) * (DM / 32);
    for (int it = F.gw; it < 2 * I_G + I_D; it += F.ngw) {
        int r = it;
        if (r < 2 * I_G) { const int up = r >= I_G; if (up) r -= I_G; const int nblk = DFF / 32, kb = r / nblk, nb = r % nblk, n0 = nb * 32;
            tr_item(up ? wu : wg, DFF, kb * 64, n0, gu, DM, 256 * (n0 / 128) + (n0 % 128) + (up ? 128 : 0), scr, F.lane); continue; }
        r -= 2 * I_G; { const int nblk = DM / 32, kb = r / nblk, nb = r % nblk; tr_item(wd, DM, kb * 64, nb * 32, dn, DFF, nb * 32, scr, F.lane); }
    }
}
__device__ __forceinline__ void convert_mixer(const Frame& F, const Params& P, int l) {
    LAS float* scr = (LAS float*)(F.lds + F.wave * 16384);
    constexpr int I_IN = (DM / 64) * (WIN / 32), I_GLU = 4 * 8, I_BRS = 4 * 32, I_BRF = 4 * 32, I_BRN = 8 * 32, I_OUT = 16 * 32;
    for (int it = F.gw; it < I_IN + I_GLU + I_BRS + I_BRF + I_BRN + I_OUT; it += F.ngw) {
        int r = it;
        if (r < I_IN) { const int nblk = WIN / 32; tr_item(P.in[11] + (size_t)l * DM * WIN, WIN, (r / nblk) * 64, (r % nblk) * 32, (bf16*)(P.ws + WS_WB + WB_IN), DM, (r % nblk) * 32, scr, F.lane); continue; } r -= I_IN;
        if (r < I_GLU) { tr_item(P.in[20] + (size_t)l * 256 * 256, 256, (r / 8) * 64, (r % 8) * 32, (bf16*)(P.ws + WS_WB + WB_GLU), 256, (r % 8) * 32, scr, F.lane); continue; } r -= I_GLU;
        if (r < I_BRS) { tr_item(P.in[23] + (size_t)l * 256 * DM, DM, (r / 32) * 64, (r % 32) * 32, (bf16*)(P.ws + WS_WB + WB_BRS), 256, (r % 32) * 32, scr, F.lane); continue; } r -= I_BRS;
        if (r < I_BRF) { tr_item(P.in[24] + (size_t)l * 256 * DM, DM, (r / 32) * 64, (r % 32) * 32, (bf16*)(P.ws + WS_WB + WB_BRF), 256, (r % 32) * 32, scr, F.lane); continue; } r -= I_BRF;
        if (r < I_BRN) { tr_item(P.in[25] + (size_t)l * 512 * DM, DM, (r / 32) * 64, (r % 32) * 32, (bf16*)(P.ws + WS_WB + WB_BRN), 512, (r % 32) * 32, scr, F.lane); continue; } r -= I_BRN;
        tr_item(P.in[26] + (size_t)l * DM * DM, DM, (r / 32) * 64, (r % 32) * 32, (bf16*)(P.ws + WS_WB + WB_OUT), DM, (r % 32) * 32, scr, F.lane);
    }
}

__device__ __forceinline__ void make_s5_tables(const Frame& F, const Params& P, int l) {
    unsigned char* tb = P.ws + WS_TBL;
    float* pneg = (float*)(tb + T_PNEG); float* ppos = (float*)(tb + T_PPOS); bf16* bbt = (bf16*)(tb + T_BBT); bf16* cct = (bf16*)(tb + T_CCT); float* apow = (float*)(tb + T_APOW);
    const float* log_dt = P.in[12] + l * 32; const float* a_re = P.in[13] + l * 2048; const float* a_im = P.in[14] + l * 2048;
    const float* b_re = P.in[15] + (size_t)l * 32768; const float* b_im = P.in[16] + (size_t)l * 32768;
    const float* c_re = P.in[17] + (size_t)l * 32768; const float* c_im = P.in[18] + (size_t)l * 32768;
    const int gt = F.gw * 64 + F.lane, ngt = F.ngw * 64;
    for (int i = gt; i < 32 * 64 * 64; i += ngt) {
        const int t = i & 63, p = (i >> 6) & 63, dg = i >> 12, dir = dg >> 4;
        const float dt = expf(log_dt[dg]), ar = a_re[dg * 64 + p] * dt, ai = a_im[dg * 64 + p] * dt;
        const float e = (float)(dir ? 63 - t : t);
        float sn, cs; sincosf(e * ai, &sn, &cs);
        const float mp = expf(e * ar), mn = expf(-e * ar);
        pneg[((size_t)(dg * 2 + 0) * 64 + p) * 64 + t] = mn * cs; pneg[((size_t)(dg * 2 + 1) * 64 + p) * 64 + t] = -mn * sn;
        ppos[((size_t)(dg * 2 + 0) * 64 + t) * 64 + p] = mp * cs; ppos[((size_t)(dg * 2 + 1) * 64 + t) * 64 + p] = mp * sn;
    }
    for (int i = gt; i < 32 * 64; i += ngt) {
        const int p = i & 63, dg = i >> 6;
        const float dt = expf(log_dt[dg]), are = a_re[dg * 64 + p], aim = a_im[dg * 64 + p], ar = are * dt, ai = aim * dt;
        const float es[3] = {1.f, 63.f, 64.f};
#pragma unroll
        for (int k = 0; k < 3; ++k) { float sn, cs; sincosf(es[k] * ai, &sn, &cs); const float m = expf(es[k] * ar);
            apow[((size_t)(k * 32 + dg) * 2 + 0) * 64 + p] = m * cs; apow[((size_t)(k * 32 + dg) * 2 + 1) * 64 + p] = m * sn; }
        float sn, cs; sincosf(ai, &sn, &cs); const float mag = expf(ar);
        const float abr = mag * cs, abi = mag * sn, den = are * are + aim * aim, nr = abr - 1.f, ni = abi;
        const float fr = (nr * are + ni * aim) / den, fi = (ni * are - nr * aim) / den;
#pragma unroll
        for (int c = 0; c < 16; ++c) {
            const float br = b_re[((size_t)dg * 64 + p) * 16 + c], bi = b_im[((size_t)dg * 64 + p) * 16 + c];
            bbt[((size_t)dg * 128 + p) * 16 + c] = (bf16)f2bf(fr * br - fi * bi);
            bbt[((size_t)dg * 128 + 64 + p) * 16 + c] = (bf16)f2bf(fr * bi + fi * br);
        }
    }
    for (int i = gt; i < 32 * 4 * 16 * 4 * 8; i += ngt) {
        const int s = i & 7, G = (i >> 3) & 3, c = (i >> 5) & 15, mt = (i >> 9) & 3, dg = i >> 11;
        const int p = 16 * mt + 4 * G + (s & 3);
        const float v = (s < 4) ? c_re[((size_t)dg * 16 + c) * 64 + p] : -c_im[((size_t)dg * 16 + c) * 64 + p];
        cct[i] = (bf16)f2bf(v);
    }
}
__device__ __forceinline__ void make_static_tables(const Frame& F, const Params& P) {
    unsigned char* tb = P.ws + WS_TBL;
    const int gt = F.gw * 64 + F.lane, ngt = F.ngw * 64;
    bf16* wcb = (bf16*)(tb + T_WCB);
    for (int i = gt; i < 128 * 64; i += ngt) { const int c = i & 63, mp = i >> 6, m = mp & 63; float sn, cs; sincospif(2.f * (float)((m * c) & 63) / 64.f, &sn, &cs);
        wcb[i] = (bf16)f2bf((mp < 64 ? cs : -sn) * 0.125f); }
    bf16* fa64 = (bf16*)(tb + T_FA64);
    for (int i = gt; i < 2 * 64 * 4 * 32; i += ngt) { const int s = i & 7, G = (i >> 3) & 3, lt = (i >> 5) & 3, k1 = (i >> 7) & 63, po = i >> 13;
        const int l1 = 16 * lt + 4 * G + (s & 3); float sn, cs; sincospif(2.f * (float)((k1 * l1) & 63) / 64.f, &sn, &cs);
        const float v = (po == 0) ? ((s < 4) ? cs : sn) : ((s < 4) ? -sn : cs); fa64[i] = (bf16)f2bf(v * 0.125f); }
    bf16* fa16 = (bf16*)(tb + T_FA16);
    for (int i = gt; i < 2 * 16 * 32; i += ngt) { const int s = i & 7, G = (i >> 3) & 3, k1 = (i >> 5) & 15, po = i >> 9;
        const int l1 = 4 * G + (s & 3); float sn, cs; sincospif(2.f * (float)((k1 * l1) & 15) / 16.f, &sn, &cs);
        const float v = (po == 0) ? ((s < 4) ? cs : sn) : ((s < 4) ? -sn : cs); fa16[i] = (bf16)f2bf(v * 0.25f); }
    bf16* fc128 = (bf16*)(tb + T_FC128);
    for (int i = gt; i < 128 * 256; i += ngt) { const int kap = i & 255, k2 = i >> 8, part = kap >> 7, l2 = kap & 127; float sn, cs; sincospif(2.f * (float)((k2 * l2) & 127) / 128.f, &sn, &cs);
        fc128[i] = (bf16)f2bf((part ? sn : cs) * 0.08838834764831845f); }
    bf16* fc16 = (bf16*)(tb + T_FC16);
    for (int i = gt; i < 16 * 32; i += ngt) { const int kap = i & 31, k2 = i >> 5, part = kap >> 4, l2 = kap & 15; float sn, cs; sincospif(2.f * (float)((k2 * l2) & 15) / 16.f, &sn, &cs);
        fc16[i] = (bf16)f2bf((part ? sn : cs) * 0.25f); }
    float* rope = (float*)(tb + T_ROPE);
    for (int i = gt; i < 128 * 16; i += ngt) { const int f = i & 15, pos = i >> 4; const float inv = powf(10000.f, -(float)f / 16.f); const float ang = (float)pos * inv;
        rope[i] = cosf(ang); rope[128 * 16 + i] = sinf(ang); }
}

__device__ __forceinline__ void mod_phase(const Frame& F, const Params& P) {
    LAS float* sc = (LAS float*)(F.lds + 8 * 16384);
    for (int i = F.tid; i < 5 * DM; i += NTHREADS) { const float v = (i < 4 * DM) ? P.in[1][i] : P.in[3][i - 4 * DM]; sc[i] = fsilu(v); }
    __syncthreads();
    float* mod = (float*)(P.ws + WS_MOD);
    int task = -1;
    if (F.wave == 0) task = blockIdx.x; else if (F.wave == 1 && (int)blockIdx.x < 288 - (int)gridDim.x) task = gridDim.x + blockIdx.x;
    if (task >= 0 && task < 288) {
        const int l = task / 144, j = (task % 144) * 64 + F.lane;
        const float* w = P.in[4] + (size_t)l * DM * 9216 + j;
        float a0 = 0.f, a1 = 0.f, a2 = 0.f, a3 = 0.f, a4 = 0.f;
#pragma unroll 8
        for (int k = 0; k < DM; ++k) { const float wv = w[(size_t)k * 9216]; a0 += sc[k] * wv; a1 += sc[DM + k] * wv; a2 += sc[2 * DM + k] * wv; a3 += sc[3 * DM + k] * wv; a4 += sc[4 * DM + k] * wv; }
        const float bv = P.in[5][l * 9216 + j];
        float* o = mod + (size_t)l * 5 * 9216 + j;
        o[0] = a0 + bv; o[9216] = a1 + bv; o[2 * 9216] = a2 + bv; o[3 * 9216] = a3 + bv; o[4 * 9216] = a4 + bv;
    }
}

__device__ __forceinline__ const float* mod_vec(const Params& P, int l, int bidx, int i) { return (const float*)(P.ws + WS_MOD) + ((size_t)l * 5 + bidx) * 9216 + i * DM; }
template <int MODE>
__device__ __forceinline__ void rowwise_phase(const Frame& F, const Params& P, int l, int gi, float gscale, int lni, int lu, int si, bool do_u, bool first_h, int nrows) {
    bf16* U = (bf16*)(P.ws + WS_U); const bf16* RES = (const bf16*)(P.ws + WS_RES); float* HC = (float*)(P.ws + WS_HC);
    for (int row = F.gw; row < nrows; row += F.ngw) {
        const bool lat = row < MLAT; const int bidx = lat ? row / SEQ : 4;
        const float* hin; float* hout;
        if (lat) { hin = (first_h ? P.in[0] : P.out) + (size_t)row * DM; hout = P.out + (size_t)row * DM; }
        else { hin = (first_h ? P.in[2] : HC) + (size_t)(row - MLAT) * DM; hout = HC + (size_t)(row - MLAT) * DM; }
        f32x4 v[4];
#pragma unroll
        for (int j = 0; j < 4; ++j) v[j] = *(const f32x4*)(hin + 4 * F.lane + 256 * j);
        if (MODE == 1) {
            const float* mg = mod_vec(P, l, bidx, gi); const float* lg = P.in[6] + (size_t)(l * 3 + lni) * DM; const float* lb = P.in[7] + (size_t)(l * 3 + lni) * DM;
            float s = 0.f;
#pragma unroll
            for (int j = 0; j < 4; ++j) { const int c = 4 * F.lane + 256 * j; const u32x2 r = *(const u32x2*)(RES + (size_t)row * DM + c); const f32x4 g = *(const f32x4*)(mg + c);
                v[j][0] = DN_ALPHA * v[j][0] + gscale * g[0] * bflo(r.x); v[j][1] = DN_ALPHA * v[j][1] + gscale * g[1] * bfhi(r.x);
                v[j][2] = DN_ALPHA * v[j][2] + gscale * g[2] * bflo(r.y); v[j][3] = DN_ALPHA * v[j][3] + gscale * g[3] * bfhi(r.y);
                s += (v[j][0] + v[j][1]) + (v[j][2] + v[j][3]); }
            const float mean = wave_sum(s) * (1.f / DM); float s2 = 0.f;
#pragma unroll
            for (int j = 0; j < 4; ++j) { v[j] = v[j] - mean; s2 += (v[j][0] * v[j][0] + v[j][1] * v[j][1]) + (v[j][2] * v[j][2] + v[j][3] * v[j][3]); }
            const float rstd = rsqrtf(wave_sum(s2) * (1.f / DM) + LN_EPS);
#pragma unroll
            for (int j = 0; j < 4; ++j) { const int c = 4 * F.lane + 256 * j; const f32x4 g = *(const f32x4*)(lg + c), b = *(const f32x4*)(lb + c);
                v[j] = v[j] * rstd * g + b;
#ifdef DIAG_SANITIZE
#pragma unroll
                for (int q = 0; q < 4; ++q) v[j][q] = (__builtin_fabsf(v[j][q]) < 1e30f) ? v[j][q] : 0.f;
#endif
                *(f32x4*)(hout + c) = v[j]; }
        }
        if (do_u) {
            const float* msh = mod_vec(P, lu, bidx, si); const float* msc = mod_vec(P, lu, bidx, si + 1);
            float s = 0.f;
#pragma unroll
            for (int j = 0; j < 4; ++j) s += (v[j][0] + v[j][1]) + (v[j][2] + v[j][3]);
            const float mean = wave_sum(s) * (1.f / DM); float s2 = 0.f;
#pragma unroll
            for (int j = 0; j < 4; ++j) { v[j] = v[j] - mean; s2 += (v[j][0] * v[j][0] + v[j][1] * v[j][1]) + (v[j][2] * v[j][2] + v[j][3] * v[j][3]); }
            const float rstd = rsqrtf(wave_sum(s2) * (1.f / DM) + LN_EPS);
#pragma unroll
            for (int j = 0; j < 4; ++j) { const int c = 4 * F.lane + 256 * j; const f32x4 sh = *(const f32x4*)(msh + c), sc = *(const f32x4*)(msc + c);
                const f32x4 o = v[j] * rstd * (sc + 1.f) + sh; u32x2 w; w.x = pk2(o[0], o[1]); w.y = pk2(o[2], o[3]); *(u32x2*)(U + (size_t)row * DM + c) = w; }
        }
    }
}
#define XB_TMO      128
#define XB_XCNT(j)  (256  + 64 * (j))
#define XB_XSUB(j)  (1280 + 64 * (j))
#define XB_XGEN(j)  (2304 + 64 * (j))
#define XB_TOP      3328
#define XB_TOPGEN   3392
#define XCD_BAR_WORDS 3456
#define XB_SPIN_CAP (1u << 30)

__device__ __forceinline__ unsigned xb_ld(unsigned* p)              { return __hip_atomic_load(p, __ATOMIC_RELAXED, __HIP_MEMORY_SCOPE_AGENT); }
__device__ __forceinline__ unsigned xb_add(unsigned* p, unsigned v) { return __hip_atomic_fetch_add(p, v, __ATOMIC_RELAXED, __HIP_MEMORY_SCOPE_AGENT); }
__device__ __forceinline__ unsigned xb_xcc_id() { return (unsigned)__builtin_amdgcn_s_getreg((3 << 11) | 20) & 0xFu; }
#define XB_SPIN(cond, bar) do { unsigned _sp = 0; while (cond) { __builtin_amdgcn_s_sleep(1); \
    if ((++_sp & 255u) == 0u) { if (xb_ld(&(bar)[XB_TMO])) break; if (_sp > XB_SPIN_CAP) { atomicAdd(&(bar)[XB_TMO], 1u); break; } } } } while (0)

struct XcdBarrier {
    unsigned* bar; unsigned x;
    volatile LAS unsigned* st;
};

__device__ __forceinline__ XcdBarrier xcd_barrier_post(unsigned* bar, volatile LAS unsigned* st, int tid) {
    XcdBarrier b; b.bar = bar; b.x = xb_xcc_id(); b.st = st;
    if (tid == 0) (void)xb_add(&bar[XB_XCNT(b.x)], 1u);
    return b;
}
__device__ __forceinline__ void xcd_barrier_complete(unsigned* bar, unsigned x, unsigned& nloc, unsigned& nx) {
    const unsigned G = gridDim.x * gridDim.y * gridDim.z;
    unsigned sum, cnt, mine, sp = 0u;
    for (;;) {
        sum = 0u; cnt = 0u; mine = 0u;
#pragma unroll
        for (unsigned j = 0; j < 16; ++j) { const unsigned c = xb_ld(&bar[XB_XCNT(j)]); sum += c; cnt += (c > 0u) ? 1u : 0u; mine = (j == x) ? c : mine; }
        if (sum == G) break;
        __builtin_amdgcn_s_sleep(1);
        if ((++sp & 255u) == 0u) { if (xb_ld(&bar[XB_TMO])) break; if (sp > XB_SPIN_CAP) { atomicAdd(&bar[XB_TMO], 1u); break; } }
    }
    nloc = mine > 0u ? mine : 1u; nx = cnt > 0u ? cnt : 1u;
}

__device__ __forceinline__ void xcd_barrier(const XcdBarrier& b, int tid) {
    asm volatile("s_waitcnt vmcnt(0)" ::: "memory");
    __syncthreads();
    if (tid == 0) {
        unsigned* bar = b.bar;
        __builtin_amdgcn_s_waitcnt(0);
        unsigned nloc = b.st[0], nx = b.st[1];
        if (nloc == 0u) { xcd_barrier_complete(bar, b.x, nloc, nx); b.st[0] = nloc; b.st[1] = nx; }
        const unsigned old = xb_add(&bar[XB_XSUB(b.x)], 1u);
        const unsigned gen = old / nloc;
        if (old + 1u == (gen + 1u) * nloc) {
            __builtin_amdgcn_fence(__ATOMIC_RELEASE, "agent");
            asm volatile("s_waitcnt vmcnt(0)" ::: "memory");
            const unsigned og = xb_add(&bar[XB_TOP], 1u);
            const unsigned tg = og / nx;
            if (og + 1u == (tg + 1u) * nx) xb_add(&bar[XB_TOPGEN], 1u);
            else XB_SPIN(xb_ld(&bar[XB_TOPGEN]) == tg, bar);
            __builtin_amdgcn_fence(__ATOMIC_ACQUIRE, "agent");
            xb_add(&bar[XB_XGEN(b.x)], 1u);
            asm volatile("s_waitcnt vmcnt(0)" ::: "memory");
        } else {
            XB_SPIN(xb_ld(&bar[XB_XGEN(b.x)]) == gen, bar);
            __builtin_amdgcn_fence(__ATOMIC_ACQUIRE, "agent");
            asm volatile("s_waitcnt vmcnt(0)" ::: "memory");
        }
    }
    __syncthreads();
}
typedef f32x4 AccT[2][2][4][2];
__device__ __forceinline__ const void* uni_ptr(const void* p) { const unsigned long long v = (unsigned long long)p; unsigned lo = __builtin_amdgcn_readfirstlane((unsigned)v), hi = __builtin_amdgcn_readfirstlane((unsigned)(v >> 32));
    asm volatile("" : "+s"(lo), "+s"(hi)); return (const void*)(((unsigned long long)hi << 32) | lo); }
#define EPI_ROWS(u, wr, fr, ai, m) ((u).pm * 256 + (ai) * 128 + (wr) * 64 + (m) * 16 + (fr))

struct EpiGU {
    static constexpr bool PERM = true, AFTER_DRAIN = false;
    bf16* O;
    __device__ __forceinline__ void operator()(const AccT& acc, const pg8::Unit& u, int wr, int wc, int fr, int fq) const {
        asm volatile("" : "+v"(fr), "+v"(fq));
        const int col = u.pn * 128 + wc * 32 + 8 * fq;
#pragma unroll
        for (int ai = 0; ai < 2; ++ai)
#pragma unroll
            for (int m = 0; m < 4; ++m) {
                const size_t row = EPI_ROWS(u, wr, fr, ai, m);
                const f32x4 g0 = acc[ai][0][m][0], g1 = acc[ai][0][m][1], u0 = acc[ai][1][m][0], u1 = acc[ai][1][m][1];
                u32x4 w; w.x = pk2(fsilu(g0[0]) * u0[0], fsilu(g0[1]) * u0[1]); w.y = pk2(fsilu(g0[2]) * u0[2], fsilu(g0[3]) * u0[3]);
                w.z = pk2(fsilu(g1[0]) * u1[0], fsilu(g1[1]) * u1[1]); w.w = pk2(fsilu(g1[2]) * u1[2], fsilu(g1[3]) * u1[3]);
                *(u32x4*)(O + row * DFF + col) = w;
            }
    }
};
struct EpiStore {
    static constexpr bool PERM = true, AFTER_DRAIN = false;
    bf16* O; int ldc;
    __device__ __forceinline__ void operator()(const AccT& acc, const pg8::Unit& u, int wr, int wc, int fr, int fq) const {
        asm volatile("" : "+v"(fr), "+v"(fq));
#pragma unroll
        for (int ai = 0; ai < 2; ++ai)
#pragma unroll
            for (int m = 0; m < 4; ++m) {
                const size_t row = EPI_ROWS(u, wr, fr, ai, m);
#pragma unroll
                for (int bj = 0; bj < 2; ++bj) { const int col = u.pn * 256 + bj * 128 + wc * 32 + 8 * fq; const f32x4 v0 = acc[ai][bj][m][0], v1 = acc[ai][bj][m][1];
                    u32x4 w; w.x = pk2(v0[0], v0[1]); w.y = pk2(v0[2], v0[3]); w.z = pk2(v1[0], v1[1]); w.w = pk2(v1[2], v1[3]);
                    *(u32x4*)(O + row * ldc + col) = w; }
            }
    }
};
struct EpiGLU {
    static constexpr bool PERM = true, AFTER_DRAIN = false;
    const bf16* Y; const float* bias; bf16* O;
    __device__ __forceinline__ void operator()(const AccT& acc, const pg8::Unit& u, int wr, int wc, int fr, int fq) const {
        asm volatile("" : "+v"(fr), "+v"(fq));
#pragma unroll
        for (int ai = 0; ai < 2; ++ai)
#pragma unroll
            for (int m = 0; m < 4; ++m) {
                const size_t row = EPI_ROWS(u, wr, fr, ai, m);
#pragma unroll
                for (int bj = 0; bj < 2; ++bj) {
                    const int col = bj * 128 + wc * 32 + 8 * fq;
                    const f32x4 b0 = *(const f32x4*)(bias + col), b1 = *(const f32x4*)(bias + col + 4);
                    const u32x4 y = *(const u32x4*)(Y + row * 256 + col); const f32x4 v0 = acc[ai][bj][m][0] + b0, v1 = acc[ai][bj][m][1] + b1;
                    u32x4 w; w.x = pk2(bflo(y.x) * fsigmoid(v0[0]), bfhi(y.x) * fsigmoid(v0[1])); w.y = pk2(bflo(y.y) * fsigmoid(v0[2]), bfhi(y.y) * fsigmoid(v0[3]));
                    w.z = pk2(bflo(y.z) * fsigmoid(v1[0]), bfhi(y.z) * fsigmoid(v1[1])); w.w = pk2(bflo(y.w) * fsigmoid(v1[2]), bfhi(y.w) * fsigmoid(v1[3]));
                    *(u32x4*)(O + row * 256 + col) = w;
                    asm volatile("" ::: "memory");
                }
            }
    }
};
template <bool FIRST> struct EpiMerge {
    static constexpr bool PERM = true, AFTER_DRAIN = false;
    const bf16* G; int gi; bf16* O;
    __device__ __forceinline__ void operator()(const AccT& acc, const pg8::Unit& u, int wr, int wc, int fr, int fq) const {
        asm volatile("" : "+v"(fr), "+v"(fq));
#pragma unroll
        for (int ai = 0; ai < 2; ++ai)
#pragma unroll
            for (int m = 0; m < 4; ++m) {
                const size_t row = EPI_ROWS(u, wr, fr, ai, m);
#pragma unroll
                for (int bj = 0; bj < 2; ++bj) { const int col = u.pn * 256 + bj * 128 + wc * 32 + 8 * fq;
                    const u32x4 g = *(const u32x4*)(G + row * 3072 + gi * 1024 + col); const f32x4 v0 = acc[ai][bj][m][0], v1 = acc[ai][bj][m][1];
                    float o[8] = {bflo(g.x) * v0[0], bfhi(g.x) * v0[1], bflo(g.y) * v0[2], bfhi(g.y) * v0[3], bflo(g.z) * v1[0], bfhi(g.z) * v1[1], bflo(g.w) * v1[2], bfhi(g.w) * v1[3]};
                    if (!FIRST) { const u32x4 p = *(const u32x4*)(O + row * DM + col);
                        o[0] += bflo(p.x); o[1] += bfhi(p.x); o[2] += bflo(p.y); o[3] += bfhi(p.y); o[4] += bflo(p.z); o[5] += bfhi(p.z); o[6] += bflo(p.w); o[7] += bfhi(p.w); }
                    u32x4 w; w.x = pk2(o[0], o[1]); w.y = pk2(o[2], o[3]); w.z = pk2(o[4], o[5]); w.w = pk2(o[6], o[7]);
                    *(u32x4*)(O + row * DM + col) = w; asm volatile("" ::: "memory"); }
            }
    }
};
struct EpiWin {
    static constexpr bool PERM = true, AFTER_DRAIN = false;
    unsigned char* z; const float* rope;
    __device__ __forceinline__ void operator()(const AccT& acc, const pg8::Unit& u, int wr, int wc, int fr, int fq) const {
        asm volatile("" : "+v"(fr), "+v"(fq));
        const int pn = u.pn;
        unsigned char* z = (unsigned char*)uni_ptr(this->z); const float* rope = (const float*)uni_ptr(this->rope);
        if (pn == 0 || pn == 5 || pn >= 8) {
            bf16* O; int ldc, cb; const bool sig = pn >= 8;
            if (pn == 0) { O = (bf16*)(z + Z_SSMU); ldc = 256; cb = 0; } else if (pn == 5) { O = (bf16*)(z + Z_F); ldc = 256; cb = 0; } else { O = (bf16*)(z + Z_G); ldc = 3072; cb = (pn - 8) * 256; }
#pragma unroll
            for (int ai = 0; ai < 2; ++ai)
#pragma unroll
                for (int m = 0; m < 4; ++m) {
                    const size_t row = EPI_ROWS(u, wr, fr, ai, m);
#pragma unroll
                    for (int bj = 0; bj < 2; ++bj) { const int col = cb + bj * 128 + wc * 32 + 8 * fq; f32x4 v0 = acc[ai][bj][m][0], v1 = acc[ai][bj][m][1];
                        if (sig) {
#pragma unroll
                            for (int j = 0; j < 4; ++j) { v0[j] = fsigmoid(v0[j]); v1[j] = fsigmoid(v1[j]); } }
                        u32x4 w; w.x = pk2(v0[0], v0[1]); w.y = pk2(v0[2], v0[3]); w.z = pk2(v1[0], v1[1]); w.w = pk2(v1[2], v1[3]);
                        *(u32x4*)(O + row * ldc + col) = w; }
                }
        } else if (pn == 3 || pn == 4) {
            bf16* VT = (bf16*)(z + Z_VT); bf16* VCT = VT + (size_t)NB * 8 * 64 * SEQ;
#pragma unroll
            for (int ai = 0; ai < 2; ++ai)
#pragma unroll
                for (int m = 0; m < 4; ++m) {
                    const int row = EPI_ROWS(u, wr, fr, ai, m);
                    bf16* base; int ldt;
                    if (row < MLAT) { const int b = row / SEQ, t = row % SEQ; base = VT + (size_t)b * 512 * SEQ + t; ldt = SEQ; }
                    else { const int rc = row - MLAT, b = rc / CTXL, t = rc % CTXL; base = VCT + (size_t)b * 512 * CTXL + t; ldt = CTXL; }
#pragma unroll
                    for (int bj = 0; bj < 2; ++bj) { const int vc = (pn - 3) * 256 + bj * 128 + wc * 32 + 8 * fq;
#pragma unroll
                        for (int n = 0; n < 2; ++n)
#pragma unroll
                            for (int j = 0; j < 4; ++j) base[(size_t)(vc + 4 * n + j) * ldt] = (bf16)f2bf(acc[ai][bj][m][n][j]); }
                }
        } else {
            const bool isq = pn >= 6; bf16* O = (bf16*)(z + (isq ? Z_Q : Z_K)); const int cb = (pn - (isq ? 6 : 1)) * 256; const float qs = isq ? 0.125f : 1.f;
            const bool latent = u.pm < MLAT / 256;
            const int ax = wc & 1, ph = fq >> 1, f0 = 8 * (fq & 1);
#pragma unroll
            for (int ai = 0; ai < 2; ++ai)
#pragma unroll
                for (int m = 0; m < 4; ++m) {
                    const int row = EPI_ROWS(u, wr, fr, ai, m);
                    f32x4 c0 = {1.f, 1.f, 1.f, 1.f}, c1 = c0, s0 = F4Z, s1 = F4Z;
                    if (latent) { const int t = row % SEQ, pos = ax ? (t & 63) : (t >> 6); const float* rc = rope + pos * 16 + f0;
                        c0 = *(const f32x4*)rc; c1 = *(const f32x4*)(rc + 4); s0 = *(const f32x4*)(rc + 2048); s1 = *(const f32x4*)(rc + 2048 + 4); }
#pragma unroll
                    for (int bj = 0; bj < 2; ++bj) { const int col = cb + bj * 128 + wc * 32 + 8 * fq; f32x4 v0 = acc[ai][bj][m][0], v1 = acc[ai][bj][m][1], o0, o1;
#pragma unroll
                        for (int j = 0; j < 4; ++j) { const float p0 = __shfl_xor(v0[j], 32), p1 = __shfl_xor(v1[j], 32);
                            o0[j] = (ph ? (v0[j] * c0[j] + p0 * s0[j]) : (v0[j] * c0[j] - p0 * s0[j])) * qs;
                            o1[j] = (ph ? (v1[j] * c1[j] + p1 * s1[j]) : (v1[j] * c1[j] - p1 * s1[j])) * qs; }
                        u32x4 w; w.x = pk2(o0[0], o0[1]); w.y = pk2(o0[2], o0[3]); w.z = pk2(o1[0], o1[1]); w.w = pk2(o1[2], o1[3]);
                        *(u32x4*)(O + (size_t)row * 512 + col) = w; }
                }
        }
    }
};
__device__ __forceinline__ int chunk_row0(int b, int ck) { return ck < 4 ? MLAT + b * CTXL + 64 * ck : b * SEQ + 64 * (ck - 4); }
__device__ __forceinline__ bf16x8 ld_frag(const bf16* p) { return *(const bf16x8*)p; }
constexpr bf16x8 BF8Z = {0, 0, 0, 0, 0, 0, 0, 0};

__device__ __forceinline__ void s5_stage1(const unsigned char* tb, int dg, int nt, const bf16x8 (&af)[4], int fr, int G, f32x4 (&vre)[4], f32x4 (&vim)[4]) {
    const bf16* bbt = (const bf16*)(tb + T_BBT); const float* pneg = (const float*)(tb + T_PNEG);
    const bf16x8 bre = (G < 2) ? ld_frag(bbt + ((size_t)dg * 128 + 16 * nt + fr) * 16 + 8 * G) : BF8Z;
    const bf16x8 bim = (G < 2) ? ld_frag(bbt + ((size_t)dg * 128 + 64 + 16 * nt + fr) * 16 + 8 * G) : BF8Z;
    const float* pr = pneg + ((size_t)(dg * 2 + 0) * 64 + 16 * nt + fr) * 64 + 4 * G;
    const float* pi = pneg + ((size_t)(dg * 2 + 1) * 64 + 16 * nt + fr) * 64 + 4 * G;
#pragma unroll
    for (int tt = 0; tt < 4; ++tt) {
        const f32x4 cr = mfma16(af[tt], bre, F4Z), ci = mfma16(af[tt], bim, F4Z);
        const f32x4 qr = *(const f32x4*)(pr + 16 * tt), qi = *(const f32x4*)(pi + 16 * tt);
        vre[tt] = qr * cr - qi * ci; vim[tt] = qr * ci + qi * cr;
    }
}
__device__ __forceinline__ void s5_load_u(const bf16* SSMU, int row0, int g, int fr, int G, bf16x8 (&af)[4]) {
#pragma unroll
    for (int tt = 0; tt < 4; ++tt) af[tt] = (G < 2) ? ld_frag(SSMU + (size_t)(row0 + 16 * tt + fr) * 256 + 16 * g + 8 * G) : BF8Z;
}

__device__ __forceinline__ void s5_pass_a(const Params& P, int item, int lane) {
    const int fr = lane & 15, G = lane >> 4;
    const int dir = item & 1, ck = (item >> 1) % NCHUNK, bg = (item >> 1) / NCHUNK, g = bg & 15, b = bg >> 4, dg = dir * 16 + g;
    const unsigned char* tb = P.ws + WS_TBL; const float* apow = (const float*)(tb + T_APOW);
    float* sloc = (float*)(P.ws + WS_SLOC) + ((size_t)((bg * 2 + dir) * NCHUNK + ck)) * 128;
    bf16x8 af[4]; s5_load_u((const bf16*)(P.ws + WS_Z + Z_SSMU), chunk_row0(b, ck), g, fr, G, af);
#pragma unroll
    for (int nt = 0; nt < 4; ++nt) {
        f32x4 vre[4], vim[4]; s5_stage1(tb, dg, nt, af, fr, G, vre, vim);
        float sr = 0.f, si = 0.f;
#pragma unroll
        for (int tt = 0; tt < 4; ++tt) { sr += (vre[tt][0] + vre[tt][1]) + (vre[tt][2] + vre[tt][3]); si += (vim[tt][0] + vim[tt][1]) + (vim[tt][2] + vim[tt][3]); }
        sr += __shfl_xor(sr, 16); sr += __shfl_xor(sr, 32); si += __shfl_xor(si, 16); si += __shfl_xor(si, 32);
        const int p = 16 * nt + fr;
        const float ar = apow[((size_t)(1 * 32 + dg) * 2 + 0) * 64 + p], ai = apow[((size_t)(1 * 32 + dg) * 2 + 1) * 64 + p];
        if (G == 0) { sloc[p] = ar * sr - ai * si; sloc[64 + p] = ar * si + ai * sr; }
    }
}
__device__ __forceinline__ void s5_pass_b(const Params& P, int item, int lane) {
    const int dir = item & 1, bg = item >> 1, g = bg & 15, dg = dir * 16 + g, p = lane;
    const float* apow = (const float*)(P.ws + WS_TBL + T_APOW);
    const float a1r = apow[((size_t)(0 * 32 + dg) * 2 + 0) * 64 + p], a1i = apow[((size_t)(0 * 32 + dg) * 2 + 1) * 64 + p];
    const float a64r = apow[((size_t)(2 * 32 + dg) * 2 + 0) * 64 + p], a64i = apow[((size_t)(2 * 32 + dg) * 2 + 1) * 64 + p];
    float* sl = (float*)(P.ws + WS_SLOC) + (size_t)(bg * 2 + dir) * NCHUNK * 128;
    float hr = 0.f, hi = 0.f;
    for (int q0 = 0; q0 < NCHUNK; q0 += 12) {
        float sr[12], si[12];
#pragma unroll
        for (int k = 0; k < 12; ++k) { const int q = q0 + k, ck = dir ? (q < 4 ? 3 - q : 135 - q) : q; sr[k] = sl[(size_t)ck * 128 + p]; si[k] = sl[(size_t)ck * 128 + 64 + p]; }
#pragma unroll
        for (int k = 0; k < 12; ++k) { const int q = q0 + k, ck = dir ? (q < 4 ? 3 - q : 135 - q) : q;
            sl[(size_t)ck * 128 + p] = a1r * hr - a1i * hi; sl[(size_t)ck * 128 + 64 + p] = a1r * hi + a1i * hr;
            const float nr = a64r * hr - a64i * hi + sr[k], ni = a64r * hi + a64i * hr + si[k]; hr = nr; hi = ni; }
    }
}
__device__ __forceinline__ void s5_pass_c(const Params& P, int l, int item, int nck, int ck0, int lane) {
    const int fr = lane & 15, G = lane >> 4;
    const int ck = ck0 + item % nck, bg = item / nck, g = bg & 15, b = bg >> 4;
    const unsigned char* tb = P.ws + WS_TBL; const float* ppos = (const float*)(tb + T_PPOS); const bf16* cct = (const bf16*)(tb + T_CCT);
    const bf16* SSMU = (const bf16*)(P.ws + WS_Z + Z_SSMU); const int row0 = chunk_row0(b, ck);
    bf16x8 af[4]; s5_load_u(SSMU, row0, g, fr, G, af);
    f32x4 yt[4] = {F4Z, F4Z, F4Z, F4Z};
#pragma unroll 1
    for (int dir = 0; dir < 2; ++dir) {
        const int dg = dir * 16 + g;
        const float* ah = (const float*)(P.ws + WS_SLOC) + ((size_t)((bg * 2 + dir) * NCHUNK + ck)) * 128;
        bf16x8 lf[2][4];
#pragma unroll
        for (int kk = 0; kk < 2; ++kk)
#pragma unroll
            for (int nto = 0; nto < 4; ++nto) { const int to = 16 * nto + fr; u32x4 w;
#pragma unroll
                for (int wi = 0; wi < 4; ++wi) { const int s0 = 16 * (2 * kk + (wi >> 1)) + 4 * G + 2 * (wi & 1), s1 = s0 + 1;
                    const unsigned lo = (dir ? (s0 >= to) : (s0 <= to)) ? 0x3F80u : 0u, hi = (dir ? (s1 >= to) : (s1 <= to)) ? 0x3F80u : 0u; w[wi] = lo | (hi << 16); }
                lf[kk][nto] = as_bf16x8(w); }
#pragma unroll
        for (int nt = 0; nt < 4; ++nt) {
            f32x4 vre[4], vim[4]; s5_stage1(tb, dg, nt, af, fr, G, vre, vim);
            const bf16x8 are0 = pack8(vre[0], vre[1]), are1 = pack8(vre[2], vre[3]), aim0 = pack8(vim[0], vim[1]), aim1 = pack8(vim[2], vim[3]);
            const f32x4 cr = *(const f32x4*)(ah + 16 * nt + 4 * G), ci = *(const f32x4*)(ah + 64 + 16 * nt + 4 * G);
            const bf16x8 cfrag = ld_frag(cct + ((((size_t)dg * 4 + nt) * 16 + fr) * 4 + G) * 8);
#pragma unroll
            for (int nto = 0; nto < 4; ++nto) {
                f32x4 hr = mfma16(are0, lf[0][nto], F4Z); hr = mfma16(are1, lf[1][nto], hr);
                f32x4 hi = mfma16(aim0, lf[0][nto], F4Z); hi = mfma16(aim1, lf[1][nto], hi);
                hr = hr + cr; hi = hi + ci;
                const float* pp = ppos + ((size_t)(dg * 2 + 0) * 64 + 16 * nto + fr) * 64 + 16 * nt + 4 * G;
                const f32x4 qr = *(const f32x4*)pp, qi = *(const f32x4*)(pp + 4096);
                const f32x4 sr = qr * hr - qi * hi, si = qr * hi + qi * hr;
                yt[nto] = mfma16(cfrag, pack8(sr, si), yt[nto]);
            }
        }
    }
    const float* dvec = P.in[19] + l * 256 + 16 * g + 4 * G; const f32x4 dv = *(const f32x4*)dvec;
    bf16* YPRE = (bf16*)(P.ws + WS_U + OV_YPRE);
#pragma unroll
    for (int nto = 0; nto < 4; ++nto) { const size_t row = row0 + 16 * nto + fr; const u32x2 uu = *(const u32x2*)(SSMU + row * 256 + 16 * g + 4 * G);
        const float y0 = gelu_tanh(yt[nto][0] + dv[0] * bflo(uu.x)), y1 = gelu_tanh(yt[nto][1] + dv[1] * bfhi(uu.x)), y2 = gelu_tanh(yt[nto][2] + dv[2] * bflo(uu.y)), y3 = gelu_tanh(yt[nto][3] + dv[3] * bfhi(uu.y));
        u32x2 w; w.x = pk2(y0, y1); w.y = pk2(y2, y3); *(u32x2*)(YPRE + row * 256 + 16 * g + 4 * G) = w; }
}

template <int N1, int N2>
__device__ __forceinline__ void fnet_a(const Params& P, int item, int lane) {
    constexpr int LT = N1 / 16, NOCT = N2 / 8, L = N1 * N2;
    const int fr = lane & 15, G = lane >> 4;
    const int kt1 = item % LT, mt = (item / LT) & 3, oct = (item / (LT * 4)) % NOCT, bg = item / (LT * 4 * NOCT), g = bg & 3, b = bg >> 2;
    const unsigned char* tb = P.ws + WS_TBL; const bf16* wcb = (const bf16*)(tb + T_WCB); const bf16* fa = (const bf16*)(tb + (N1 == 64 ? T_FA64 : T_FA16));
    const bf16* FB = (const bf16*)(P.ws + WS_Z + Z_F); bf16* TB = (bf16*)(P.ws + WS_U + (N1 == 64 ? OV_TBL : OV_TBC));
    const int rbase = (N1 == 64) ? b * SEQ : MLAT + b * CTXL;
    bf16x8 wre[2], wim[2], far[LT], fai[LT];
#pragma unroll
    for (int kk = 0; kk < 2; ++kk) { wre[kk] = ld_frag(wcb + (size_t)(16 * mt + fr) * 64 + 32 * kk + 8 * G); wim[kk] = ld_frag(wcb + (size_t)(64 + 16 * mt + fr) * 64 + 32 * kk + 8 * G); }
#pragma unroll
    for (int lt = 0; lt < LT; ++lt) { far[lt] = ld_frag(fa + ((((size_t)0 * N1 + 16 * kt1 + fr) * LT + lt) * 4 + G) * 8); fai[lt] = ld_frag(fa + ((((size_t)1 * N1 + 16 * kt1 + fr) * LT + lt) * 4 + G) * 8); }
    unsigned ore[4][4], oim[4][4];
#pragma unroll
    for (int e2 = 0; e2 < 4; ++e2) {
        f32x4 tr2[2], ti2[2];
#pragma unroll
        for (int eo = 0; eo < 2; ++eo) {
            const int l2 = 8 * oct + 2 * e2 + eo;
            f32x4 tre = F4Z, tim = F4Z;
#pragma unroll
            for (int lt = 0; lt < LT; ++lt) {
                const bf16* rp = FB + (size_t)(rbase + (16 * lt + fr) * N2 + l2) * 256 + g * 64 + 8 * G;
                const bf16x8 a0 = ld_frag(rp), a1 = ld_frag(rp + 32);
                f32x4 xr = mfma16(a0, wre[0], F4Z); xr = mfma16(a1, wre[1], xr);
                f32x4 xi = mfma16(a0, wim[0], F4Z); xi = mfma16(a1, wim[1], xi);
                const bf16x8 xf = pack8(xr, xi);
                tre = mfma16(far[lt], xf, tre); tim = mfma16(fai[lt], xf, tim);
            }
#pragma unroll
            for (int r = 0; r < 4; ++r) { const int k1 = 16 * kt1 + 4 * G + r; float sn, cs; sincospif(2.f * (float)((k1 * l2) % L) / (float)L, &sn, &cs);
                const float a = tre[r], bb = tim[r]; tre[r] = a * cs + bb * sn; tim[r] = bb * cs - a * sn; }
            tr2[eo] = tre; ti2[eo] = tim;
        }
#pragma unroll
        for (int r = 0; r < 4; ++r) { ore[r][e2] = pk2(tr2[0][r], tr2[1][r]); oim[r][e2] = pk2(ti2[0][r], ti2[1][r]); }
    }
    const int m = 16 * mt + fr;
#pragma unroll
    for (int r = 0; r < 4; ++r) { const int k1 = 16 * kt1 + 4 * G + r;
        bf16* o = TB + ((((size_t)bg * N1 + k1) * 2 + 0) * 64 + m) * N2 + 8 * oct;
        u32x4 w0 = {ore[r][0], ore[r][1], ore[r][2], ore[r][3]}, w1 = {oim[r][0], oim[r][1], oim[r][2], oim[r][3]};
        *(u32x4*)o = w0; *(u32x4*)(o + (size_t)64 * N2) = w1; }
}
template <int N1, int N2>
__device__ __forceinline__ void fnet_c(const Params& P, int item, int lane) {
    constexpr int KT2 = N2 / 16, NKB = 2 * N2 / 32;
    const int fr = lane & 15, G = lane >> 4;
    const int mt = item & 3, k1 = (item >> 2) % N1, bg = (item >> 2) / N1, g = bg & 3, b = bg >> 2;
    const unsigned char* tb = P.ws + WS_TBL; const bf16* fc = (const bf16*)(tb + (N2 == 128 ? T_FC128 : T_FC16));
    const bf16* TB = (const bf16*)(P.ws + WS_U + (N1 == 64 ? OV_TBL : OV_TBC)); bf16* YF = (bf16*)(P.ws + WS_RES + SZ_256);
    const int rbase = (N1 == 64) ? b * SEQ : MLAT + b * CTXL;
    f32x4 acc[KT2];
#pragma unroll
    for (int k = 0; k < KT2; ++k) acc[k] = F4Z;
#pragma unroll 2
    for (int kb = 0; kb < NKB; ++kb) {
        const int kap = 32 * kb + 8 * G, part = kap / N2, l2 = kap % N2;
        const bf16x8 tf = ld_frag(TB + ((((size_t)bg * N1 + k1) * 2 + part) * 64 + 16 * mt + fr) * N2 + l2);
#pragma unroll
        for (int k = 0; k < KT2; ++k) acc[k] = mfma16(tf, ld_frag(fc + (size_t)(16 * k + fr) * (2 * N2) + kap), acc[k]);
    }
#pragma unroll
    for (int k = 0; k < KT2; ++k) { const size_t row = rbase + k1 + N1 * (16 * k + fr); u32x2 w; w.x = pk2(acc[k][0], acc[k][1]); w.y = pk2(acc[k][2], acc[k][3]);
        *(u32x2*)(YF + row * 256 + g * 64 + 16 * mt + 4 * G) = w; }
}
struct KVFrag { bf16x8 k[2][2]; u32x2 v[4][2]; };
__device__ __forceinline__ void attn_load(const bf16* __restrict__ KB, const bf16* __restrict__ VT, const bf16* __restrict__ VCT, int b, int h, int r0, int cb, int ch, bool ctxonly, int fr, int G, KVFrag& f) {
    const bool loc = !ctxonly && ch < 8; const int cc = ctxonly ? ch : ch - 8;
    const int tok0 = loc ? (r0 + ch) * 64 + cb : 32 * cc;
    const size_t krow = loc ? (size_t)b * SEQ + tok0 : (size_t)MLAT + b * CTXL + tok0;
    const bf16* kp = KB + (krow + fr) * 512 + h * 64 + 8 * G;
#pragma unroll
    for (int t = 0; t < 2; ++t)
#pragma unroll
        for (int kt = 0; kt < 2; ++kt) f.k[t][kt] = *(const bf16x8*)(kp + (size_t)(16 * t) * 512 + 32 * kt);
    const bf16* vp = loc ? VT + ((size_t)(b * 512 + h * 64 + fr)) * SEQ + tok0 + 4 * G : VCT + ((size_t)(b * 512 + h * 64 + fr)) * CTXL + tok0 + 4 * G;
    const size_t dstep = loc ? (size_t)16 * SEQ : (size_t)16 * CTXL;
#pragma unroll
    for (int dt = 0; dt < 4; ++dt)
#pragma unroll
        for (int t = 0; t < 2; ++t) f.v[dt][t] = *(const u32x2*)(vp + dt * dstep + 16 * t);
}
__device__ __forceinline__ void attn_item(const Params& P, const LAS float* rpb, int item, bool ctxq, int lane) {
    const int fr = lane & 15, G = lane >> 4;
    const bf16* KB = (const bf16*)(P.ws + WS_Z + Z_K); const bf16* QB = (const bf16*)(P.ws + WS_Z + Z_Q);
    const bf16* VT = (const bf16*)(P.ws + WS_Z + Z_VT); const bf16* VCT = VT + (size_t)NB * 512 * SEQ;
    bf16* YN = (bf16*)(P.ws + WS_RES + 2 * SZ_256);
    int b, h, r = 0, cg = 0, r0 = 0, cb = 0, nch; size_t qrow0;
    if (!ctxq) { cg = item & 3; r = (item >> 2) & 127; h = (item >> 9) & 7; b = item >> 12; r0 = min(max(r - 4, 0), 120); cb = (cg == 0) ? 0 : (cg == 1) ? 8 : (cg == 2) ? 24 : 32;
        qrow0 = (size_t)b * SEQ + r * 64 + 16 * cg; nch = 16; }
    else { const int qt = item & 15; h = (item >> 4) & 7; b = item >> 7; qrow0 = (size_t)MLAT + b * CTXL + 16 * qt; nch = 8; }
    bf16x8 qf[2];
#pragma unroll
    for (int kt = 0; kt < 2; ++kt) qf[kt] = *(const bf16x8*)(QB + (qrow0 + fr) * 512 + h * 64 + 32 * kt + 8 * G);
    const int qc = 16 * cg + fr, c0 = min(max(qc - 8, 0), 48);
    const LAS float* rph = rpb + h * (15 * 31);
    f32x4 ot[4] = {F4Z, F4Z, F4Z, F4Z};
    float mrun = -1e30f, lsum = 0.f;
    KVFrag cur, nxt;
    attn_load(KB, VT, VCT, b, h, r0, cb, 0, ctxq, fr, G, cur);
#pragma unroll 2
    for (int ch = 0; ch < nch; ++ch) {
        if (ch + 1 < nch) attn_load(KB, VT, VCT, b, h, r0, cb, ch + 1, ctxq, fr, G, nxt);
        f32x4 s[2];
#pragma unroll
        for (int t = 0; t < 2; ++t) { s[t] = mfma16(cur.k[t][0], qf[0], F4Z); s[t] = mfma16(cur.k[t][1], qf[1], s[t]); }
        if (!ctxq && ch < 8) {
            const int dr = r0 + ch - r + 7;
#pragma unroll
            for (int t = 0; t < 2; ++t)
#pragma unroll
                for (int j = 0; j < 4; ++j) { const int kc = cb + 16 * t + 4 * G + j; const bool ok = (kc >= c0) && (kc < c0 + 16); const int dc = min(max(kc - qc + 15, 0), 30);
                    const float bias = rph[dr * 31 + dc]; s[t][j] = ok ? s[t][j] + bias : -1e30f; }
        }
        float cm = fmaxf(fmaxf(fmaxf(s[0][0], s[0][1]), fmaxf(s[0][2], s[0][3])), fmaxf(fmaxf(s[1][0], s[1][1]), fmaxf(s[1][2], s[1][3])));
        cm = fmaxf(cm, __shfl_xor(cm, 16)); cm = fmaxf(cm, __shfl_xor(cm, 32));
        const float mnew = fmaxf(mrun, cm), alpha = __expf(mrun - mnew); mrun = mnew;
        f32x4 p0, p1; float ps = 0.f;
#pragma unroll
        for (int j = 0; j < 4; ++j) { p0[j] = __expf(s[0][j] - mnew); p1[j] = __expf(s[1][j] - mnew); ps += p0[j] + p1[j]; }
        lsum = lsum * alpha + ps;
        const bf16x8 pf = pack8(p0, p1);
#pragma unroll
        for (int dt = 0; dt < 4; ++dt) { u32x4 vw = {cur.v[dt][0].x, cur.v[dt][0].y, cur.v[dt][1].x, cur.v[dt][1].y}; ot[dt] = mfma16(as_bf16x8(vw), pf, ot[dt] * alpha); }
        cur = nxt;
    }
    lsum += __shfl_xor(lsum, 16); lsum += __shfl_xor(lsum, 32);
    const float inv = 1.f / lsum;
#pragma unroll
    for (int dt = 0; dt < 4; ++dt) { u32x2 w; w.x = pk2(ot[dt][0] * inv, ot[dt][1] * inv); w.y = pk2(ot[dt][2] * inv, ot[dt][3] * inv);
        *(u32x2*)(YN + (qrow0 + fr) * 512 + h * 64 + 16 * dt + 4 * G) = w; }
}
constexpr int LDS_CTL_OFF = 8 * 16384 + 5 * DM * 4;
constexpr int LDS_BYTES = LDS_CTL_OFF + 128;
__device__ __forceinline__ int q_next(unsigned* ctr, int lane) { unsigned v = 0; if (lane == 0) v = atomicAdd(ctr, 1u); return (int)__builtin_amdgcn_readfirstlane(v); }

template <class Epi>
__device__ __forceinline__ void run_gemm(const Frame& F, const bf16* A, const bf16* Bt, int M, int N, int K, const Epi& E) {
    pg8::Gemm g{A, Bt, M, N, K}; pg8::StaticOrder S; S.init(M, N, (int)gridDim.x, (int)blockIdx.x);
    pg8::gemm_phase<Epi, pg8::StaticOrder, true, true>((PG8_LAS unsigned char*)F.lds, g, S, E, F.tid);
}

__device__ __forceinline__ Frame mkframe(unsigned char* lds_raw, int wv) {
    Frame Fr; asm volatile("" : "+s"(wv)); int ln = (int)__builtin_amdgcn_mbcnt_hi(~0u, __builtin_amdgcn_mbcnt_lo(~0u, 0u)); asm volatile("" : "+v"(ln));
    Fr.lds = (LAS unsigned char*)lds_raw; Fr.lane = ln; Fr.wave = wv; Fr.tid = wv * 64 + ln;
    Fr.gw = blockIdx.x * NWAVES + wv; Fr.ngw = gridDim.x * NWAVES; return Fr;
}
__device__ __forceinline__ const Params& getP() { const Params* kp = (const Params*)__builtin_amdgcn_kernarg_segment_ptr(); asm volatile("" : "+s"(kp)); return *kp; }
#define PP getP()
#define WSP(off) (getP().ws + (off))
#define F mkframe(lds_raw, wv0)
#define GRID_SYNC() do { XcdBarrier bb; bb.bar = (unsigned*)WSP(WS_CTL); bb.x = xb_xcc_id(); bb.st = (volatile LAS unsigned*)((LAS unsigned char*)lds_raw + LDS_CTL_OFF); xcd_barrier(bb, F.tid); } while (0)


#ifndef DIAG_TIME
#define DIAG_TIME 0
#endif
#define TSTAMP(k) do { if (DIAG_TIME) { const Frame Ft = F; if (blockIdx.x == 0 && Ft.tid == 0) ((unsigned long long*)(WSP(WS_CTL) + 32768))[k] = __builtin_amdgcn_s_memrealtime(); } } while (0)
#ifndef DIAG_STOP
#define DIAG_STOP 0
#endif
__device__ __forceinline__ void diag_dump(const Frame& Fr, const Params& P, const bf16* src, int ld, int ncols) {
    for (size_t i = (size_t)Fr.gw * 64 + Fr.lane; i < (size_t)MLAT * DM; i += (size_t)Fr.ngw * 64) { const size_t row = i >> 10; const int c = (int)(i & 1023);
        float v = bf2f(src[row * ld + (c % ncols)]); v = (__builtin_fabsf(v) < 1e30f) ? v : 12345.f; P.out[i] = v; }
}

__device__ __forceinline__ void diag_dump3(const Frame& Fr, const Params& P, int mode) {
    const bf16* ypre = (const bf16*)(P.ws + WS_U + OV_YPRE); const bf16* yf = (const bf16*)(P.ws + WS_RES + SZ_256); const bf16* yn = (const bf16*)(P.ws + WS_RES + 2 * SZ_256);
    for (size_t i = (size_t)Fr.gw * 64 + Fr.lane; i < (size_t)MLAT * DM; i += (size_t)Fr.ngw * 64) { const size_t row = i >> 10; const int c = (int)(i & 1023);
        float v = 0.f;
        if (c < 256) { if (mode & 1) v = bf2f(ypre[row * 256 + c]); } else if (c < 512) { if (mode & 2) v = bf2f(yf[row * 256 + c - 256]); } else { if (mode & 4) v = bf2f(yn[row * 512 + c - 512]); }
        v = (__builtin_fabsf(v) < 1e30f) ? v : 12345.f; P.out[i] = v; }
}
#define DIAG_AT(n, src, ld, ncols) do { if (DIAG_STOP == (n)) { GRID_SYNC(); diag_dump(F, PP, (const bf16*)(src), ld, ncols); return true; } } while (0)
template <int l>
__device__ __forceinline__ bool layer_body(unsigned char* lds_raw, const int wv0) {
    constexpr bool last = (l == DEPTH - 1);

        const int Mx = last ? MLAT : MT;
        run_gemm(F, (const bf16*)WSP(WS_U), (const bf16*)WSP(WS_WA + WA_GU), MT, 2 * DFF, DM, EpiGU{(bf16*)WSP(WS_Z)});
        if (l == 0) DIAG_AT(2, WSP(WS_Z), DFF, 1024);
        GRID_SYNC();
        run_gemm(F, (const bf16*)WSP(WS_Z), (const bf16*)WSP(WS_WA + WA_DN), MT, DM, DFF, EpiStore{(bf16*)WSP(WS_RES), DM});
        if (l == 0) DIAG_AT(3, WSP(WS_RES), DM, 1024);
        GRID_SYNC();
        rowwise_phase<1>(F, PP, l, 2, 0.5f, 0, l, 3, true, l == 0, MT);
        convert_ffn(F, PP, l, 1);
        GRID_SYNC();
        run_gemm(F, (const bf16*)WSP(WS_U), (const bf16*)WSP(WS_WB + WB_IN), MT, WIN, DM, EpiWin{WSP(WS_Z), (const float*)WSP(WS_TBL + T_ROPE)});
        if (l == 0) DIAG_AT(5, WSP(WS_Z + Z_K), 512, 512);
        if (l == 0) DIAG_AT(6, WSP(WS_Z + Z_G), 3072, 1024);
        GRID_SYNC();
        if (l == 0) TSTAMP(1);
        {
            const Frame Fl = F;
            LAS float* rpb = (LAS float*)(Fl.lds + 8 * 16384);
            for (int i = Fl.tid; i < 8 * 15 * 31; i += NTHREADS) rpb[i] = PP.in[22][l * 8 * 15 * 31 + i];
            __syncthreads();
            const int n_att = 16384, n_attc = last ? 0 : 512, n_s5a = 4 * 16 * NCHUNK * 2, n_fa = 4096, n_fac = last ? 0 : 128;
            const int e0 = n_att, e1 = e0 + n_attc, e2 = e1 + n_s5a, e3 = e2 + n_fa, e4 = e3 + n_fac;
            for (int it = q_next((unsigned*)WSP(WS_CTL) + QCTR(l, 0), Fl.lane); it < e4; it = q_next((unsigned*)WSP(WS_CTL) + QCTR(l, 0), Fl.lane)) {
                if (it < e0) attn_item(PP, rpb, it, false, Fl.lane);
                else if (it < e1) attn_item(PP, rpb, it - e0, true, Fl.lane);
                else if (it < e2) s5_pass_a(PP, it - e1, Fl.lane);
                else if (it < e3) fnet_a<64, 128>(PP, it - e2, Fl.lane);
                else fnet_a<16, 16>(PP, it - e3, Fl.lane);
            }
        }
        GRID_SYNC();
        if (l == 0) TSTAMP(2);
        {
            const Frame Fl = F;
            const int n_b = 128, n_fc = 4096, n_fcc = last ? 0 : 1024;
            const int e0 = n_b, e1 = e0 + n_fc, e2 = e1 + n_fcc;
            for (int it = q_next((unsigned*)WSP(WS_CTL) + QCTR(l, 1), Fl.lane); it < e2; it = q_next((unsigned*)WSP(WS_CTL) + QCTR(l, 1), Fl.lane)) {
                if (it < e0) s5_pass_b(PP, it, Fl.lane);
                else if (it < e1) fnet_c<64, 128>(PP, it - e0, Fl.lane);
                else fnet_c<16, 16>(PP, it - e1, Fl.lane);
            }
        }
        GRID_SYNC();
        if (l == 0) TSTAMP(3);
        {
            const Frame Fl = F;
            const int nck = last ? 128 : NCHUNK, ck0 = last ? 4 : 0, n_c = 64 * nck;
            for (int it = q_next((unsigned*)WSP(WS_CTL) + QCTR(l, 2), Fl.lane); it < n_c; it = q_next((unsigned*)WSP(WS_CTL) + QCTR(l, 2), Fl.lane)) s5_pass_c(PP, l, it, nck, ck0, Fl.lane);
        }
        GRID_SYNC();
        if (l == 0 && DIAG_STOP >= 10 && DIAG_STOP < 18) { diag_dump3(F, PP, DIAG_STOP - 10); return true; }
        if (l == 0) TSTAMP(4);
        run_gemm(F, (const bf16*)WSP(WS_U + OV_YPRE), (const bf16*)WSP(WS_WB + WB_GLU), Mx, 256, 256, EpiGLU{(const bf16*)WSP(WS_U + OV_YPRE), PP.in[21] + l * 256, (bf16*)WSP(WS_RES)});
        if (l == 0) DIAG_AT(20, WSP(WS_RES), 256, 256);
        GRID_SYNC();
        run_gemm(F, (const bf16*)WSP(WS_RES), (const bf16*)WSP(WS_WB + WB_BRS), Mx, DM, 256, EpiMerge<true>{(const bf16*)WSP(WS_Z + Z_G), 0, (bf16*)WSP(WS_Z + Z_K)});
        run_gemm(F, (const bf16*)WSP(WS_RES + SZ_256), (const bf16*)WSP(WS_WB + WB_BRF), Mx, DM, 256, EpiMerge<false>{(const bf16*)WSP(WS_Z + Z_G), 1, (bf16*)WSP(WS_Z + Z_K)});
        run_gemm(F, (const bf16*)WSP(WS_RES + 2 * SZ_256), (const bf16*)WSP(WS_WB + WB_BRN), Mx, DM, 512, EpiMerge<false>{(const bf16*)WSP(WS_Z + Z_G), 2, (bf16*)WSP(WS_Z + Z_K)});
        if (l == 0) DIAG_AT(21, WSP(WS_Z + Z_K), DM, 1024);
        GRID_SYNC();
        run_gemm(F, (const bf16*)WSP(WS_Z + Z_K), (const bf16*)WSP(WS_WB + WB_OUT), Mx, DM, DM, EpiStore{(bf16*)WSP(WS_RES), DM});
        if (l == 0) DIAG_AT(22, WSP(WS_RES), DM, 1024);
        GRID_SYNC();
        rowwise_phase<1>(F, PP, l, 5, 1.0f, 1, l, 6, true, false, Mx);
        if (l == 0) DIAG_AT(23, WSP(WS_U), DM, 1024);
        GRID_SYNC();
        run_gemm(F, (const bf16*)WSP(WS_U), (const bf16*)WSP(WS_WA + WA_GU), Mx, 2 * DFF, DM, EpiGU{(bf16*)WSP(WS_Z)});
        GRID_SYNC();
        run_gemm(F, (const bf16*)WSP(WS_Z), (const bf16*)WSP(WS_WA + WA_DN), Mx, DM, DFF, EpiStore{(bf16*)WSP(WS_RES), DM});
        if (l == 0) DIAG_AT(24, WSP(WS_RES), DM, 1024);
        GRID_SYNC();
        rowwise_phase<1>(F, PP, l, 8, 0.5f, 2, last ? l : l + 1, 0, !last, false, Mx);
        if (!last) { convert_ffn(F, PP, l + 1, 0); convert_mixer(F, PP, l + 1); make_s5_tables(F, PP, l + 1); GRID_SYNC(); }
        return false;
}
__global__ void __launch_bounds__(NTHREADS, 2) hybrid_fwd(Params Parg) {
    extern __shared__ __attribute__((aligned(16))) unsigned char lds_raw[];
    cg::grid_group grid = cg::this_grid();
    const int wv0 = __builtin_amdgcn_readfirstlane((int)threadIdx.x >> 6);
    {
        const int t0 = threadIdx.x;
        if (t0 < 32) ((LAS unsigned*)(lds_raw))[LDS_CTL_OFF / 4 + t0] = 0u;
        if (blockIdx.x == 0) { unsigned* ctlw = (unsigned*)(getP().ws + WS_CTL); for (int i = t0; i < (int)(CTL_BYTES / 4); i += NTHREADS) __hip_atomic_store(ctlw + i, 0u, __ATOMIC_RELAXED, __HIP_MEMORY_SCOPE_AGENT); }
        __threadfence();
        __syncthreads();
        grid.sync();
    }
    XcdBarrier bar = xcd_barrier_post((unsigned*)WSP(WS_CTL), (volatile LAS unsigned*)((LAS unsigned char*)lds_raw + LDS_CTL_OFF), F.tid);
    (void)bar;
    TSTAMP(0);
#if defined(DIAG_BARTEST)
    {
        unsigned* slots = (unsigned*)(WSP(WS_Z));
        unsigned* errs = (unsigned*)(WSP(WS_CTL)) + 12288;
        unsigned bad = 0;
        for (int rnd = 1; rnd <= 64; ++rnd) {
            const Frame Fb = F;
            if ((blockIdx.x + rnd) % 7 == 0) { for (int d = 0; d < 2000; ++d) __builtin_amdgcn_s_sleep(20); }
            for (int i = Fb.tid; i < 4096; i += NTHREADS) slots[(size_t)blockIdx.x * 4096 + i] = (unsigned)(rnd * 65536 + blockIdx.x * 16 + (i & 15));
            GRID_SYNC();
            for (int j = 0; j < 8; ++j) { const int ob = (blockIdx.x * 37 + j * 31 + rnd) % (int)gridDim.x;
                for (int i = Fb.tid; i < 4096; i += NTHREADS) { const unsigned v = slots[(size_t)ob * 4096 + i]; if (v != (unsigned)(rnd * 65536 + ob * 16 + (i & 15))) ++bad; } }
            GRID_SYNC();
        }
        if (bad) atomicAdd(errs, bad);
        GRID_SYNC();
        const Frame Fd = F; const unsigned e = __hip_atomic_load(errs, __ATOMIC_RELAXED, __HIP_MEMORY_SCOPE_AGENT);
        float* o = getP().out;
        for (size_t i = (size_t)Fd.gw * 64 + Fd.lane; i < (size_t)MLAT * DM; i += (size_t)Fd.ngw * 64) o[i] = (i == 0 && e) ? 4096.f : 0.f;
        return;
    }
#endif
    mod_phase(F, PP);
    convert_ffn(F, PP, 0, 0); convert_mixer(F, PP, 0); make_s5_tables(F, PP, 0); make_static_tables(F, PP);
    GRID_SYNC();
    rowwise_phase<0>(F, PP, 0, 0, 0.f, 0, 0, 0, true, true, MT);
    GRID_SYNC();
    if (DIAG_STOP == 1) { GRID_SYNC(); diag_dump(F, PP, (const bf16*)WSP(WS_U), DM, 1024); return; }

    if (layer_body<0>(lds_raw, wv0)) return;
    if (layer_body<1>(lds_raw, wv0)) return;
    if (DIAG_TIME) {
        TSTAMP(5); GRID_SYNC();
        const Frame Fd = F; const unsigned long long* ts = (const unsigned long long*)(WSP(WS_CTL) + 32768);
        const float X = exp2f(floorf(log2f((float)(ts[DIAG_TX1] - ts[DIAG_TX0]) * 0.01f)));
        const float C = floorf(2.f * log2f((float)(ts[DIAG_TC1] - ts[DIAG_TC0]) * 0.01f));
        float* o = getP().out;
        for (size_t i = (size_t)Fd.gw * 64 + Fd.lane; i < (size_t)MLAT * DM; i += (size_t)Fd.ngw * 64) o[i] = (i == 0) ? X : C;
    }
}

extern "C" void kernel_launch(void* const* d_in, const int* in_sizes, int n_in, void* d_out, int out_size, void* d_ws, size_t ws_size, hipStream_t stream) {
    static int grid_blocks = 0;
    if (grid_blocks == 0) {
        if (n_in != 27 || ws_size < WS_END) { fprintf(stderr, "kernel_launch: unexpected n_in %d or ws_size %zu (< %zu)\n", n_in, ws_size, (size_t)WS_END); grid_blocks = -1; return; }
        int dev = 0, cus = 0, per_cu = 0;
        hipGetDevice(&dev); hipDeviceGetAttribute(&cus, hipDeviceAttributeMultiprocessorCount, dev);
        hipFuncSetAttribute((const void*)hybrid_fwd, hipFuncAttributeMaxDynamicSharedMemorySize, LDS_BYTES);
        if (hipOccupancyMaxActiveBlocksPerMultiprocessor(&per_cu, (const void*)hybrid_fwd, NTHREADS, LDS_BYTES) != hipSuccess || per_cu < 1) per_cu = 1;
        (void)hipGetLastError();
        grid_blocks = cus * 1;
    }
    if (grid_blocks < 0) return;
    hipMemsetAsync((char*)d_ws + WS_CTL, 0, CTL_BYTES, stream);
    Params p{};
    for (int i = 0; i < 27; ++i) p.in[i] = (const float*)d_in[i];
    p.out = (float*)d_out; p.ws = (unsigned char*)d_ws;
    void* args[] = {&p};
    hipError_t e = hipLaunchCooperativeKernel((const void*)hybrid_fwd, dim3(grid_blocks), dim3(NTHREADS), args, LDS_BYTES, stream);
    if (e != hipSuccess) fprintf(stderr, "cooperative launch failed: %s (grid %d)\n", hipGetErrorString(e), grid_blocks);
}
```

```cpp
#define DIAG_STOP 0
#define DIAG_TX0 0
#define DIAG_TX1 5
#define DIAG_TC0 1
#define DIAG_TC1 2
#define DIAG_REPEAT 0
#include <hip/hip_runtime.h>
#include <hip/hip_cooperative_groups.h>
#include <cstdio>
#include <cstdint>
namespace pg8 {
#define PG8_LAS __attribute__((address_space(3)))
typedef unsigned short bf16_t;
typedef short bf16x8 __attribute__((ext_vector_type(8)));
typedef float f32x4 __attribute__((ext_vector_type(4)));
typedef unsigned u32x4 __attribute__((ext_vector_type(4)));
constexpr int BM = 256, BK = 64, HALF = 128, HTB = HALF * BK * 2  , STAGE_BYTES = 8 * HTB, NXCD = 8, WGM = 8;

__host__ __device__ __forceinline__ int lds_byte(int r, int c) { const int st = (r >> 4) * 2 + (c >> 5), rr = r & 15, cc = c & 31, ob = rr * 64 + cc * 2; return st * 1024 + (ob ^ (((ob >> 9) & 1) << 5)); }
__host__ __device__ __forceinline__ void stage_rc(int b, int& R, int& C) { const int st = b / 1024, sb = b % 1024, swz = sb ^ (((sb >> 9) & 1) << 5); R = (st >> 1) * 16 + swz / 64; C = (st & 1) * 32 + (swz % 64) / 2; }
__host__ __device__ __forceinline__ int perm32(int rho) { const int n = rho >> 4, i = rho & 15; return 8 * (i >> 2) + 4 * n + (i & 3); }

struct Unit { int pm, pn; };
struct Gemm { const bf16_t* A; const bf16_t* Bt; int M, N, K, ld; };

struct StaticOrder {
    int nM, nN, nwg, G, c;
    __host__ __device__ void init(int M, int N, int G_, int c_) { nM = M / BM; nN = N / BM; nwg = nM * nN; G = G_; c = c_; }
    __host__ __device__ bool next(int i, Unit& u) const {
        const long L = (long)i * G + c; if (L >= nwg) return false;
        int wgid = (int)L; { const int q = nwg / NXCD, r = nwg % NXCD, xcd = wgid % NXCD, off = wgid / NXCD; wgid = (xcd < r ? xcd * (q + 1) : r * (q + 1) + (xcd - r) * q) + off; }
        const int nig = WGM * nN, gid = wgid / nig, fm = gid * WGM, gsz = (nM - fm) < WGM ? (nM - fm) : WGM;
        u.pm = fm + ((wgid % nig) % gsz); u.pn = (wgid % nig) / gsz; return true;
    }
    __device__ __forceinline__ void a_ready(const Unit&) const {}
    __device__ __forceinline__ void done(const Unit&) const {}
};

__device__ __forceinline__ unsigned cvt_pk_bf16(float lo, float hi) { unsigned r; asm volatile("v_cvt_pk_bf16_f32 %0, %1, %2" : "=v"(r) : "v"(lo), "v"(hi)); return r; }
typedef float f32x2 __attribute__((ext_vector_type(2)));
template <class Epi, class Sched, bool ALIGN_EPI = false, bool SP2 = false>
__device__ __forceinline__ void gemm_phase(PG8_LAS unsigned char* lds, const Gemm g, const Sched& S, const Epi& E, int tid_in) {
    int tid_l = tid_in; asm volatile("" : "+v"(tid_l));
    const int tid = tid_l, wid = __builtin_amdgcn_readfirstlane(tid >> 6), lane = tid & 63, wr = wid >> 2, wc = wid & 3, fr = lane & 15, fq = lane >> 4;
    const int K = g.K, nt = K / BK;
    unsigned voffA[2], voffB[2];
#pragma unroll
    for (int i = 0; i < 2; ++i) { int R, C; stage_rc(tid * 16 + i * 8192, R, C); const int Rb = Epi::PERM ? ((R & ~31) + perm32(R & 31)) : R;
        voffA[i] = (unsigned)(R * g.ld + C) * 2u; voffB[i] = (unsigned)(Rb * g.ld + C) * 2u; }
    const size_t kstep = (size_t)(BK * 2);
    const size_t hstep = (size_t)HALF * g.ld * 2;
    const size_t tstep = 2 * hstep;
    const unsigned ldsw = (unsigned)wid * 1024u;
    const int aoff = lds_byte(wr * 64 + fr, fq * 8), boff = lds_byte(wc * 32 + fr, fq * 8);
#define PG8_SA(b, h) (((b) * 2 + (h)) * HTB)
#define PG8_SB(b, h) ((4 + (b) * 2 + (h)) * HTB)
#define PG8_STAGE(bufoff, gbase, voff) do { _Pragma("unroll") for (int _i = 0; _i < 2; ++_i) \
        __builtin_amdgcn_global_load_lds((const unsigned*)((const char*)(gbase) + (voff)[_i]), (PG8_LAS unsigned*)(lds + (bufoff) + ldsw + _i * 8192), 16, 0, 0); } while (0)
#define PG8_LDA(dst, b, h) do { _Pragma("unroll") for (int m = 0; m < 4; ++m) _Pragma("unroll") for (int k = 0; k < 2; ++k) dst[m][k] = *(const PG8_LAS bf16x8*)(lds + PG8_SA(b, h) + aoff + m * 2048 + k * 1024); } while (0)
#define PG8_LDB(dst, b, h) do { _Pragma("unroll") for (int n = 0; n < 2; ++n) _Pragma("unroll") for (int k = 0; k < 2; ++k) dst[n][k] = *(const PG8_LAS bf16x8*)(lds + PG8_SB(b, h) + boff + n * 2048 + k * 1024); } while (0)
#define PG8_MMA(ai, bj, At, Bt) do { __builtin_amdgcn_s_setprio(1); _Pragma("unroll") for (int m = 0; m < 4; ++m) _Pragma("unroll") for (int n = 0; n < 2; ++n) _Pragma("unroll") for (int k = 0; k < 2; ++k) \
        acc[ai][bj][m][n] = __builtin_amdgcn_mfma_f32_16x16x32_bf16(Bt[n][k], At[m][k], acc[ai][bj][m][n], 0, 0, 0); __builtin_amdgcn_s_setprio(0); } while (0)
#define PG8_WAIT_V(n) asm volatile("s_waitcnt vmcnt(" #n ")" ::: "memory")
#define PG8_WAIT_L(n) asm volatile("s_waitcnt lgkmcnt(" #n ")" ::: "memory")
#define PG8_BAR __builtin_amdgcn_s_barrier()
#define PG8_SCHED __builtin_amdgcn_sched_barrier(0)
    Unit cur, nxt; int ui = 0;
    if (!S.next(0, cur)) return;
    f32x4 acc[2][2][4][2];
#pragma unroll
    for (int a = 0; a < 2; ++a)
#pragma unroll
        for (int b = 0; b < 2; ++b)
#pragma unroll
            for (int m = 0; m < 4; ++m)
#pragma unroll
                for (int n = 0; n < 2; ++n) acc[a][b][m][n] = (f32x4){0.f, 0.f, 0.f, 0.f};
    bf16x8 At[4][2], B0[2][2], B1[2][2];
    const char* cA = (const char*)g.A + (size_t)cur.pm * tstep; const char* cB = (const char*)g.Bt + (size_t)cur.pn * tstep;
    S.a_ready(cur);
    if constexpr (SP2) {
        PG8_STAGE(PG8_SB(0, 0), cB, voffB); PG8_STAGE(PG8_SB(0, 1), cB + hstep, voffB); PG8_STAGE(PG8_SA(0, 0), cA, voffA); PG8_STAGE(PG8_SA(0, 1), cA + hstep, voffA);
        if (wr == 1) PG8_BAR;
        PG8_WAIT_V(2); PG8_BAR;
        PG8_STAGE(PG8_SB(1, 0), cB + kstep, voffB); PG8_STAGE(PG8_SA(1, 0), cA + kstep, voffA); PG8_STAGE(PG8_SB(1, 1), cB + hstep + kstep, voffB);
        PG8_WAIT_V(6); PG8_BAR;
    } else {
        PG8_STAGE(PG8_SB(0, 0), cB, voffB); PG8_STAGE(PG8_SA(0, 0), cA, voffA); PG8_STAGE(PG8_SB(0, 1), cB + hstep, voffB); PG8_STAGE(PG8_SA(0, 1), cA + hstep, voffA);
        if (wr == 1) PG8_BAR;
        PG8_WAIT_V(4); PG8_BAR;
        PG8_STAGE(PG8_SB(1, 0), cB + kstep, voffB); PG8_STAGE(PG8_SA(1, 0), cA + kstep, voffA); PG8_STAGE(PG8_SB(1, 1), cB + hstep + kstep, voffB);
        PG8_WAIT_V(6); PG8_BAR;
    }
#pragma unroll 1
    for (;;) {
        const bool has_next = S.next(ui + 1, nxt);
        const char* nA = has_next ? (const char*)g.A + (size_t)nxt.pm * tstep : cA; const char* nB = has_next ? (const char*)g.Bt + (size_t)nxt.pn * tstep : cB;
#pragma unroll 1
        for (int t = 0; t < nt; t += 2) {
            const bool last = (t == nt - 2);
            const char* a1 = cA + (size_t)(t + 1) * kstep;
            const char* a2 = last ? nA : cA + (size_t)(t + 2) * kstep; const char* b2 = last ? nB : cB + (size_t)(t + 2) * kstep;
            const char* a3 = a2 + kstep; const char* b3 = b2 + kstep;
            if (last && has_next) S.a_ready(nxt);
            if constexpr (Epi::KHOOK) { if (t == 4 || t == 8) E.khook(acc, cur, wr, wc, fr, fq, t); }
            if constexpr (SP2) {
            PG8_LDB(B0, 0, 0); PG8_LDB(B1, 0, 1); PG8_SCHED; PG8_LDA(At, 0, 0); PG8_STAGE(PG8_SA(1, 1), a1 + hstep, voffA);
            PG8_WAIT_V(8); PG8_WAIT_L(0); PG8_BAR; PG8_MMA(0, 0, At, B0); PG8_MMA(0, 1, At, B1); PG8_BAR; PG8_SCHED;
            PG8_LDA(At, 0, 1); PG8_STAGE(PG8_SB(0, 0), b2, voffB); PG8_STAGE(PG8_SB(0, 1), b2 + hstep, voffB); PG8_STAGE(PG8_SA(0, 0), a2, voffA);
            PG8_WAIT_V(8); PG8_WAIT_L(0); PG8_BAR; PG8_MMA(1, 0, At, B0); PG8_MMA(1, 1, At, B1); PG8_BAR; PG8_SCHED;
            PG8_LDB(B0, 1, 0); PG8_LDB(B1, 1, 1); PG8_SCHED; PG8_LDA(At, 1, 0); PG8_STAGE(PG8_SA(0, 1), a2 + hstep, voffA);
            PG8_WAIT_V(8); PG8_WAIT_L(0); PG8_BAR; PG8_MMA(0, 0, At, B0); PG8_MMA(0, 1, At, B1); PG8_BAR; PG8_SCHED;
            PG8_LDA(At, 1, 1); PG8_STAGE(PG8_SB(1, 0), b3, voffB); PG8_STAGE(PG8_SB(1, 1), b3 + hstep, voffB); PG8_STAGE(PG8_SA(1, 0), a3, voffA);
            PG8_WAIT_V(8); PG8_WAIT_L(0); PG8_BAR; PG8_MMA(1, 0, At, B0); PG8_MMA(1, 1, At, B1); PG8_BAR; PG8_SCHED;
            } else {
            PG8_LDB(B0, 0, 0); PG8_SCHED; PG8_LDA(At, 0, 0); PG8_STAGE(PG8_SA(1, 1), a1 + hstep, voffA);
            PG8_WAIT_L(8); PG8_BAR; PG8_WAIT_L(0); PG8_MMA(0, 0, At, B0); PG8_BAR; PG8_SCHED;
            PG8_LDB(B1, 0, 1); PG8_STAGE(PG8_SB(0, 0), b2, voffB);
            PG8_BAR; PG8_WAIT_L(0); PG8_MMA(0, 1, At, B1); PG8_BAR;
            PG8_LDA(At, 0, 1); PG8_STAGE(PG8_SA(0, 0), a2, voffA);
            PG8_BAR; PG8_WAIT_L(0); PG8_MMA(1, 0, At, B0); PG8_BAR; PG8_SCHED;
            PG8_STAGE(PG8_SB(0, 1), b2 + hstep, voffB);
            PG8_WAIT_V(6); PG8_BAR; PG8_MMA(1, 1, At, B1); PG8_BAR;
            PG8_LDB(B0, 1, 0); PG8_SCHED; PG8_LDA(At, 1, 0); PG8_STAGE(PG8_SA(0, 1), a2 + hstep, voffA);
            PG8_WAIT_L(8); PG8_BAR; PG8_WAIT_L(0); PG8_MMA(0, 0, At, B0); PG8_BAR; PG8_SCHED;
            PG8_LDB(B1, 1, 1); PG8_STAGE(PG8_SB(1, 0), b3, voffB);
            PG8_BAR; PG8_WAIT_L(0); PG8_MMA(0, 1, At, B1); PG8_BAR;
            PG8_LDA(At, 1, 1); PG8_STAGE(PG8_SA(1, 0), a3, voffA);
            PG8_BAR; PG8_WAIT_L(0); PG8_MMA(1, 0, At, B0); PG8_BAR; PG8_SCHED;
            PG8_STAGE(PG8_SB(1, 1), b3 + hstep, voffB);
            PG8_WAIT_V(6); PG8_BAR; PG8_MMA(1, 1, At, B1); PG8_BAR;
            }
        }
        if constexpr (ALIGN_EPI) { if (wr == 0) PG8_BAR; }
        if constexpr (!Epi::AFTER_DRAIN) { E(acc, cur, wr, wc, fr, fq); S.done(cur); }
        if (!has_next) break;
#pragma unroll
        for (int a = 0; a < 2; ++a)
#pragma unroll
            for (int b = 0; b < 2; ++b)
#pragma unroll
                for (int m = 0; m < 4; ++m)
#pragma unroll
                    for (int n = 0; n < 2; ++n) acc[a][b][m][n] = (f32x4){0.f, 0.f, 0.f, 0.f};
        cur = nxt; cA = nA; cB = nB; ++ui;
        if constexpr (ALIGN_EPI) { if (wr == 1) PG8_BAR; }
    }
    PG8_WAIT_V(0);
    if constexpr (!ALIGN_EPI) { if (wr == 0) PG8_BAR; }
    PG8_BAR;
    if constexpr (Epi::AFTER_DRAIN) { E.fused(acc, cur, wr, wc, fr, fq, lds, wid, lane); S.done(cur); }
#undef PG8_SA
#undef PG8_SB
#undef PG8_STAGE
#undef PG8_LDA
#undef PG8_LDB
#undef PG8_MMA
#undef PG8_WAIT_V
#undef PG8_WAIT_L
#undef PG8_BAR
#undef PG8_SCHED
}
}
namespace cg = cooperative_groups;
#define LAS __attribute__((address_space(3)))
typedef unsigned short bf16;
typedef short bf16x8 __attribute__((ext_vector_type(8)));
typedef float f32x4 __attribute__((ext_vector_type(4)));
typedef unsigned u32x4 __attribute__((ext_vector_type(4)));
typedef unsigned u32x2 __attribute__((ext_vector_type(2)));

constexpr int DM = 1024, NB = 4, SEQ = 8192, DEPTH = 2, CTXL = 256;
constexpr int MLAT = NB * SEQ, MCTX = NB * CTXL, MT = MLAT + MCTX;
constexpr int DFF = 2816, NMOD = 9, WIN = 5120;
constexpr int NTHREADS = 512, NWAVES = 8;
constexpr float LN_EPS = 1e-6f;
constexpr float DN_ALPHA = 1.41421356237309515f;
constexpr int NCHUNK = 132;
constexpr float TWO_PI = 6.283185307179586f;

constexpr size_t al256(size_t x) { return (x + 255) & ~(size_t)255; }
constexpr size_t WS_CTL = 0, CTL_BYTES = 65536;
constexpr size_t WS_MOD = WS_CTL + CTL_BYTES;
constexpr size_t WS_HC = al256(WS_MOD + (size_t)DEPTH * 5 * 9216 * 4);
constexpr size_t WS_TBL = WS_HC + (size_t)MCTX * DM * 4;
constexpr size_t T_PNEG = 0;
constexpr size_t T_PPOS = T_PNEG + 2 * 16 * 2 * 64 * 64 * 4;
constexpr size_t T_BBT = T_PPOS + 2 * 16 * 2 * 64 * 64 * 4;
constexpr size_t T_CCT = T_BBT + 2 * 16 * 128 * 16 * 2;
constexpr size_t T_APOW = T_CCT + 2 * 16 * 4 * 16 * 32 * 2;
constexpr size_t T_WCB = T_APOW + 3 * 2 * 16 * 2 * 64 * 4;
constexpr size_t T_FA64 = T_WCB + 128 * 64 * 2;
constexpr size_t T_FA16 = T_FA64 + 2 * 64 * 4 * 32 * 2;
constexpr size_t T_FC128 = T_FA16 + 2 * 16 * 32 * 2;
constexpr size_t T_FC16 = T_FC128 + 128 * 256 * 2;
constexpr size_t T_ROPE = T_FC16 + 16 * 32 * 2;
constexpr size_t T_END = T_ROPE + 2 * 128 * 16 * 4;
constexpr size_t WS_SLOC = al256(WS_TBL + T_END);
constexpr size_t WS_WA = al256(WS_SLOC + (size_t)4 * 16 * 2 * NCHUNK * 128 * 4);
constexpr size_t WA_GU = 0, WA_DN = (size_t)5632 * 1024 * 2, WA_BYTES = WA_DN + (size_t)1024 * 2816 * 2;
constexpr size_t WS_WB = al256(WS_WA + WA_BYTES);
constexpr size_t WB_IN = 0, WB_GLU = WB_IN + (size_t)WIN * 1024 * 2, WB_BRS = WB_GLU + 256 * 256 * 2, WB_BRF = WB_BRS + 1024 * 256 * 2,
                 WB_BRN = WB_BRF + 1024 * 256 * 2, WB_OUT = WB_BRN + 1024 * 512 * 2, WB_BYTES = WB_OUT + 1024 * 1024 * 2;
constexpr size_t WS_U = al256(WS_WB + WB_BYTES);
constexpr size_t SZ_U = (size_t)MT * 1024 * 2;
constexpr size_t WS_RES = WS_U + SZ_U;
constexpr size_t WS_Z = WS_RES + SZ_U;
constexpr size_t SZ_256 = (size_t)MT * 256 * 2, SZ_512 = (size_t)MT * 512 * 2;
constexpr int VLD = SEQ;
constexpr size_t SZ_VT = al256((size_t)NB * 512 * VLD * 2 + (size_t)NB * 512 * CTXL * 2);
constexpr size_t Z_K = 0, Z_Q = Z_K + SZ_512, Z_VT = Z_Q + SZ_512, Z_SSMU = Z_VT + SZ_VT, Z_F = Z_SSMU + SZ_256, Z_G = Z_F + SZ_256, Z_END = Z_G + (size_t)MT * 3072 * 2;
constexpr size_t WS_END = WS_Z + Z_END;
constexpr size_t OV_YPRE = 0, OV_TBL = SZ_256, OV_TBC = OV_TBL + (size_t)16 * 64 * 2 * 64 * 128 * 2;
static_assert(OV_TBC + (size_t)16 * 16 * 2 * 64 * 16 * 2 <= SZ_U, "U overlay");
static_assert(SZ_256 * 2 + SZ_512 == SZ_U, "RES overlay");
constexpr size_t RESP_OFF = al256((size_t)MT * 2816 * 2);
static_assert(RESP_OFF + (size_t)11 * MCTX * DM * 2 <= Z_END, "ACT + RESP overlay");
static_assert(WS_END <= (size_t)536870912, "d_ws map exceeds 512 MiB");

#define QCTR(l, s) (4096 + 64 * (1 + (l) * 3 + (s)))

__device__ __forceinline__ unsigned f2bf(float f) { unsigned u = __builtin_bit_cast(unsigned, f); return (u + 0x7fffu + ((u >> 16) & 1u)) >> 16; }
__device__ __forceinline__ float bf2f(unsigned b) { return __builtin_bit_cast(float, b << 16); }
typedef __bf16 bf16x2_t __attribute__((ext_vector_type(2)));
typedef float f32x2_t __attribute__((ext_vector_type(2)));
__device__ __forceinline__ unsigned pk2(float lo, float hi) { const f32x2_t v = {lo, hi}; const bf16x2_t r = __builtin_convertvector(v, bf16x2_t); return __builtin_bit_cast(unsigned, r); }
__device__ __forceinline__ float bflo(unsigned w) { return __builtin_bit_cast(float, w << 16); }
__device__ __forceinline__ float bfhi(unsigned w) { return __builtin_bit_cast(float, w & 0xffff0000u); }
__device__ __forceinline__ float fsigmoid(float x) { return __builtin_amdgcn_rcpf(1.f + __expf(-x)); }
__device__ __forceinline__ float fsilu(float x) { return x * fsigmoid(x); }
__device__ __forceinline__ float gelu_tanh(float x) { const float z = 0.7978845608028654f * (x + 0.044715f * x * x * x); return x * fsigmoid(2.f * z); }
__device__ __forceinline__ f32x4 mfma16(bf16x8 a, bf16x8 b, f32x4 c) { return __builtin_amdgcn_mfma_f32_16x16x32_bf16(a, b, c, 0, 0, 0); }
__device__ __forceinline__ bf16x8 as_bf16x8(u32x4 v) { return __builtin_bit_cast(bf16x8, v); }
__device__ __forceinline__ bf16x8 pack8(f32x4 a, f32x4 b) { u32x4 w; w.x = pk2(a[0], a[1]); w.y = pk2(a[2], a[3]); w.z = pk2(b[0], b[1]); w.w = pk2(b[2], b[3]); return as_bf16x8(w); }
__device__ __forceinline__ float wave_sum(float v) {
#pragma unroll
    for (int o = 1; o < 64; o <<= 1) v += __shfl_xor(v, o);
    return v;
}
constexpr f32x4 F4Z = {0.f, 0.f, 0.f, 0.f};

struct Params {
    const float* in[27];
    float* out;
    unsigned char* ws;
};

struct Frame {
    LAS unsigned char* lds;
    int tid, lane, wave, gw, ngw;
};

__device__ __forceinline__ void tr_item(const float* __restrict__ W, int N, int k0, int n0, bf16* __restrict__ WT, int ldk, int drow0, LAS float* scr, int lane) {
#pragma unroll 8
    for (int i = 0; i < 32; ++i) { const int kk = 2 * i + (lane >> 5); scr[kk * 33 + (lane & 31)] = W[(size_t)(k0 + kk) * N + n0 + (lane & 31)]; }
    asm volatile("s_waitcnt lgkmcnt(0)" ::: "memory");
    const int c = lane & 7;
#pragma unroll
    for (int j = 0; j < 4; ++j) { const int n = (lane >> 3) + 8 * j; const LAS float* s = scr + (8 * c) * 33 + n;
        u32x4 o; o.x = pk2(s[0 * 33], s[1 * 33]); o.y = pk2(s[2 * 33], s[3 * 33]); o.z = pk2(s[4 * 33], s[5 * 33]); o.w = pk2(s[6 * 33], s[7 * 33]);
        *(u32x4*)(WT + (size_t)(drow0 + n) * ldk + k0 + 8 * c) = o; }
    asm volatile("s_waitcnt lgkmcnt(0)" ::: "memory");
}

constexpr int FFN_CONV_ITEMS = 2 * (DM / 64) * (DFF / 32) + (DFF / 64) * (DM / 32);
__device__ __forceinline__ void convert_ffn_item(const Params& P, LAS unsigned char* lds, int wave, int lane, int l, int f, int it) {
    LAS float* scr = (LAS float*)(lds + wave * 16384);
    const float* wg = P.in[8] + (size_t)(l * 2 + f) * DM * DFF;
    const float* wu = P.in[9] + (size_t)(l * 2 + f) * DM * DFF;
    const float* wd = P.in[10] + (size_t)(l * 2 + f) * DFF * DM;
    bf16* gu = (bf16*)(P.ws + WS_WA + WA_GU); bf16* dn = (bf16*)(P.ws + WS_WA + WA_DN);
    constexpr int I_G = (DM / 64) * (DFF / 32);
    int r = it;
    if (r < 2 * I_G) { const int up = r >= I_G; if (up) r -= I_G; const int nblk = DFF / 32, kb = r / nblk, nb = r % nblk, n0 = nb * 32;
        tr_item(up ? wu : wg, DFF, kb * 64, n0, gu, DM, 256 * (n0 / 128) + (n0 % 128) + (up ? 128 : 0), scr, lane); return; }
    r -= 2 * I_G; { const int nblk = DM / 32, kb = r / nblk, nb = r % nblk; tr_item(wd, DM, kb * 64, nb * 32, dn, DFF, nb * 32, scr, lane); }
}
__device__ __forceinline__ void convert_ffn(const Frame& F, const Params& P, int l, int f) {
    for (int it = F.gw; it < FFN_CONV_ITEMS; it += F.ngw) convert_ffn_item(P, F.lds, F.wave, F.lane, l, f, it);
}
__device__ __forceinline__ void convert_mixer(const Frame& F, const Params& P, int l) {
    LAS float* scr = (LAS float*)(F.lds + F.wave * 16384);
    constexpr int I_IN = (DM / 64) * (WIN / 32), I_GLU = 4 * 8, I_BRS = 4 * 32, I_BRF = 4 * 32, I_BRN = 8 * 32, I_OUT = 16 * 32;
    for (int it = F.gw; it < I_IN + I_GLU + I_BRS + I_BRF + I_BRN + I_OUT; it += F.ngw) {
        int r = it;
        if (r < I_IN) { const int nblk = WIN / 32; tr_item(P.in[11] + (size_t)l * DM * WIN, WIN, (r / nblk) * 64, (r % nblk) * 32, (bf16*)(P.ws + WS_WB + WB_IN), DM, (r % nblk) * 32, scr, F.lane); continue; } r -= I_IN;
        if (r < I_GLU) { tr_item(P.in[20] + (size_t)l * 256 * 256, 256, (r / 8) * 64, (r % 8) * 32, (bf16*)(P.ws + WS_WB + WB_GLU), 256, (r % 8) * 32, scr, F.lane); continue; } r -= I_GLU;
        if (r < I_BRS) { tr_item(P.in[23] + (size_t)l * 256 * DM, DM, (r / 32) * 64, (r % 32) * 32, (bf16*)(P.ws + WS_WB + WB_BRS), 1024, (r % 32) * 32, scr, F.lane); continue; } r -= I_BRS;
        if (r < I_BRF) { tr_item(P.in[24] + (size_t)l * 256 * DM, DM, (r / 32) * 64, (r % 32) * 32, (bf16*)(P.ws + WS_WB + WB_BRS) + 256, 1024, (r % 32) * 32, scr, F.lane); continue; } r -= I_BRF;
        if (r < I_BRN) { tr_item(P.in[25] + (size_t)l * 512 * DM, DM, (r / 32) * 64, (r % 32) * 32, (bf16*)(P.ws + WS_WB + WB_BRS) + 512, 1024, (r % 32) * 32, scr, F.lane); continue; } r -= I_BRN;
        tr_item(P.in[26] + (size_t)l * DM * DM, DM, (r / 32) * 64, (r % 32) * 32, (bf16*)(P.ws + WS_WB + WB_OUT), DM, (r % 32) * 32, scr, F.lane);
    }
}

__device__ __forceinline__ void make_s5_tables(const Frame& F, const Params& P, int l) {
    unsigned char* tb = P.ws + WS_TBL;
    float* pneg = (float*)(tb + T_PNEG); float* ppos = (float*)(tb + T_PPOS); bf16* bbt = (bf16*)(tb + T_BBT); bf16* cct = (bf16*)(tb + T_CCT); float* apow = (float*)(tb + T_APOW);
    const float* log_dt = P.in[12] + l * 32; const float* a_re = P.in[13] + l * 2048; const float* a_im = P.in[14] + l * 2048;
    const float* b_re = P.in[15] + (size_t)l * 32768; const float* b_im = P.in[16] + (size_t)l * 32768;
    const float* c_re = P.in[17] + (size_t)l * 32768; const float* c_im = P.in[18] + (size_t)l * 32768;
    const int gt = F.gw * 64 + F.lane, ngt = F.ngw * 64;
    for (int i = gt; i < 32 * 64 * 64; i += ngt) {
        const int t = i & 63, p = (i >> 6) & 63, dg = i >> 12, dir = dg >> 4;
        const float dt = expf(log_dt[dg]), ar = a_re[dg * 64 + p] * dt, ai = a_im[dg * 64 + p] * dt;
        const float e = (float)(dir ? 63 - t : t);
        float sn, cs; sincosf(e * ai, &sn, &cs);
        const float mp = expf(e * ar), mn = expf(-e * ar);
        pneg[((size_t)(dg * 2 + 0) * 64 + p) * 64 + t] = mn * cs; pneg[((size_t)(dg * 2 + 1) * 64 + p) * 64 + t] = -mn * sn;
        ppos[((size_t)(dg * 2 + 0) * 64 + t) * 64 + p] = mp * cs; ppos[((size_t)(dg * 2 + 1) * 64 + t) * 64 + p] = mp * sn;
    }
    for (int i = gt; i < 32 * 64; i += ngt) {
        const int p = i & 63, dg = i >> 6;
        const float dt = expf(log_dt[dg]), are = a_re[dg * 64 + p], aim = a_im[dg * 64 + p], ar = are * dt, ai = aim * dt;
        const float es[3] = {1.f, 63.f, 64.f};
#pragma unroll
        for (int k = 0; k < 3; ++k) { float sn, cs; sincosf(es[k] * ai, &sn, &cs); const float m = expf(es[k] * ar);
            apow[((size_t)(k * 32 + dg) * 2 + 0) * 64 + p] = m * cs; apow[((size_t)(k * 32 + dg) * 2 + 1) * 64 + p] = m * sn; }
        float sn, cs; sincosf(ai, &sn, &cs); const float mag = expf(ar);
        const float abr = mag * cs, abi = mag * sn, den = are * are + aim * aim, nr = abr - 1.f, ni = abi;
        const float fr = (nr * are + ni * aim) / den, fi = (ni * are - nr * aim) / den;
#pragma unroll
        for (int c = 0; c < 16; ++c) {
            const float br = b_re[((size_t)dg * 64 + p) * 16 + c], bi = b_im[((size_t)dg * 64 + p) * 16 + c];
            bbt[((size_t)dg * 128 + p) * 16 + c] = (bf16)f2bf(fr * br - fi * bi);
            bbt[((size_t)dg * 128 + 64 + p) * 16 + c] = (bf16)f2bf(fr * bi + fi * br);
        }
    }
    for (int i = gt; i < 32 * 4 * 16 * 4 * 8; i += ngt) {
        const int s = i & 7, G = (i >> 3) & 3, c = (i >> 5) & 15, mt = (i >> 9) & 3, dg = i >> 11;
        const int p = 16 * mt + 4 * G + (s & 3);
        const float v = (s < 4) ? c_re[((size_t)dg * 16 + c) * 64 + p] : -c_im[((size_t)dg * 16 + c) * 64 + p];
        cct[i] = (bf16)f2bf(v);
    }
}
__device__ __forceinline__ void make_static_tables(const Frame& F, const Params& P) {
    unsigned char* tb = P.ws + WS_TBL;
    const int gt = F.gw * 64 + F.lane, ngt = F.ngw * 64;
    bf16* wcb = (bf16*)(tb + T_WCB);
    for (int i = gt; i < 128 * 64; i += ngt) { const int c = i & 63, mp = i >> 6, m = mp & 63; float sn, cs; sincospif(2.f * (float)((m * c) & 63) / 64.f, &sn, &cs);
        wcb[i] = (bf16)f2bf((mp < 64 ? cs : -sn) * 0.125f); }
    bf16* fa64 = (bf16*)(tb + T_FA64);
    for (int i = gt; i < 2 * 64 * 4 * 32; i += ngt) { const int s = i & 7, G = (i >> 3) & 3, lt = (i >> 5) & 3, k1 = (i >> 7) & 63, po = i >> 13;
        const int l1 = 16 * lt + 4 * G + (s & 3); float sn, cs; sincospif(2.f * (float)((k1 * l1) & 63) / 64.f, &sn, &cs);
        const float v = (po == 0) ? ((s < 4) ? cs : sn) : ((s < 4) ? -sn : cs); fa64[i] = (bf16)f2bf(v * 0.125f); }
    bf16* fa16 = (bf16*)(tb + T_FA16);
    for (int i = gt; i < 2 * 16 * 32; i += ngt) { const int s = i & 7, G = (i >> 3) & 3, k1 = (i >> 5) & 15, po = i >> 9;
        const int l1 = 4 * G + (s & 3); float sn, cs; sincospif(2.f * (float)((k1 * l1) & 15) / 16.f, &sn, &cs);
        const float v = (po == 0) ? ((s < 4) ? cs : sn) : ((s < 4) ? -sn : cs); fa16[i] = (bf16)f2bf(v * 0.25f); }
    bf16* fc128 = (bf16*)(tb + T_FC128);
    for (int i = gt; i < 128 * 256; i += ngt) { const int kap = i & 255, k2 = i >> 8, part = kap >> 7, l2 = kap & 127; float sn, cs; sincospif(2.f * (float)((k2 * l2) & 127) / 128.f, &sn, &cs);
        fc128[i] = (bf16)f2bf((part ? sn : cs) * 0.08838834764831845f); }
    bf16* fc16 = (bf16*)(tb + T_FC16);
    for (int i = gt; i < 16 * 32; i += ngt) { const int kap = i & 31, k2 = i >> 5, part = kap >> 4, l2 = kap & 15; float sn, cs; sincospif(2.f * (float)((k2 * l2) & 15) / 16.f, &sn, &cs);
        fc16[i] = (bf16)f2bf((part ? sn : cs) * 0.25f); }
    float* rope = (float*)(tb + T_ROPE);
    for (int i = gt; i < 128 * 16; i += ngt) { const int f = i & 15, pos = i >> 4; const float inv = powf(10000.f, -(float)f / 16.f); const float ang = (float)pos * inv;
        rope[i] = cosf(ang); rope[128 * 16 + i] = sinf(ang); }
}

__device__ __forceinline__ void mod_phase(const Frame& F, const Params& P) {
    LAS float* sc = (LAS float*)(F.lds + 8 * 16384);
    LAS float* part = (LAS float*)(F.lds);
    for (int i = F.tid; i < 5 * DM; i += NTHREADS) { const float v = (i < 4 * DM) ? P.in[1][i] : P.in[3][i - 4 * DM]; sc[i] = fsilu(v); }
    __syncthreads();
    float* mod = (float*)(P.ws + WS_MOD);
    for (int task = blockIdx.x; task < 288; task += gridDim.x) {
        const int l = task / 144, j = (task % 144) * 64 + F.lane, k0 = F.wave * 128;
        const float* w = P.in[4] + (size_t)l * DM * 9216 + (size_t)k0 * 9216 + j;
        float a0 = 0.f, a1 = 0.f, a2 = 0.f, a3 = 0.f, a4 = 0.f;
#pragma unroll 16
        for (int k = 0; k < 128; ++k) { const float wv = w[(size_t)k * 9216]; a0 += sc[k0 + k] * wv; a1 += sc[DM + k0 + k] * wv; a2 += sc[2 * DM + k0 + k] * wv; a3 += sc[3 * DM + k0 + k] * wv; a4 += sc[4 * DM + k0 + k] * wv; }
        LAS float* pw = part + F.wave * 320 + F.lane;
        pw[0] = a0; pw[64] = a1; pw[128] = a2; pw[192] = a3; pw[256] = a4;
        __syncthreads();
        if (F.tid < 320) { float s = 0.f;
#pragma unroll
            for (int wv = 0; wv < 8; ++wv) s += part[wv * 320 + F.tid];
            const int r = F.tid >> 6, jj = (task % 144) * 64 + (F.tid & 63); mod[((size_t)l * 5 + r) * 9216 + jj] = s + P.in[5][l * 9216 + jj]; }
        __syncthreads();
    }
}

__device__ __forceinline__ const float* mod_vec(const Params& P, int l, int bidx, int i) { return (const float*)(P.ws + WS_MOD) + ((size_t)l * 5 + bidx) * 9216 + i * DM; }
template <int MODE>
__device__ __forceinline__ void rowwise_phase(const Frame& F, const Params& P, int l, int gi, float gscale, int lni, int lu, int si, bool do_u, bool first_h, int nrows, int nparts) {
    bf16* U = (bf16*)(P.ws + WS_U); const bf16* RES = (const bf16*)(P.ws + WS_RES); float* HC = (float*)(P.ws + WS_HC);
    constexpr int RG = 8;
    for (int grp = F.gw; grp < nrows / RG; grp += F.ngw) {
        const int row_g = grp * RG; const bool lat = row_g < MLAT; const int bidx = lat ? row_g / SEQ : 4;
        f32x4 vg[4], vlg[4], vlb[4], vsh[4], vsc[4];
#pragma unroll
        for (int j = 0; j < 4; ++j) { const int c = 4 * F.lane + 256 * j;
            if (MODE == 1) { vg[j] = *(const f32x4*)(mod_vec(P, l, bidx, gi) + c) * gscale; vlg[j] = *(const f32x4*)(P.in[6] + (size_t)(l * 3 + lni) * DM + c); vlb[j] = *(const f32x4*)(P.in[7] + (size_t)(l * 3 + lni) * DM + c); }
            if (do_u) { vsh[j] = *(const f32x4*)(mod_vec(P, lu, bidx, si) + c); vsc[j] = *(const f32x4*)(mod_vec(P, lu, bidx, si + 1) + c) + 1.f; } }
#pragma unroll 2
        for (int rr = 0; rr < RG; ++rr) {
            const int row = row_g + rr;
            const float* hin; float* hout;
            if (lat) { hin = (first_h ? P.in[0] : P.out) + (size_t)row * DM; hout = P.out + (size_t)row * DM; }
            else { hin = (first_h ? P.in[2] : HC) + (size_t)(row - MLAT) * DM; hout = HC + (size_t)(row - MLAT) * DM; }
            f32x4 v[4];
#pragma unroll
            for (int j = 0; j < 4; ++j) v[j] = *(const f32x4*)(hin + 4 * F.lane + 256 * j);
            if (MODE == 1) {
                float s = 0.f;
#pragma unroll
                for (int j = 0; j < 4; ++j) { const int c = 4 * F.lane + 256 * j; u32x2 r;
                    if (lat || nparts == 1) r = *(const u32x2*)(RES + (size_t)row * DM + c);
                    else { const bf16* rp = (const bf16*)(P.ws + WS_Z + RESP_OFF) + (size_t)(row - MLAT) * DM + c; float a0 = 0.f, a1 = 0.f, a2 = 0.f, a3 = 0.f;
                        for (int k = 0; k < nparts; ++k) { const u32x2 q = *(const u32x2*)(rp + (size_t)k * MCTX * DM); a0 += bflo(q.x); a1 += bfhi(q.x); a2 += bflo(q.y); a3 += bfhi(q.y); }
                        r.x = pk2(a0, a1); r.y = pk2(a2, a3); }
                    v[j][0] = DN_ALPHA * v[j][0] + vg[j][0] * bflo(r.x); v[j][1] = DN_ALPHA * v[j][1] + vg[j][1] * bfhi(r.x);
                    v[j][2] = DN_ALPHA * v[j][2] + vg[j][2] * bflo(r.y); v[j][3] = DN_ALPHA * v[j][3] + vg[j][3] * bfhi(r.y);
                    s += (v[j][0] + v[j][1]) + (v[j][2] + v[j][3]); }
                const float mean = wave_sum(s) * (1.f / DM); float s2 = 0.f;
#pragma unroll
                for (int j = 0; j < 4; ++j) { v[j] = v[j] - mean; s2 += (v[j][0] * v[j][0] + v[j][1] * v[j][1]) + (v[j][2] * v[j][2] + v[j][3] * v[j][3]); }
                const float rstd = rsqrtf(wave_sum(s2) * (1.f / DM) + LN_EPS);
#pragma unroll
                for (int j = 0; j < 4; ++j) { const int c = 4 * F.lane + 256 * j; v[j] = v[j] * rstd * vlg[j] + vlb[j]; *(f32x4*)(hout + c) = v[j]; }
            }
            if (do_u) {
                float s = 0.f;
#pragma unroll
                for (int j = 0; j < 4; ++j) s += (v[j][0] + v[j][1]) + (v[j][2] + v[j][3]);
                const float mean = wave_sum(s) * (1.f / DM); float s2 = 0.f;
#pragma unroll
                for (int j = 0; j < 4; ++j) { v[j] = v[j] - mean; s2 += (v[j][0] * v[j][0] + v[j][1] * v[j][1]) + (v[j][2] * v[j][2] + v[j][3] * v[j][3]); }
                const float rstd = rsqrtf(wave_sum(s2) * (1.f / DM) + LN_EPS);
#pragma unroll
                for (int j = 0; j < 4; ++j) { const int c = 4 * F.lane + 256 * j; const f32x4 o = v[j] * rstd * vsc[j] + vsh[j]; u32x2 w; w.x = pk2(o[0], o[1]); w.y = pk2(o[2], o[3]); *(u32x2*)(U + (size_t)row * DM + c) = w; }
            }
        }
    }
}
#define XB_TMO      128
#define XB_XCNT(j)  (256  + 64 * (j))
#define XB_XSUB(j)  (1280 + 64 * (j))
#define XB_XGEN(j)  (2304 + 64 * (j))
#define XB_TOP      3328
#define XB_TOPGEN   3392
#define XCD_BAR_WORDS 3456
#define XB_SPIN_CAP (1u << 30)

__device__ __forceinline__ unsigned xb_ld(unsigned* p)              { return __hip_atomic_load(p, __ATOMIC_RELAXED, __HIP_MEMORY_SCOPE_AGENT); }
__device__ __forceinline__ unsigned xb_add(unsigned* p, unsigned v) { return __hip_atomic_fetch_add(p, v, __ATOMIC_RELAXED, __HIP_MEMORY_SCOPE_AGENT); }
__device__ __forceinline__ unsigned xb_xcc_id() { return (unsigned)__builtin_amdgcn_s_getreg((3 << 11) | 20) & 0xFu; }
#define XB_SPIN(cond, bar) do { unsigned _sp = 0; while (cond) { __builtin_amdgcn_s_sleep(1); \
    if ((++_sp & 255u) == 0u) { if (xb_ld(&(bar)[XB_TMO])) break; if (_sp > XB_SPIN_CAP) { atomicAdd(&(bar)[XB_TMO], 1u); break; } } } } while (0)

struct XcdBarrier {
    unsigned* bar; unsigned x;
    volatile LAS unsigned* st;
};

__device__ __forceinline__ XcdBarrier xcd_barrier_post(unsigned* bar, volatile LAS unsigned* st, int tid) {
    XcdBarrier b; b.bar = bar; b.x = xb_xcc_id(); b.st = st;
    if (tid == 0) (void)xb_add(&bar[XB_XCNT(b.x)], 1u);
    return b;
}
__device__ __forceinline__ void xcd_barrier_complete(unsigned* bar, unsigned x, unsigned& nloc, unsigned& nx) {
    const unsigned G = gridDim.x * gridDim.y * gridDim.z;
    unsigned sum, cnt, mine, sp = 0u;
    for (;;) {
        sum = 0u; cnt = 0u; mine = 0u;
#pragma unroll
        for (unsigned j = 0; j < 16; ++j) { const unsigned c = xb_ld(&bar[XB_XCNT(j)]); sum += c; cnt += (c > 0u) ? 1u : 0u; mine = (j == x) ? c : mine; }
        if (sum == G) break;
        __builtin_amdgcn_s_sleep(1);
        if ((++sp & 255u) == 0u) { if (xb_ld(&bar[XB_TMO])) break; if (sp > XB_SPIN_CAP) { atomicAdd(&bar[XB_TMO], 1u); break; } }
    }
    nloc = mine > 0u ? mine : 1u; nx = cnt > 0u ? cnt : 1u;
}

__device__ __forceinline__ void xcd_barrier(const XcdBarrier& b, int tid) {
    asm volatile("s_waitcnt vmcnt(0)" ::: "memory");
    __syncthreads();
    if (tid == 0) {
        unsigned* bar = b.bar;
        __builtin_amdgcn_s_waitcnt(0);
        unsigned nloc = b.st[0], nx = b.st[1];
        if (nloc == 0u) { xcd_barrier_complete(bar, b.x, nloc, nx); b.st[0] = nloc; b.st[1] = nx; }
        const unsigned old = xb_add(&bar[XB_XSUB(b.x)], 1u);
        const unsigned gen = old / nloc;
        if (old + 1u == (gen + 1u) * nloc) {
            __builtin_amdgcn_fence(__ATOMIC_RELEASE, "agent");
            asm volatile("s_waitcnt vmcnt(0)" ::: "memory");
            const unsigned og = xb_add(&bar[XB_TOP], 1u);
            const unsigned tg = og / nx;
            if (og + 1u == (tg + 1u) * nx) xb_add(&bar[XB_TOPGEN], 1u);
            else XB_SPIN(xb_ld(&bar[XB_TOPGEN]) == tg, bar);
            __builtin_amdgcn_fence(__ATOMIC_ACQUIRE, "agent");
            xb_add(&bar[XB_XGEN(b.x)], 1u);
            asm volatile("s_waitcnt vmcnt(0)" ::: "memory");
        } else {
            XB_SPIN(xb_ld(&bar[XB_XGEN(b.x)]) == gen, bar);
            __builtin_amdgcn_fence(__ATOMIC_ACQUIRE, "agent");
            asm volatile("s_waitcnt vmcnt(0)" ::: "memory");
        }
    }
    __syncthreads();
}
typedef f32x4 AccT[2][2][4][2];
__device__ __forceinline__ const void* uni_ptr(const void* p) { const unsigned long long v = (unsigned long long)p; unsigned lo = __builtin_amdgcn_readfirstlane((unsigned)v), hi = __builtin_amdgcn_readfirstlane((unsigned)(v >> 32));
    asm volatile("" : "+s"(lo), "+s"(hi)); return (const void*)(((unsigned long long)hi << 32) | lo); }
#define EPI_ROWS(u, wr, fr, ai, m) ((u).pm * 256 + (ai) * 128 + (wr) * 64 + (m) * 16 + (fr))

struct EpiGU {
    static constexpr bool PERM = true, AFTER_DRAIN = false, KHOOK = false;
    bf16* O;
    __device__ __forceinline__ void operator()(const AccT& acc, const pg8::Unit& u, int wr, int wc, int fr, int fq) const {
        asm volatile("" : "+v"(fr), "+v"(fq));
        const int col = u.pn * 128 + wc * 32 + 8 * fq;
#pragma unroll
        for (int ai = 0; ai < 2; ++ai)
#pragma unroll
            for (int m = 0; m < 4; ++m) {
                const size_t row = EPI_ROWS(u, wr, fr, ai, m);
                const f32x4 g0 = acc[ai][0][m][0], g1 = acc[ai][0][m][1], u0 = acc[ai][1][m][0], u1 = acc[ai][1][m][1];
                u32x4 w; w.x = pk2(fsilu(g0[0]) * u0[0], fsilu(g0[1]) * u0[1]); w.y = pk2(fsilu(g0[2]) * u0[2], fsilu(g0[3]) * u0[3]);
                w.z = pk2(fsilu(g1[0]) * u1[0], fsilu(g1[1]) * u1[1]); w.w = pk2(fsilu(g1[2]) * u1[2], fsilu(g1[3]) * u1[3]);
                *(u32x4*)(O + row * DFF + col) = w;
            }
    }
};
struct EpiStore {
    static constexpr bool PERM = true, AFTER_DRAIN = false, KHOOK = false;
    bf16* O; int ldc;
    __device__ __forceinline__ void operator()(const AccT& acc, const pg8::Unit& u, int wr, int wc, int fr, int fq) const {
        asm volatile("" : "+v"(fr), "+v"(fq));
#pragma unroll
        for (int ai = 0; ai < 2; ++ai)
#pragma unroll
            for (int m = 0; m < 4; ++m) {
                const size_t row = EPI_ROWS(u, wr, fr, ai, m);
#pragma unroll
                for (int bj = 0; bj < 2; ++bj) { const int col = u.pn * 256 + bj * 128 + wc * 32 + 8 * fq; const f32x4 v0 = acc[ai][bj][m][0], v1 = acc[ai][bj][m][1];
                    u32x4 w; w.x = pk2(v0[0], v0[1]); w.y = pk2(v0[2], v0[3]); w.z = pk2(v1[0], v1[1]); w.w = pk2(v1[2], v1[3]);
                    *(u32x4*)(O + row * ldc + col) = w; }
            }
    }
};
struct EpiGLU {
    static constexpr bool PERM = true, AFTER_DRAIN = false, KHOOK = false;
    const bf16* Y; const float* bias; bf16* O;
    __device__ __forceinline__ void operator()(const AccT& acc, const pg8::Unit& u, int wr, int wc, int fr, int fq) const {
        asm volatile("" : "+v"(fr), "+v"(fq));
#pragma unroll
        for (int ai = 0; ai < 2; ++ai)
#pragma unroll
            for (int m = 0; m < 4; ++m) {
                const size_t row = EPI_ROWS(u, wr, fr, ai, m);
#pragma unroll
                for (int bj = 0; bj < 2; ++bj) {
                    const int col = bj * 128 + wc * 32 + 8 * fq;
                    const f32x4 b0 = *(const f32x4*)(bias + col), b1 = *(const f32x4*)(bias + col + 4);
                    const u32x4 y = *(const u32x4*)(Y + row * 256 + col); const f32x4 v0 = acc[ai][bj][m][0] + b0, v1 = acc[ai][bj][m][1] + b1;
                    u32x4 w; w.x = pk2(bflo(y.x) * fsigmoid(v0[0]), bfhi(y.x) * fsigmoid(v0[1])); w.y = pk2(bflo(y.y) * fsigmoid(v0[2]), bfhi(y.y) * fsigmoid(v0[3]));
                    w.z = pk2(bflo(y.z) * fsigmoid(v1[0]), bfhi(y.z) * fsigmoid(v1[1])); w.w = pk2(bflo(y.w) * fsigmoid(v1[2]), bfhi(y.w) * fsigmoid(v1[3]));
                    *(u32x4*)(O + row * 1024 + col) = w;
                    asm volatile("" ::: "memory");
                }
            }
    }
};
template <bool FIRST> struct EpiMerge {
    static constexpr bool PERM = true, AFTER_DRAIN = false, KHOOK = false;
    const bf16* G; int gi; bf16* O;
    __device__ __forceinline__ void operator()(const AccT& acc, const pg8::Unit& u, int wr, int wc, int fr, int fq) const {
        asm volatile("" : "+v"(fr), "+v"(fq));
#pragma unroll
        for (int ai = 0; ai < 2; ++ai)
#pragma unroll
            for (int m = 0; m < 4; ++m) {
                const size_t row = EPI_ROWS(u, wr, fr, ai, m);
#pragma unroll
                for (int bj = 0; bj < 2; ++bj) { const int col = u.pn * 256 + bj * 128 + wc * 32 + 8 * fq;
                    const u32x4 g = *(const u32x4*)(G + row * 3072 + gi * 1024 + col); const f32x4 v0 = acc[ai][bj][m][0], v1 = acc[ai][bj][m][1];
                    float o[8] = {bflo(g.x) * v0[0], bfhi(g.x) * v0[1], bflo(g.y) * v0[2], bfhi(g.y) * v0[3], bflo(g.z) * v1[0], bfhi(g.z) * v1[1], bflo(g.w) * v1[2], bfhi(g.w) * v1[3]};
                    if (!FIRST) { const u32x4 p = *(const u32x4*)(O + row * DM + col);
                        o[0] += bflo(p.x); o[1] += bfhi(p.x); o[2] += bflo(p.y); o[3] += bfhi(p.y); o[4] += bflo(p.z); o[5] += bfhi(p.z); o[6] += bflo(p.w); o[7] += bfhi(p.w); }
                    u32x4 w; w.x = pk2(o[0], o[1]); w.y = pk2(o[2], o[3]); w.z = pk2(o[4], o[5]); w.w = pk2(o[6], o[7]);
                    *(u32x4*)(O + row * DM + col) = w; asm volatile("" ::: "memory"); }
            }
    }
};
struct EpiMergeK {
    static constexpr bool PERM = true, AFTER_DRAIN = false, KHOOK = true;
    const bf16* G; bf16* O;
    __device__ __forceinline__ void khook(AccT& acc, const pg8::Unit& u, int wr, int wc, int fr, int fq, int t) const {
        asm volatile("" : "+v"(fr), "+v"(fq));
        const int ga = (t == 4) ? 0 : 1024, gb = ga + 1024;
#pragma unroll
        for (int ai = 0; ai < 2; ++ai)
#pragma unroll
            for (int m = 0; m < 4; ++m) {
                const size_t row = EPI_ROWS(u, wr, fr, ai, m);
#pragma unroll
                for (int bj = 0; bj < 2; ++bj) { const int col = u.pn * 256 + bj * 128 + wc * 32 + 8 * fq;
                    const u32x4 a = *(const u32x4*)(G + row * 3072 + ga + col), b = *(const u32x4*)(G + row * 3072 + gb + col);
                    acc[ai][bj][m][0][0] *= bflo(a.x) * __builtin_amdgcn_rcpf(1e-30f + bflo(b.x)); acc[ai][bj][m][0][1] *= bfhi(a.x) * __builtin_amdgcn_rcpf(1e-30f + bfhi(b.x));
                    acc[ai][bj][m][0][2] *= bflo(a.y) * __builtin_amdgcn_rcpf(1e-30f + bflo(b.y)); acc[ai][bj][m][0][3] *= bfhi(a.y) * __builtin_amdgcn_rcpf(1e-30f + bfhi(b.y));
                    acc[ai][bj][m][1][0] *= bflo(a.z) * __builtin_amdgcn_rcpf(1e-30f + bflo(b.z)); acc[ai][bj][m][1][1] *= bfhi(a.z) * __builtin_amdgcn_rcpf(1e-30f + bfhi(b.z));
                    acc[ai][bj][m][1][2] *= bflo(a.w) * __builtin_amdgcn_rcpf(1e-30f + bflo(b.w)); acc[ai][bj][m][1][3] *= bfhi(a.w) * __builtin_amdgcn_rcpf(1e-30f + bfhi(b.w));
                    asm volatile("" ::: "memory"); }
            }
    }
    __device__ __forceinline__ void operator()(const AccT& acc, const pg8::Unit& u, int wr, int wc, int fr, int fq) const {
        asm volatile("" : "+v"(fr), "+v"(fq));
#pragma unroll
        for (int ai = 0; ai < 2; ++ai)
#pragma unroll
            for (int m = 0; m < 4; ++m) {
                const size_t row = EPI_ROWS(u, wr, fr, ai, m);
#pragma unroll
                for (int bj = 0; bj < 2; ++bj) { const int col = u.pn * 256 + bj * 128 + wc * 32 + 8 * fq;
                    const u32x4 g = *(const u32x4*)(G + row * 3072 + 2048 + col); const f32x4 v0 = acc[ai][bj][m][0], v1 = acc[ai][bj][m][1];
                    u32x4 w; w.x = pk2(bflo(g.x) * v0[0], bfhi(g.x) * v0[1]); w.y = pk2(bflo(g.y) * v0[2], bfhi(g.y) * v0[3]); w.z = pk2(bflo(g.z) * v1[0], bfhi(g.z) * v1[1]); w.w = pk2(bflo(g.w) * v1[2], bfhi(g.w) * v1[3]);
                    *(u32x4*)(O + row * DM + col) = w; asm volatile("" ::: "memory"); }
            }
    }
};
struct EpiWin {
    static constexpr bool PERM = true, AFTER_DRAIN = false, KHOOK = false;
    unsigned char* z; const float* rope;
    __device__ __forceinline__ void operator()(const AccT& acc, const pg8::Unit& u, int wr, int wc, int fr, int fq) const {
        asm volatile("" : "+v"(fr), "+v"(fq));
        const int pn = u.pn;
        unsigned char* z = (unsigned char*)uni_ptr(this->z); const float* rope = (const float*)uni_ptr(this->rope);
        if (pn == 0 || pn == 5 || pn >= 8) {
            bf16* O; int ldc, cb; const bool sig = pn >= 8;
            if (pn == 0) { O = (bf16*)(z + Z_SSMU); ldc = 256; cb = 0; } else if (pn == 5) { O = (bf16*)(z + Z_F); ldc = 256; cb = 0; } else { O = (bf16*)(z + Z_G); ldc = 3072; cb = (pn - 8) * 256; }
#pragma unroll
            for (int ai = 0; ai < 2; ++ai)
#pragma unroll
                for (int m = 0; m < 4; ++m) {
                    const size_t row = EPI_ROWS(u, wr, fr, ai, m);
#pragma unroll
                    for (int bj = 0; bj < 2; ++bj) { const int col = cb + bj * 128 + wc * 32 + 8 * fq; f32x4 v0 = acc[ai][bj][m][0], v1 = acc[ai][bj][m][1];
                        if (sig) {
#pragma unroll
                            for (int j = 0; j < 4; ++j) { v0[j] = fsigmoid(v0[j]); v1[j] = fsigmoid(v1[j]); } }
                        u32x4 w; w.x = pk2(v0[0], v0[1]); w.y = pk2(v0[2], v0[3]); w.z = pk2(v1[0], v1[1]); w.w = pk2(v1[2], v1[3]);
                        *(u32x4*)(O + row * ldc + col) = w; }
                }
        } else if (pn == 3 || pn == 4) {
            bf16* VT = (bf16*)(z + Z_VT); bf16* VCT = VT + (size_t)NB * 512 * VLD;
#pragma unroll
            for (int ai = 0; ai < 2; ++ai)
#pragma unroll
                for (int m = 0; m < 4; ++m) {
                    const int row = EPI_ROWS(u, wr, fr, ai, m);
                    bf16* base; int ldt;
                    if (row < MLAT) { const int b = row / SEQ, t = row % SEQ; base = VT + (size_t)b * 512 * VLD + t; ldt = VLD; }
                    else { const int rc = row - MLAT, b = rc / CTXL, t = rc % CTXL; base = VCT + (size_t)b * 512 * CTXL + t; ldt = CTXL; }
#pragma unroll
                    for (int bj = 0; bj < 2; ++bj) { const int vc = (pn - 3) * 256 + bj * 128 + wc * 32 + 8 * fq;
#pragma unroll
                        for (int n = 0; n < 2; ++n)
#pragma unroll
                            for (int j = 0; j < 4; ++j) base[(size_t)(vc + 4 * n + j) * ldt] = (bf16)f2bf(acc[ai][bj][m][n][j]); }
                }
        } else {
            const bool isq = pn >= 6; bf16* O = (bf16*)(z + (isq ? Z_Q : Z_K)); const int cb = (pn - (isq ? 6 : 1)) * 256; const float qs = isq ? 0.125f : 1.f;
            const bool latent = u.pm < MLAT / 256;
            const int ax = wc & 1, ph = fq >> 1, f0 = 8 * (fq & 1);
#pragma unroll
            for (int ai = 0; ai < 2; ++ai)
#pragma unroll
                for (int m = 0; m < 4; ++m) {
                    const int row = EPI_ROWS(u, wr, fr, ai, m);
                    f32x4 c0 = {1.f, 1.f, 1.f, 1.f}, c1 = c0, s0 = F4Z, s1 = F4Z;
                    if (latent) { const int t = row % SEQ, pos = ax ? (t & 63) : (t >> 6); const float* rc = rope + pos * 16 + f0;
                        c0 = *(const f32x4*)rc; c1 = *(const f32x4*)(rc + 4); s0 = *(const f32x4*)(rc + 2048); s1 = *(const f32x4*)(rc + 2048 + 4); }
#pragma unroll
                    for (int bj = 0; bj < 2; ++bj) { const int col = cb + bj * 128 + wc * 32 + 8 * fq; f32x4 v0 = acc[ai][bj][m][0], v1 = acc[ai][bj][m][1], o0, o1;
#pragma unroll
                        for (int j = 0; j < 4; ++j) { const float p0 = __shfl_xor(v0[j], 32), p1 = __shfl_xor(v1[j], 32);
                            o0[j] = (ph ? (v0[j] * c0[j] + p0 * s0[j]) : (v0[j] * c0[j] - p0 * s0[j])) * qs;
                            o1[j] = (ph ? (v1[j] * c1[j] + p1 * s1[j]) : (v1[j] * c1[j] - p1 * s1[j])) * qs; }
                        u32x4 w; w.x = pk2(o0[0], o0[1]); w.y = pk2(o0[2], o0[3]); w.z = pk2(o1[0], o1[1]); w.w = pk2(o1[2], o1[3]);
                        *(u32x4*)(O + (size_t)row * 512 + col) = w; }
                }
        }
    }
};
__device__ __forceinline__ int chunk_row0(int b, int ck) { return ck < 4 ? MLAT + b * CTXL + 64 * ck : b * SEQ + 64 * (ck - 4); }
__device__ __forceinline__ bf16x8 ld_frag(const bf16* p) { return *(const bf16x8*)p; }
constexpr bf16x8 BF8Z = {0, 0, 0, 0, 0, 0, 0, 0};

struct S5T1 { bf16x8 bre, bim; f32x4 pr[4], pi[4]; };
__device__ __forceinline__ void s5_load_t1(const unsigned char* tb, int dg, int nt, int fr, int G, S5T1& T) {
    const bf16* bbt = (const bf16*)(tb + T_BBT); const float* pneg = (const float*)(tb + T_PNEG);
    T.bre = (G < 2) ? ld_frag(bbt + ((size_t)dg * 128 + 16 * nt + fr) * 16 + 8 * G) : BF8Z;
    T.bim = (G < 2) ? ld_frag(bbt + ((size_t)dg * 128 + 64 + 16 * nt + fr) * 16 + 8 * G) : BF8Z;
    const float* pr = pneg + ((size_t)(dg * 2 + 0) * 64 + 16 * nt + fr) * 64 + 4 * G;
#pragma unroll
    for (int tt = 0; tt < 4; ++tt) { T.pr[tt] = *(const f32x4*)(pr + 16 * tt); T.pi[tt] = *(const f32x4*)(pr + 4096 + 16 * tt); }
}
__device__ __forceinline__ void s5_stage1(const S5T1& T, const bf16x8 (&af)[4], f32x4 (&vre)[4], f32x4 (&vim)[4]) {
#pragma unroll
    for (int tt = 0; tt < 4; ++tt) {
        const f32x4 cr = mfma16(af[tt], T.bre, F4Z), ci = mfma16(af[tt], T.bim, F4Z);
        vre[tt] = T.pr[tt] * cr - T.pi[tt] * ci; vim[tt] = T.pr[tt] * ci + T.pi[tt] * cr;
    }
}
__device__ __forceinline__ void s5_load_u(const bf16* SSMU, int row0, int g, int fr, int G, bf16x8 (&af)[4]) {
#pragma unroll
    for (int tt = 0; tt < 4; ++tt) af[tt] = (G < 2) ? ld_frag(SSMU + (size_t)(row0 + 16 * tt + fr) * 256 + 16 * g + 8 * G) : BF8Z;
}

template <int NC>
__device__ __forceinline__ void s5_pass_a(const Params& P, int item, int lane) {
    const int fr = lane & 15, G = lane >> 4;
    const int dir = item & 1, ckb = ((item >> 1) % (NCHUNK / NC)) * NC, bg = (item >> 1) / (NCHUNK / NC), g = bg & 15, b = bg >> 4, dg = dir * 16 + g;
    const unsigned char* tb = P.ws + WS_TBL; const float* apow = (const float*)(tb + T_APOW);
    float* sloc = (float*)(P.ws + WS_SLOC) + ((size_t)((bg * 2 + dir) * NCHUNK + ckb)) * 128;
    bf16x8 af[NC][4];
#pragma unroll
    for (int c = 0; c < NC; ++c) s5_load_u((const bf16*)(P.ws + WS_Z + Z_SSMU), chunk_row0(b, ckb + c), g, fr, G, af[c]);
    S5T1 T[2]; s5_load_t1(tb, dg, 0, fr, G, T[0]);
    float a63r[4], a63i[4];
#pragma unroll
    for (int nt = 0; nt < 4; ++nt) { a63r[nt] = apow[((size_t)(1 * 32 + dg) * 2 + 0) * 64 + 16 * nt + fr]; a63i[nt] = apow[((size_t)(1 * 32 + dg) * 2 + 1) * 64 + 16 * nt + fr]; }
#pragma unroll
    for (int nt = 0; nt < 4; ++nt) {
        if (nt + 1 < 4) s5_load_t1(tb, dg, nt + 1, fr, G, T[(nt + 1) & 1]);
#pragma unroll
        for (int c = 0; c < NC; ++c) {
            f32x4 vre[4], vim[4]; s5_stage1(T[nt & 1], af[c], vre, vim);
            float sr = 0.f, si = 0.f;
#pragma unroll
            for (int tt = 0; tt < 4; ++tt) { sr += (vre[tt][0] + vre[tt][1]) + (vre[tt][2] + vre[tt][3]); si += (vim[tt][0] + vim[tt][1]) + (vim[tt][2] + vim[tt][3]); }
            sr += __shfl_xor(sr, 16); sr += __shfl_xor(sr, 32); si += __shfl_xor(si, 16); si += __shfl_xor(si, 32);
            const int p = 16 * nt + fr;
            if (G == 0) { sloc[c * 128 + p] = a63r[nt] * sr - a63i[nt] * si; sloc[c * 128 + 64 + p] = a63r[nt] * si + a63i[nt] * sr; }
        }
    }
}
__device__ __forceinline__ void s5_pass_b(const Params& P, int item, int lane) {
    const int dir = item & 1, bg = item >> 1, g = bg & 15, dg = dir * 16 + g, p = lane;
    const float* apow = (const float*)(P.ws + WS_TBL + T_APOW);
    const float a1r = apow[((size_t)(0 * 32 + dg) * 2 + 0) * 64 + p], a1i = apow[((size_t)(0 * 32 + dg) * 2 + 1) * 64 + p];
    const float a64r = apow[((size_t)(2 * 32 + dg) * 2 + 0) * 64 + p], a64i = apow[((size_t)(2 * 32 + dg) * 2 + 1) * 64 + p];
    float* sl = (float*)(P.ws + WS_SLOC) + (size_t)(bg * 2 + dir) * NCHUNK * 128;
    float hr = 0.f, hi = 0.f;
    for (int q0 = 0; q0 < NCHUNK; q0 += 12) {
        float sr[12], si[12];
#pragma unroll
        for (int k = 0; k < 12; ++k) { const int q = q0 + k, ck = dir ? (q < 4 ? 3 - q : 135 - q) : q; sr[k] = sl[(size_t)ck * 128 + p]; si[k] = sl[(size_t)ck * 128 + 64 + p]; }
#pragma unroll
        for (int k = 0; k < 12; ++k) { const int q = q0 + k, ck = dir ? (q < 4 ? 3 - q : 135 - q) : q;
            sl[(size_t)ck * 128 + p] = a1r * hr - a1i * hi; sl[(size_t)ck * 128 + 64 + p] = a1r * hi + a1i * hr;
            const float nr = a64r * hr - a64i * hi + sr[k], ni = a64r * hi + a64i * hr + si[k]; hr = nr; hi = ni; }
    }
}
struct S5T3 { f32x4 cr, ci; bf16x8 cfrag; f32x4 qr[4], qi[4]; };
__device__ __forceinline__ void s5_load_t3(const unsigned char* tb, const float* ah, int dg, int nt, int fr, int G, S5T3& T) {
    const float* ppos = (const float*)(tb + T_PPOS); const bf16* cct = (const bf16*)(tb + T_CCT);
    T.cr = *(const f32x4*)(ah + 16 * nt + 4 * G); T.ci = *(const f32x4*)(ah + 64 + 16 * nt + 4 * G);
    T.cfrag = ld_frag(cct + ((((size_t)dg * 4 + nt) * 16 + fr) * 4 + G) * 8);
#pragma unroll
    for (int nto = 0; nto < 4; ++nto) { const float* pp = ppos + ((size_t)(dg * 2 + 0) * 64 + 16 * nto + fr) * 64 + 16 * nt + 4 * G; T.qr[nto] = *(const f32x4*)pp; T.qi[nto] = *(const f32x4*)(pp + 4096); }
}
template <int NC>
__device__ __forceinline__ void s5_pass_c(const Params& P, int l, int item, int nck, int ck0, int lane) {
    const int fr = lane & 15, G = lane >> 4;
    const int ckb = ck0 + (item * NC) % nck, bg = (item * NC) / nck, g = bg & 15, b = bg >> 4;
    const unsigned char* tb = P.ws + WS_TBL;
    const bf16* SSMU = (const bf16*)(P.ws + WS_Z + Z_SSMU);
    bf16x8 af[NC][4]; f32x4 yt[NC][4];
#pragma unroll
    for (int c = 0; c < NC; ++c) { s5_load_u(SSMU, chunk_row0(b, ckb + c), g, fr, G, af[c]);
#pragma unroll
        for (int q = 0; q < 4; ++q) yt[c][q] = F4Z; }
#pragma unroll 1
    for (int dir = 0; dir < 2; ++dir) {
        const int dg = dir * 16 + g;
        const float* ah = (const float*)(P.ws + WS_SLOC) + ((size_t)((bg * 2 + dir) * NCHUNK + ckb)) * 128;
        bf16x8 la, lb;
        { u32x4 wa, wb;
#pragma unroll
            for (int wi = 0; wi < 4; ++wi) { const int s0 = 16 * (wi >> 1) + 4 * G + 2 * (wi & 1), s1 = s0 + 1;
                const unsigned alo = (dir ? (s0 >= fr) : (s0 <= fr)) ? 0x3F80u : 0u, ahi = (dir ? (s1 >= fr) : (s1 <= fr)) ? 0x3F80u : 0u;
                const unsigned blo = (dir ? (s0 >= 16 + fr) : (s0 <= 16 + fr)) ? 0x3F80u : 0u, bhi = (dir ? (s1 >= 16 + fr) : (s1 <= 16 + fr)) ? 0x3F80u : 0u;
                wa[wi] = alo | (ahi << 16); wb[wi] = blo | (bhi << 16); }
            la = as_bf16x8(wa); lb = as_bf16x8(wb); }
        const u32x4 w1 = {0x3F803F80u, 0x3F803F80u, 0x3F803F80u, 0x3F803F80u}; const bf16x8 lones = as_bf16x8(w1);
#pragma unroll
        for (int nt = 0; nt < 4; ++nt) {
            S5T1 T1; s5_load_t1(tb, dg, nt, fr, G, T1);
            const float* ppos = (const float*)(tb + T_PPOS); const bf16* cct = (const bf16*)(tb + T_CCT);
            const bf16x8 cfrag = ld_frag(cct + ((((size_t)dg * 4 + nt) * 16 + fr) * 4 + G) * 8);
#pragma unroll
            for (int c = 0; c < NC; ++c) {
                const f32x4 cr = *(const f32x4*)(ah + c * 128 + 16 * nt + 4 * G), ci = *(const f32x4*)(ah + c * 128 + 64 + 16 * nt + 4 * G);
                f32x4 vre[4], vim[4]; s5_stage1(T1, af[c], vre, vim);
                const bf16x8 are0 = pack8(vre[0], vre[1]), are1 = pack8(vre[2], vre[3]), aim0 = pack8(vim[0], vim[1]), aim1 = pack8(vim[2], vim[3]);
#pragma unroll
                for (int nto = 0; nto < 4; ++nto) {
                    const bf16x8 lm = (nto & 1) ? lb : la; const bool mixed_k1 = (nto >> 1) != 0;
                    f32x4 hr = mfma16(mixed_k1 ? are1 : are0, lm, F4Z), hi = mfma16(mixed_k1 ? aim1 : aim0, lm, F4Z);
                    if (dir == 0 && mixed_k1) { hr = mfma16(are0, lones, hr); hi = mfma16(aim0, lones, hi); }
                    if (dir == 1 && !mixed_k1) { hr = mfma16(are1, lones, hr); hi = mfma16(aim1, lones, hi); }
                    hr = hr + cr; hi = hi + ci;
                    const float* pp = ppos + ((size_t)(dg * 2 + 0) * 64 + 16 * nto + fr) * 64 + 16 * nt + 4 * G; const f32x4 qr = *(const f32x4*)pp, qi = *(const f32x4*)(pp + 4096);
                    const f32x4 sr = qr * hr - qi * hi, si = qr * hi + qi * hr;
                    yt[c][nto] = mfma16(cfrag, pack8(sr, si), yt[c][nto]);
                }
            }
        }
    }
    const float* dvec = P.in[19] + l * 256 + 16 * g + 4 * G; const f32x4 dv = *(const f32x4*)dvec;
    bf16* YPRE = (bf16*)(P.ws + WS_U + OV_YPRE);
#pragma unroll
    for (int c = 0; c < NC; ++c) { const int row0 = chunk_row0(b, ckb + c);
#pragma unroll
        for (int nto = 0; nto < 4; ++nto) { const size_t row = row0 + 16 * nto + fr; const u32x2 uu = *(const u32x2*)(SSMU + row * 256 + 16 * g + 4 * G);
            const float y0 = gelu_tanh(yt[c][nto][0] + dv[0] * bflo(uu.x)), y1 = gelu_tanh(yt[c][nto][1] + dv[1] * bfhi(uu.x)), y2 = gelu_tanh(yt[c][nto][2] + dv[2] * bflo(uu.y)), y3 = gelu_tanh(yt[c][nto][3] + dv[3] * bfhi(uu.y));
            u32x2 w; w.x = pk2(y0, y1); w.y = pk2(y2, y3); *(u32x2*)(YPRE + row * 256 + 16 * g + 4 * G) = w; } }
}

template <int N1, int N2>
__device__ __forceinline__ void fnet_a(const Params& P, int item, int lane) {
    constexpr int LT = N1 / 16, NOCT = N2 / 8, L = N1 * N2, NK = 1, NKG = LT / NK;
    const int fr = lane & 15, G = lane >> 4;
    const int kg = item % NKG, mt = (item / NKG) & 3, oct = (item / (NKG * 4)) % NOCT, bg = item / (NKG * 4 * NOCT), g = bg & 3, b = bg >> 2;
    const unsigned char* tb = P.ws + WS_TBL; const bf16* wcb = (const bf16*)(tb + T_WCB); const bf16* fa = (const bf16*)(tb + (N1 == 64 ? T_FA64 : T_FA16));
    const bf16* FB = (const bf16*)(P.ws + WS_Z + Z_F); bf16* TB = (bf16*)(P.ws + WS_U + (N1 == 64 ? OV_TBL : OV_TBC));
    const int rbase = (N1 == 64) ? b * SEQ : MLAT + b * CTXL;
    bf16x8 wre[2], wim[2], far[NK][LT], fai[NK][LT];
#pragma unroll
    for (int kk = 0; kk < 2; ++kk) { wre[kk] = ld_frag(wcb + (size_t)(16 * mt + fr) * 64 + 32 * kk + 8 * G); wim[kk] = ld_frag(wcb + (size_t)(64 + 16 * mt + fr) * 64 + 32 * kk + 8 * G); }
#pragma unroll
    for (int q = 0; q < NK; ++q)
#pragma unroll
        for (int lt = 0; lt < LT; ++lt) { const int kt1 = kg * NK + q;
            far[q][lt] = ld_frag(fa + ((((size_t)0 * N1 + 16 * kt1 + fr) * LT + lt) * 4 + G) * 8); fai[q][lt] = ld_frag(fa + ((((size_t)1 * N1 + 16 * kt1 + fr) * LT + lt) * 4 + G) * 8); }
    unsigned ore[NK][4][4], oim[NK][4][4];
#pragma unroll
    for (int e2 = 0; e2 < 4; ++e2) {
        f32x4 tr2[NK][2], ti2[NK][2];
#pragma unroll
        for (int eo = 0; eo < 2; ++eo) {
            const int l2 = 8 * oct + 2 * e2 + eo;
            f32x4 tre[NK], tim[NK];
#pragma unroll
            for (int q = 0; q < NK; ++q) { tre[q] = F4Z; tim[q] = F4Z; }
#pragma unroll
            for (int lt = 0; lt < LT; ++lt) {
                const bf16* rp = FB + (size_t)(rbase + (16 * lt + fr) * N2 + l2) * 256 + g * 64 + 8 * G;
                const bf16x8 a0 = ld_frag(rp), a1 = ld_frag(rp + 32);
                f32x4 xr = mfma16(a0, wre[0], F4Z); xr = mfma16(a1, wre[1], xr);
                f32x4 xi = mfma16(a0, wim[0], F4Z); xi = mfma16(a1, wim[1], xi);
                const bf16x8 xf = pack8(xr, xi);
#pragma unroll
                for (int q = 0; q < NK; ++q) { tre[q] = mfma16(far[q][lt], xf, tre[q]); tim[q] = mfma16(fai[q][lt], xf, tim[q]); }
            }
#pragma unroll
            for (int q = 0; q < NK; ++q)
#pragma unroll
                for (int r = 0; r < 4; ++r) { const int k1 = 16 * (kg * NK + q) + 4 * G + r; const float rev = (float)((k1 * l2) % L) * (1.f / (float)L); const float sn = __builtin_amdgcn_sinf(rev), cs = __builtin_amdgcn_cosf(rev);
                    const float a = tre[q][r], bb = tim[q][r]; tre[q][r] = a * cs + bb * sn; tim[q][r] = bb * cs - a * sn; }
#pragma unroll
            for (int q = 0; q < NK; ++q) { tr2[q][eo] = tre[q]; ti2[q][eo] = tim[q]; }
        }
#pragma unroll
        for (int q = 0; q < NK; ++q)
#pragma unroll
            for (int r = 0; r < 4; ++r) { ore[q][r][e2] = pk2(tr2[q][0][r], tr2[q][1][r]); oim[q][r][e2] = pk2(ti2[q][0][r], ti2[q][1][r]); }
    }
    const int m = 16 * mt + fr;
#pragma unroll
    for (int q = 0; q < NK; ++q)
#pragma unroll
        for (int r = 0; r < 4; ++r) { const int k1 = 16 * (kg * NK + q) + 4 * G + r;
            bf16* o = TB + ((((size_t)bg * N1 + k1) * 2 + 0) * 64 + m) * N2 + 8 * oct;
            u32x4 w0 = {ore[q][r][0], ore[q][r][1], ore[q][r][2], ore[q][r][3]}, w1 = {oim[q][r][0], oim[q][r][1], oim[q][r][2], oim[q][r][3]};
            *(u32x4*)o = w0; *(u32x4*)(o + (size_t)64 * N2) = w1; }
}
template <int N1, int N2>
__device__ __forceinline__ void fnet_c(const Params& P, int item, int lane) {
    constexpr int KT2 = N2 / 16, NKB = 2 * N2 / 32;
    const int fr = lane & 15, G = lane >> 4;
    const int mt0 = 2 * (item & 1), k1 = (item >> 1) % N1, bg = (item >> 1) / N1, g = bg & 3, b = bg >> 2;
    const unsigned char* tb = P.ws + WS_TBL; const bf16* fc = (const bf16*)(tb + (N2 == 128 ? T_FC128 : T_FC16));
    const bf16* TB = (const bf16*)(P.ws + WS_U + (N1 == 64 ? OV_TBL : OV_TBC)); bf16* YF = (bf16*)(P.ws + WS_RES) + 256;
    const int rbase = (N1 == 64) ? b * SEQ : MLAT + b * CTXL;
    f32x4 acc[2][KT2];
#pragma unroll
    for (int k = 0; k < KT2; ++k) { acc[0][k] = F4Z; acc[1][k] = F4Z; }
#pragma unroll 2
    for (int kb = 0; kb < NKB; ++kb) {
        const int kap = 32 * kb + 8 * G, part = kap / N2, l2 = kap % N2;
        const bf16* tp = TB + ((((size_t)bg * N1 + k1) * 2 + part) * 64 + 16 * mt0 + fr) * N2 + l2;
        const bf16x8 tf0 = ld_frag(tp), tf1 = ld_frag(tp + (size_t)16 * N2);
#pragma unroll
        for (int k = 0; k < KT2; ++k) { const bf16x8 ff = ld_frag(fc + (size_t)(16 * k + fr) * (2 * N2) + kap); acc[0][k] = mfma16(tf0, ff, acc[0][k]); acc[1][k] = mfma16(tf1, ff, acc[1][k]); }
    }
#pragma unroll
    for (int q = 0; q < 2; ++q)
#pragma unroll
        for (int k = 0; k < KT2; ++k) { const size_t row = rbase + k1 + N1 * (16 * k + fr); u32x2 w; w.x = pk2(acc[q][k][0], acc[q][k][1]); w.y = pk2(acc[q][k][2], acc[q][k][3]);
            *(u32x2*)(YF + row * 1024 + g * 64 + 16 * (mt0 + q) + 4 * G) = w; }
}
struct KVFrag { bf16x8 k[2][2]; bf16x8 v[4]; };
__device__ __forceinline__ void attn_load2(const char* kbase, const char* vbase, unsigned koff, unsigned voff, unsigned vdstep, KVFrag& f) {
#pragma unroll
    for (int t = 0; t < 2; ++t)
#pragma unroll
        for (int kt = 0; kt < 2; ++kt) f.k[t][kt] = *(const bf16x8*)(kbase + koff + (t * 4 * 512 + 32 * kt) * 2);
#pragma unroll
    for (int dt = 0; dt < 4; ++dt) f.v[dt] = *(const bf16x8*)(vbase + (size_t)dt * vdstep + voff);
}
template <bool CTXQ>
__device__ __forceinline__ void attn_item(const Params& P, const LAS float* rpb, int item, int lane) {
    constexpr int NCH = CTXQ ? 8 : 16;
    const int fr = lane & 15, G = lane >> 4;
    const char* KB = (const char*)(P.ws + WS_Z + Z_K); const bf16* QB = (const bf16*)(P.ws + WS_Z + Z_Q);
    const char* VT = (const char*)(P.ws + WS_Z + Z_VT); const char* VCT = VT + (size_t)NB * 512 * VLD * 2;
    bf16* YN = (bf16*)(P.ws + WS_RES) + 512;
    int b, h, r = 0, cg = 0, r0 = 0, cb = 0; size_t qrow0;
    if (!CTXQ) { cg = item & 3; r = (item >> 2) & 127; h = (item >> 9) & 7; b = item >> 12; r0 = min(max(r - 4, 0), 120); cb = (cg == 0) ? 0 : (cg == 1) ? 8 : (cg == 2) ? 24 : 32;
        qrow0 = (size_t)b * SEQ + r * 64 + 16 * cg; }
    else { const int qt = item & 15; h = (item >> 4) & 7; b = item >> 7; qrow0 = (size_t)MLAT + b * CTXL + 16 * qt; }
    bf16x8 qf[2];
#pragma unroll
    for (int kt = 0; kt < 2; ++kt) qf[kt] = *(const bf16x8*)(QB + (qrow0 + fr) * 512 + h * 64 + 32 * kt + 8 * G);
    const unsigned koff = (unsigned)(((8 * (fr >> 2) + (fr & 3)) * 512 + 8 * G) * 2);
    const unsigned voff_l = (unsigned)((fr * VLD + 8 * G) * 2), voff_c = (unsigned)((fr * CTXL + 8 * G) * 2);
    const char* kloc = KB + ((size_t)b * SEQ + (size_t)r0 * 64 + cb) * 1024 + h * 128;
    const char* kctx = KB + ((size_t)MLAT + (size_t)b * CTXL) * 1024 + h * 128;
    const char* vloc = VT + ((size_t)(b * 512 + h * 64) * VLD + (size_t)r0 * 64 + cb) * 2;
    const char* vctx = VCT + ((size_t)(b * 512 + h * 64) * CTXL) * 2;
    const int qc = 16 * cg + fr, c0 = min(max(qc - 8, 0), 48);
    int boff[2][4];
#pragma unroll
    for (int t = 0; t < 2; ++t)
#pragma unroll
        for (int j = 0; j < 4; ++j) { const int kc = cb + 8 * G + 4 * t + j; const bool ok = (kc >= c0) && (kc < c0 + 16); boff[t][j] = h * (15 * 32) + (ok ? (kc - qc + 15) : 31) + (r0 - r + 7) * 32; }
    f32x4 ot[4] = {F4Z, F4Z, F4Z, F4Z};
    float mrun = -1e30f, lsum = 0.f;
    KVFrag fb[4];
#define ATT_LOAD(CH, DST) do { const int _ch = (CH); if (!CTXQ && _ch < 8) attn_load2(kloc + (size_t)_ch * 65536, vloc + (size_t)_ch * 128, koff, voff_l, 16 * VLD * 2, DST); \
        else { const int _cc = CTXQ ? _ch : _ch - 8; attn_load2(kctx + (size_t)_cc * 32768, vctx + (size_t)_cc * 64, koff, voff_c, 16 * CTXL * 2, DST); } } while (0)
    ATT_LOAD(0, fb[0]); ATT_LOAD(1, fb[1]); ATT_LOAD(2, fb[2]);
#pragma unroll 1
    for (int o = 0; o < NCH / 4; ++o) {
#pragma unroll
        for (int i = 0; i < 4; ++i) {
            const int ch = 4 * o + i;
            if (ch + 3 < NCH) ATT_LOAD(ch + 3, fb[(i + 3) & 3]);
            const KVFrag& cur = fb[i];
            f32x4 s[2];
#pragma unroll
            for (int t = 0; t < 2; ++t) { s[t] = mfma16(cur.k[t][0], qf[0], F4Z); s[t] = mfma16(cur.k[t][1], qf[1], s[t]); }
            if (!CTXQ && ch < 8) {
#pragma unroll
                for (int t = 0; t < 2; ++t)
#pragma unroll
                    for (int j = 0; j < 4; ++j) s[t][j] += rpb[boff[t][j] + ch * 32];
            }
            float cm = fmaxf(fmaxf(fmaxf(s[0][0], s[0][1]), fmaxf(s[0][2], s[0][3])), fmaxf(fmaxf(s[1][0], s[1][1]), fmaxf(s[1][2], s[1][3])));
            cm = fmaxf(cm, __shfl_xor(cm, 16)); cm = fmaxf(cm, __shfl_xor(cm, 32));
            const float mnew = fmaxf(mrun, cm), alpha = __expf(mrun - mnew); mrun = mnew;
            f32x4 p0, p1; float ps = 0.f;
#pragma unroll
            for (int j = 0; j < 4; ++j) { p0[j] = __expf(s[0][j] - mnew); p1[j] = __expf(s[1][j] - mnew); ps += p0[j] + p1[j]; }
            lsum = lsum * alpha + ps;
            const bf16x8 pf = pack8(p0, p1);
#pragma unroll
            for (int dt = 0; dt < 4; ++dt) ot[dt] = mfma16(cur.v[dt], pf, ot[dt] * alpha);
            asm volatile("" ::: "memory");
        }
    }
#undef ATT_LOAD
    lsum += __shfl_xor(lsum, 16); lsum += __shfl_xor(lsum, 32);
    const float inv = 1.f / lsum;
#pragma unroll
    for (int dt = 0; dt < 4; ++dt) { u32x2 w; w.x = pk2(ot[dt][0] * inv, ot[dt][1] * inv); w.y = pk2(ot[dt][2] * inv, ot[dt][3] * inv);
        *(u32x2*)(YN + (qrow0 + fr) * 1024 + h * 64 + 16 * dt + 4 * G) = w; }
}
constexpr int LDS_CTL_OFF = 8 * 16384 + 5 * DM * 4;
constexpr int LDS_BYTES = LDS_CTL_OFF + 128;
__device__ __forceinline__ int q_raw_lds(LAS unsigned* ctr, int lane) { unsigned v = 0; if (lane == 0) v = __hip_atomic_fetch_add(ctr, 1u, __ATOMIC_RELAXED, __HIP_MEMORY_SCOPE_WORKGROUP); return (int)__builtin_amdgcn_readfirstlane(v); }
#define WG_RANGE(n, lo, cnt) const int lo = (int)(((long long)(n) * (int)blockIdx.x) / (int)gridDim.x), cnt = (int)(((long long)(n) * ((int)blockIdx.x + 1)) / (int)gridDim.x) - lo
__device__ __forceinline__ int q_next_lds(LAS unsigned* ctr, int lane) { unsigned v = 0; if (lane == 0) v = __hip_atomic_fetch_add(ctr, 1u, __ATOMIC_RELAXED, __HIP_MEMORY_SCOPE_WORKGROUP); return (int)__builtin_amdgcn_readfirstlane(v) * (int)gridDim.x + (int)blockIdx.x; }
__device__ __forceinline__ int q_next(unsigned* ctr, int lane) { unsigned v = 0; if (lane == 0) v = atomicAdd(ctr, 1u); return (int)__builtin_amdgcn_readfirstlane(v); }

template <class Epi>
__device__ __forceinline__ void run_gemm(const Frame& F, const bf16* A, const bf16* Bt, int M, int N, int K, const Epi& E) {
    pg8::Gemm g{A, Bt, M, N, K, K}; pg8::StaticOrder S; S.init(M, N, (int)gridDim.x, (int)blockIdx.x);
    pg8::gemm_phase<Epi, pg8::StaticOrder, true, true>((PG8_LAS unsigned char*)F.lds, g, S, E, F.tid);
}
struct OneUnit {
    int pm, pn; bool have;
    __device__ __forceinline__ bool next(int i, pg8::Unit& u) const { if (i > 0 || !have) return false; u.pm = pm; u.pn = pn; return true; }
    __device__ __forceinline__ void a_ready(const pg8::Unit&) const {}
    __device__ __forceinline__ void done(const pg8::Unit&) const {}
};
template <int NSL>
__device__ __forceinline__ void ctx_split_gemm(const Frame& F, const bf16* A, const bf16* Bt, int ldk, bf16* resp) {
    const int c = blockIdx.x; OneUnit S; S.have = c < 16 * NSL; const int sl = c >> 4; S.pm = (MLAT / 256) + ((c & 15) >> 2); S.pn = c & 3;
    pg8::Gemm g{A + sl * 256, Bt + sl * 256, MT, DM, 256, ldk};
    EpiStore E{resp + (size_t)sl * MCTX * DM - (size_t)MLAT * DM, DM};
    pg8::gemm_phase<EpiStore, OneUnit, true, true>((PG8_LAS unsigned char*)F.lds, g, S, E, F.tid);
}

__device__ __forceinline__ Frame mkframe(unsigned char* lds_raw, int wv) {
    Frame Fr; asm volatile("" : "+s"(wv)); int ln = (int)__builtin_amdgcn_mbcnt_hi(~0u, __builtin_amdgcn_mbcnt_lo(~0u, 0u)); asm volatile("" : "+v"(ln));
    Fr.lds = (LAS unsigned char*)lds_raw; Fr.lane = ln; Fr.wave = wv; Fr.tid = wv * 64 + ln;
    Fr.gw = blockIdx.x * NWAVES + wv; Fr.ngw = gridDim.x * NWAVES; return Fr;
}
__device__ __forceinline__ const Params& getP() { const Params* kp = (const Params*)__builtin_amdgcn_kernarg_segment_ptr(); asm volatile("" : "+s"(kp)); return *kp; }
#define PP getP()
#define WSP(off) (getP().ws + (off))
#define F mkframe(lds_raw, wv0)
#define GRID_SYNC() do { XcdBarrier bb; bb.bar = (unsigned*)WSP(WS_CTL); bb.x = xb_xcc_id(); bb.st = (volatile LAS unsigned*)((LAS unsigned char*)lds_raw + LDS_CTL_OFF); xcd_barrier(bb, F.tid); } while (0)


#ifndef DIAG_TIME
#define DIAG_TIME 0
#endif
#define TSTAMP(k) do { if (DIAG_TIME) { const Frame Ft = F; if (blockIdx.x == 0 && Ft.tid == 0) ((unsigned long long*)(WSP(WS_CTL) + 32768))[k] = __builtin_amdgcn_s_memrealtime(); } } while (0)
#ifndef DIAG_REPEAT
#define DIAG_REPEAT 0
#endif
#ifndef DIAG_STOP
#define DIAG_STOP 0
#endif
__device__ __forceinline__ void diag_dump(const Frame& Fr, const Params& P, const bf16* src, int ld, int ncols) {
    for (size_t i = (size_t)Fr.gw * 64 + Fr.lane; i < (size_t)MLAT * DM; i += (size_t)Fr.ngw * 64) { const size_t row = i >> 10; const int c = (int)(i & 1023);
        float v = bf2f(src[row * ld + (c % ncols)]); v = (__builtin_fabsf(v) < 1e30f) ? v : 12345.f; P.out[i] = v; }
}

__device__ __forceinline__ void diag_dump3(const Frame& Fr, const Params& P, int mode) {
    const bf16* ypre = (const bf16*)(P.ws + WS_U + OV_YPRE); const bf16* yf = (const bf16*)(P.ws + WS_RES + SZ_256); const bf16* yn = (const bf16*)(P.ws + WS_RES + 2 * SZ_256);
    for (size_t i = (size_t)Fr.gw * 64 + Fr.lane; i < (size_t)MLAT * DM; i += (size_t)Fr.ngw * 64) { const size_t row = i >> 10; const int c = (int)(i & 1023);
        float v = 0.f;
        if (c < 256) { if (mode & 1) v = bf2f(ypre[row * 256 + c]); } else if (c < 512) { if (mode & 2) v = bf2f(yf[row * 256 + c - 256]); } else { if (mode & 4) v = bf2f(yn[row * 512 + c - 512]); }
        v = (__builtin_fabsf(v) < 1e30f) ? v : 12345.f; P.out[i] = v; }
}
#define DIAG_AT(n, src, ld, ncols) do { if (DIAG_STOP == (n)) { GRID_SYNC(); diag_dump(F, PP, (const bf16*)(src), ld, ncols); return true; } } while (0)
template <int l>
__device__ __forceinline__ bool layer_body(unsigned char* lds_raw, const int wv0) {
    constexpr bool last = (l == DEPTH - 1);

        const int Mx = last ? MLAT : MT;
        run_gemm(F, (const bf16*)WSP(WS_U), (const bf16*)WSP(WS_WA + WA_GU), MT, 2 * DFF, DM, EpiGU{(bf16*)WSP(WS_Z)});
        if (l == 0 && DIAG_REPEAT == 6) run_gemm(F, (const bf16*)WSP(WS_U), (const bf16*)WSP(WS_WA + WA_GU), MT, 2 * DFF, DM, EpiGU{(bf16*)WSP(WS_Z)});
        if (l == 0) DIAG_AT(2, WSP(WS_Z), DFF, 1024);
        GRID_SYNC();
        run_gemm(F, (const bf16*)WSP(WS_Z), (const bf16*)WSP(WS_WA + WA_DN), MT, DM, DFF, EpiStore{(bf16*)WSP(WS_RES), DM});
        if (l == 0) DIAG_AT(3, WSP(WS_RES), DM, 1024);
        GRID_SYNC();
        rowwise_phase<1>(F, PP, l, 2, 0.5f, 0, l, 3, true, l == 0, MT, 1);
        GRID_SYNC();
        run_gemm(F, (const bf16*)WSP(WS_U), (const bf16*)WSP(WS_WB + WB_IN), MT, WIN, DM, EpiWin{WSP(WS_Z), (const float*)WSP(WS_TBL + T_ROPE)});
        if (l == 0) DIAG_AT(5, WSP(WS_Z + Z_K), 512, 512);
        if (l == 0) DIAG_AT(6, WSP(WS_Z + Z_G), 3072, 1024);
        GRID_SYNC();
        if (l == 0) TSTAMP(1);
        {
            const Frame Fl = F;
            LAS float* rpb = (LAS float*)(Fl.lds + 8 * 16384);
            for (int i = Fl.tid; i < 8 * 15 * 32; i += NTHREADS) rpb[i] = ((i & 31) < 31) ? PP.in[22][l * 8 * 15 * 31 + (i >> 5) * 31 + (i & 31)] : -1e30f;
            LAS unsigned* qc = (LAS unsigned*)(Fl.lds + LDS_CTL_OFF) + 8;
            if (Fl.tid < 4) qc[Fl.tid] = 0u;
            __syncthreads();
            const int n_fa = 4096, n_fac = last ? 0 : 128, n_s5a = 4 * 16 * NCHUNK * 2;
            const int e0 = n_fa, e1 = e0 + n_fac, e2 = e1 + n_s5a;
            for (int it = q_next_lds(qc, Fl.lane); it < e1; it = q_next_lds(qc, Fl.lane)) { if (it < e0) fnet_a<64, 128>(PP, it, Fl.lane); else fnet_a<16, 16>(PP, it - e0, Fl.lane); }
            for (int it = q_next_lds(qc + 1, Fl.lane); it < n_s5a / 4; it = q_next_lds(qc + 1, Fl.lane)) s5_pass_a<4>(PP, it, Fl.lane);
        }
        GRID_SYNC();
        if (l == 0) TSTAMP(2);
        {
            const Frame Fl = F;
            LAS float* rpb = (LAS float*)(Fl.lds + 8 * 16384);
            const int n_b = 128, n_att = 16384, n_attc = last ? 0 : 512, n_fc = 2048, n_fcc = last ? 0 : 512;
            const int e0 = n_b, e1 = e0 + n_att, e2 = e1 + n_attc, e3 = e2 + n_fc, e4 = e3 + n_fcc;
            LAS unsigned* qc = (LAS unsigned*)(Fl.lds + LDS_CTL_OFF) + 8;
            for (int it = q_next_lds(qc + 2, Fl.lane); it < e4; it = q_next_lds(qc + 2, Fl.lane)) {
                if (it < e0) s5_pass_b(PP, it, Fl.lane);
                else if (it < e1) attn_item<false>(PP, rpb, it - e0, Fl.lane);
                else if (it < e2) attn_item<true>(PP, rpb, it - e1, Fl.lane);
                else if (it < e3) fnet_c<64, 128>(PP, it - e2, Fl.lane);
                else fnet_c<16, 16>(PP, it - e3, Fl.lane);
            }
        }
        GRID_SYNC();
        if (l == 0) TSTAMP(3);
        {
            const Frame Fl = F;
            const int nck = last ? 128 : NCHUNK, ck0 = last ? 4 : 0, n_c = 64 * nck;
            LAS unsigned* qc = (LAS unsigned*)(Fl.lds + LDS_CTL_OFF) + 8;
            const int n_lat = 64 * 64, n_ctx = last ? 0 : 64 * 4;
            for (int it = q_next_lds(qc + 3, Fl.lane); it < n_lat + n_ctx; it = q_next_lds(qc + 3, Fl.lane)) {
                if (it < n_lat) s5_pass_c<2>(PP, l, it, 128, 4, Fl.lane); else s5_pass_c<1>(PP, l, it - n_lat, 4, 0, Fl.lane); }
        }
        GRID_SYNC();
        if (l == 0) TSTAMP(4);
        {
            const int nun = Mx / 256;
            if ((int)blockIdx.x >= nun && (int)gridDim.x > nun) { Frame Fc = F; Fc.gw = ((int)blockIdx.x - nun) * NWAVES + Fc.wave; Fc.ngw = ((int)gridDim.x - nun) * NWAVES; convert_ffn(Fc, PP, l, 1); }
            else if ((int)gridDim.x <= nun) convert_ffn(F, PP, l, 1);
        }
        run_gemm(F, (const bf16*)WSP(WS_U + OV_YPRE), (const bf16*)WSP(WS_WB + WB_GLU), Mx, 256, 256, EpiGLU{(const bf16*)WSP(WS_U + OV_YPRE), PP.in[21] + l * 256, (bf16*)WSP(WS_RES)});
        GRID_SYNC();
        run_gemm(F, (const bf16*)WSP(WS_RES), (const bf16*)WSP(WS_WB + WB_BRS), Mx, DM, DM, EpiMergeK{(const bf16*)WSP(WS_Z + Z_G), (bf16*)WSP(WS_Z + Z_K)});
        GRID_SYNC();
        run_gemm(F, (const bf16*)WSP(WS_Z + Z_K), (const bf16*)WSP(WS_WB + WB_OUT), Mx, DM, DM, EpiStore{(bf16*)WSP(WS_RES), DM});
        if (l == 0) DIAG_AT(22, WSP(WS_RES), DM, 1024);
        GRID_SYNC();
        rowwise_phase<1>(F, PP, l, 5, 1.0f, 1, l, 6, true, false, Mx, 1);
        if (l == 0) DIAG_AT(23, WSP(WS_U), DM, 1024);
        GRID_SYNC();
        run_gemm(F, (const bf16*)WSP(WS_U), (const bf16*)WSP(WS_WA + WA_GU), Mx, 2 * DFF, DM, EpiGU{(bf16*)WSP(WS_Z)});
        GRID_SYNC();
        run_gemm(F, (const bf16*)WSP(WS_Z), (const bf16*)WSP(WS_WA + WA_DN), Mx, DM, DFF, EpiStore{(bf16*)WSP(WS_RES), DM});
        if (l == 0) DIAG_AT(24, WSP(WS_RES), DM, 1024);
        GRID_SYNC();
        rowwise_phase<1>(F, PP, l, 8, 0.5f, 2, last ? l : l + 1, 0, !last, false, Mx, 1);
        if (!last) { convert_ffn(F, PP, l + 1, 0); convert_mixer(F, PP, l + 1); make_s5_tables(F, PP, l + 1); GRID_SYNC(); }
        return false;
}
__global__ void __launch_bounds__(NTHREADS, 2) hybrid_fwd(Params Parg) {
    extern __shared__ __attribute__((aligned(16))) unsigned char lds_raw[];
    cg::grid_group grid = cg::this_grid();
    const int wv0 = __builtin_amdgcn_readfirstlane((int)threadIdx.x >> 6);
    {
        const int t0 = threadIdx.x;
        if (t0 < 32) ((LAS unsigned*)(lds_raw))[LDS_CTL_OFF / 4 + t0] = 0u;
        if (blockIdx.x == 0) { unsigned* ctlw = (unsigned*)(getP().ws + WS_CTL); for (int i = t0; i < (int)(CTL_BYTES / 4); i += NTHREADS) __hip_atomic_store(ctlw + i, 0u, __ATOMIC_RELAXED, __HIP_MEMORY_SCOPE_AGENT); }
        __threadfence();
        __syncthreads();
        grid.sync();
    }
    XcdBarrier bar = xcd_barrier_post((unsigned*)WSP(WS_CTL), (volatile LAS unsigned*)((LAS unsigned char*)lds_raw + LDS_CTL_OFF), F.tid);
    (void)bar;
    TSTAMP(0);
#if defined(DIAG_BARTEST)
    {
        unsigned* slots = (unsigned*)(WSP(WS_Z));
        unsigned* errs = (unsigned*)(WSP(WS_CTL)) + 12288;
        unsigned bad = 0;
        for (int rnd = 1; rnd <= 64; ++rnd) {
            const Frame Fb = F;
            if ((blockIdx.x + rnd) % 7 == 0) { for (int d = 0; d < 2000; ++d) __builtin_amdgcn_s_sleep(20); }
            for (int i = Fb.tid; i < 4096; i += NTHREADS) slots[(size_t)blockIdx.x * 4096 + i] = (unsigned)(rnd * 65536 + blockIdx.x * 16 + (i & 15));
            GRID_SYNC();
            for (int j = 0; j < 8; ++j) { const int ob = (blockIdx.x * 37 + j * 31 + rnd) % (int)gridDim.x;
                for (int i = Fb.tid; i < 4096; i += NTHREADS) { const unsigned v = slots[(size_t)ob * 4096 + i]; if (v != (unsigned)(rnd * 65536 + ob * 16 + (i & 15))) ++bad; } }
            GRID_SYNC();
        }
        if (bad) atomicAdd(errs, bad);
        GRID_SYNC();
        const Frame Fd = F; const unsigned e = __hip_atomic_load(errs, __ATOMIC_RELAXED, __HIP_MEMORY_SCOPE_AGENT);
        float* o = getP().out;
        for (size_t i = (size_t)Fd.gw * 64 + Fd.lane; i < (size_t)MLAT * DM; i += (size_t)Fd.ngw * 64) o[i] = (i == 0 && e) ? 4096.f : 0.f;
        return;
    }
#endif
    mod_phase(F, PP);
    convert_ffn(F, PP, 0, 0); convert_mixer(F, PP, 0); make_s5_tables(F, PP, 0); make_static_tables(F, PP);
    if (DIAG_REPEAT == 8) { convert_ffn(F, PP, 0, 0); convert_mixer(F, PP, 0); }
    if (DIAG_REPEAT == 7) { for (int k = 0; k < 10; ++k) GRID_SYNC(); }
    if (DIAG_REPEAT == 9) { mod_phase(F, PP); make_s5_tables(F, PP, 0); make_static_tables(F, PP); }
    GRID_SYNC();
    rowwise_phase<0>(F, PP, 0, 0, 0.f, 0, 0, 0, true, true, MT, 1);
    GRID_SYNC();
    if (DIAG_STOP == 1) { GRID_SYNC(); diag_dump(F, PP, (const bf16*)WSP(WS_U), DM, 1024); return; }

    if (layer_body<0>(lds_raw, wv0)) return;
    if (layer_body<1>(lds_raw, wv0)) return;
    if (DIAG_TIME) {
        TSTAMP(5); GRID_SYNC();
        const Frame Fd = F; const unsigned long long* ts = (const unsigned long long*)(WSP(WS_CTL) + 32768);
        const float X = exp2f(floorf(log2f((float)(ts[DIAG_TX1] - ts[DIAG_TX0]) * 0.01f)));
        const float C = floorf(2.f * log2f((float)(ts[DIAG_TC1] - ts[DIAG_TC0]) * 0.01f));
        float* o = getP().out;
        for (size_t i = (size_t)Fd.gw * 64 + Fd.lane; i < (size_t)MLAT * DM; i += (size_t)Fd.ngw * 64) o[i] = (i == 0) ? X : C;
    }
}

extern "C" void kernel_launch(void* const* d_in, const int* in_sizes, int n_in, void* d_out, int out_size, void* d_ws, size_t ws_size, hipStream_t stream) {
    static int grid_blocks = 0;
    if (grid_blocks == 0) {
        if (n_in != 27 || ws_size < WS_END) { fprintf(stderr, "kernel_launch: unexpected n_in %d or ws_size %zu (< %zu)\n", n_in, ws_size, (size_t)WS_END); grid_blocks = -1; return; }
        int dev = 0, cus = 0, per_cu = 0;
        hipGetDevice(&dev); hipDeviceGetAttribute(&cus, hipDeviceAttributeMultiprocessorCount, dev);
        hipFuncSetAttribute((const void*)hybrid_fwd, hipFuncAttributeMaxDynamicSharedMemorySize, LDS_BYTES);
        if (hipOccupancyMaxActiveBlocksPerMultiprocessor(&per_cu, (const void*)hybrid_fwd, NTHREADS, LDS_BYTES) != hipSuccess || per_cu < 1) per_cu = 1;
        (void)hipGetLastError();
        grid_blocks = cus * 1;
    }
    if (grid_blocks < 0) return;
    hipMemsetAsync((char*)d_ws + WS_CTL, 0, CTL_BYTES, stream);
    Params p{};
    for (int i = 0; i < 27; ++i) p.in[i] = (const float*)d_in[i];
    p.out = (float*)d_out; p.ws = (unsigned char*)d_ws;
    void* args[] = {&p};
    hipError_t e = hipLaunchCooperativeKernel((const void*)hybrid_fwd, dim3(grid_blocks), dim3(NTHREADS), args, LDS_BYTES, stream);
    if (e != hipSuccess) fprintf(stderr, "cooperative launch failed: %s (grid %d)\n", hipGetErrorString(e), grid_blocks);
}
```

```cpp
#define DIAG_STOP 0
#define DIAG_TX0 0
#define DIAG_TX1 5
#define DIAG_TC0 1
#define DIAG_TC1 2
#define DIAG_REPEAT 0
#include <hip/hip_runtime.h>
#include <hip/hip_cooperative_groups.h>
#include <cstdio>
#include <cstdint>
namespace pg8 {
#define PG8_LAS __attribute__((address_space(3)))
typedef unsigned short bf16_t;
typedef short bf16x8 __attribute__((ext_vector_type(8)));
typedef float f32x4 __attribute__((ext_vector_type(4)));
typedef unsigned u32x4 __attribute__((ext_vector_type(4)));
constexpr int BM = 256, BK = 64, HALF = 128, HTB = HALF * BK * 2  , STAGE_BYTES = 8 * HTB, NXCD = 8, WGM = 8;

__host__ __device__ __forceinline__ int lds_byte(int r, int c) { const int st = (r >> 4) * 2 + (c >> 5), rr = r & 15, cc = c & 31, ob = rr * 64 + cc * 2; return st * 1024 + (ob ^ (((ob >> 9) & 1) << 5)); }
__host__ __device__ __forceinline__ void stage_rc(int b, int& R, int& C) { const int st = b / 1024, sb = b % 1024, swz = sb ^ (((sb >> 9) & 1) << 5); R = (st >> 1) * 16 + swz / 64; C = (st & 1) * 32 + (swz % 64) / 2; }
__host__ __device__ __forceinline__ int perm32(int rho) { const int n = rho >> 4, i = rho & 15; return 8 * (i >> 2) + 4 * n + (i & 3); }

struct Unit { int pm, pn; };
struct Gemm { const bf16_t* A; const bf16_t* Bt; int M, N, K, ld; };

struct StaticOrder {
    int nM, nN, nwg, G, c;
    __host__ __device__ void init(int M, int N, int G_, int c_) { nM = M / BM; nN = N / BM; nwg = nM * nN; G = G_; c = c_; }
    __host__ __device__ bool next(int i, Unit& u) const {
        const long L = (long)i * G + c; if (L >= nwg) return false;
        int wgid = (int)L; { const int q = nwg / NXCD, r = nwg % NXCD, xcd = wgid % NXCD, off = wgid / NXCD; wgid = (xcd < r ? xcd * (q + 1) : r * (q + 1) + (xcd - r) * q) + off; }
        const int nig = WGM * nN, gid = wgid / nig, fm = gid * WGM, gsz = (nM - fm) < WGM ? (nM - fm) : WGM;
        u.pm = fm + ((wgid % nig) % gsz); u.pn = (wgid % nig) / gsz; return true;
    }
    __device__ __forceinline__ void a_ready(const Unit&) const {}
    __device__ __forceinline__ void done(const Unit&) const {}
};

__device__ __forceinline__ unsigned cvt_pk_bf16(float lo, float hi) { unsigned r; asm volatile("v_cvt_pk_bf16_f32 %0, %1, %2" : "=v"(r) : "v"(lo), "v"(hi)); return r; }
typedef float f32x2 __attribute__((ext_vector_type(2)));
template <class Epi, class Sched, bool ALIGN_EPI = false, bool SP2 = false>
__device__ __forceinline__ void gemm_phase(PG8_LAS unsigned char* lds, const Gemm g, const Sched& S, const Epi& E, int tid_in) {
    int tid_l = tid_in; asm volatile("" : "+v"(tid_l));
    const int tid = tid_l, wid = __builtin_amdgcn_readfirstlane(tid >> 6), lane = tid & 63, wr = wid >> 2, wc = wid & 3, fr = lane & 15, fq = lane >> 4;
    const int K = g.K, nt = K / BK;
    unsigned voffA[2], voffB[2];
#pragma unroll
    for (int i = 0; i < 2; ++i) { int R, C; stage_rc(tid * 16 + i * 8192, R, C); const int Rb = Epi::PERM ? ((R & ~31) + perm32(R & 31)) : R;
        voffA[i] = (unsigned)(R * g.ld + C) * 2u; voffB[i] = (unsigned)(Rb * g.ld + C) * 2u; }
    const size_t kstep = (size_t)(BK * 2);
    const size_t hstep = (size_t)HALF * g.ld * 2;
    const size_t tstep = 2 * hstep;
    const unsigned ldsw = (unsigned)wid * 1024u;
    const int aoff = lds_byte(wr * 64 + fr, fq * 8), boff = lds_byte(wc * 32 + fr, fq * 8);
#define PG8_SA(b, h) (((b) * 2 + (h)) * HTB)
#define PG8_SB(b, h) ((4 + (b) * 2 + (h)) * HTB)
#define PG8_STAGE(bufoff, gbase, voff) do { _Pragma("unroll") for (int _i = 0; _i < 2; ++_i) \
        __builtin_amdgcn_global_load_lds((const unsigned*)((const char*)(gbase) + (voff)[_i]), (PG8_LAS unsigned*)(lds + (bufoff) + ldsw + _i * 8192), 16, 0, 0); } while (0)
#define PG8_LDA(dst, b, h) do { _Pragma("unroll") for (int m = 0; m < 4; ++m) _Pragma("unroll") for (int k = 0; k < 2; ++k) dst[m][k] = *(const PG8_LAS bf16x8*)(lds + PG8_SA(b, h) + aoff + m * 2048 + k * 1024); } while (0)
#define PG8_LDB(dst, b, h) do { _Pragma("unroll") for (int n = 0; n < 2; ++n) _Pragma("unroll") for (int k = 0; k < 2; ++k) dst[n][k] = *(const PG8_LAS bf16x8*)(lds + PG8_SB(b, h) + boff + n * 2048 + k * 1024); } while (0)
#define PG8_MMA(ai, bj, At, Bt) do { __builtin_amdgcn_s_setprio(1); _Pragma("unroll") for (int m = 0; m < 4; ++m) _Pragma("unroll") for (int n = 0; n < 2; ++n) _Pragma("unroll") for (int k = 0; k < 2; ++k) \
        acc[ai][bj][m][n] = __builtin_amdgcn_mfma_f32_16x16x32_bf16(Bt[n][k], At[m][k], acc[ai][bj][m][n], 0, 0, 0); __builtin_amdgcn_s_setprio(0); } while (0)
#define PG8_WAIT_V(n) asm volatile("s_waitcnt vmcnt(" #n ")" ::: "memory")
#define PG8_WAIT_L(n) asm volatile("s_waitcnt lgkmcnt(" #n ")" ::: "memory")
#define PG8_BAR __builtin_amdgcn_s_barrier()
#define PG8_SCHED __builtin_amdgcn_sched_barrier(0)
    Unit cur, nxt; int ui = 0;
    if (!S.next(0, cur)) return;
    f32x4 acc[2][2][4][2];
#pragma unroll
    for (int a = 0; a < 2; ++a)
#pragma unroll
        for (int b = 0; b < 2; ++b)
#pragma unroll
            for (int m = 0; m < 4; ++m)
#pragma unroll
                for (int n = 0; n < 2; ++n) acc[a][b][m][n] = (f32x4){0.f, 0.f, 0.f, 0.f};
    bf16x8 At[4][2], B0[2][2], B1[2][2];
    const char* cA = (const char*)g.A + (size_t)cur.pm * tstep; const char* cB = (const char*)g.Bt + (size_t)cur.pn * tstep;
    S.a_ready(cur);
    if constexpr (SP2) {
        PG8_STAGE(PG8_SB(0, 0), cB, voffB); PG8_STAGE(PG8_SB(0, 1), cB + hstep, voffB); PG8_STAGE(PG8_SA(0, 0), cA, voffA); PG8_STAGE(PG8_SA(0, 1), cA + hstep, voffA);
        if (wr == 1) PG8_BAR;
        PG8_WAIT_V(2); PG8_BAR;
        PG8_STAGE(PG8_SB(1, 0), cB + kstep, voffB); PG8_STAGE(PG8_SA(1, 0), cA + kstep, voffA); PG8_STAGE(PG8_SB(1, 1), cB + hstep + kstep, voffB);
        PG8_WAIT_V(6); PG8_BAR;
    } else {
        PG8_STAGE(PG8_SB(0, 0), cB, voffB); PG8_STAGE(PG8_SA(0, 0), cA, voffA); PG8_STAGE(PG8_SB(0, 1), cB + hstep, voffB); PG8_STAGE(PG8_SA(0, 1), cA + hstep, voffA);
        if (wr == 1) PG8_BAR;
        PG8_WAIT_V(4); PG8_BAR;
        PG8_STAGE(PG8_SB(1, 0), cB + kstep, voffB); PG8_STAGE(PG8_SA(1, 0), cA + kstep, voffA); PG8_STAGE(PG8_SB(1, 1), cB + hstep + kstep, voffB);
        PG8_WAIT_V(6); PG8_BAR;
    }
#pragma unroll 1
    for (;;) {
        const bool has_next = S.next(ui + 1, nxt);
        const char* nA = has_next ? (const char*)g.A + (size_t)nxt.pm * tstep : cA; const char* nB = has_next ? (const char*)g.Bt + (size_t)nxt.pn * tstep : cB;
#pragma unroll 1
        for (int t = 0; t < nt; t += 2) {
            const bool last = (t == nt - 2);
            const char* a1 = cA + (size_t)(t + 1) * kstep;
            const char* a2 = last ? nA : cA + (size_t)(t + 2) * kstep; const char* b2 = last ? nB : cB + (size_t)(t + 2) * kstep;
            const char* a3 = a2 + kstep; const char* b3 = b2 + kstep;
            if (last && has_next) S.a_ready(nxt);
            if constexpr (Epi::KHOOK) { if (t == 4 || t == 8) E.khook(acc, cur, wr, wc, fr, fq, t); }
            if constexpr (SP2) {
            PG8_LDB(B0, 0, 0); PG8_LDB(B1, 0, 1); PG8_SCHED; PG8_LDA(At, 0, 0); PG8_STAGE(PG8_SA(1, 1), a1 + hstep, voffA);
            PG8_WAIT_V(8); PG8_WAIT_L(0); PG8_BAR; PG8_MMA(0, 0, At, B0); PG8_MMA(0, 1, At, B1); PG8_BAR; PG8_SCHED;
            PG8_LDA(At, 0, 1); PG8_STAGE(PG8_SB(0, 0), b2, voffB); PG8_STAGE(PG8_SB(0, 1), b2 + hstep, voffB); PG8_STAGE(PG8_SA(0, 0), a2, voffA);
            PG8_WAIT_V(8); PG8_WAIT_L(0); PG8_BAR; PG8_MMA(1, 0, At, B0); PG8_MMA(1, 1, At, B1); PG8_BAR; PG8_SCHED;
            PG8_LDB(B0, 1, 0); PG8_LDB(B1, 1, 1); PG8_SCHED; PG8_LDA(At, 1, 0); PG8_STAGE(PG8_SA(0, 1), a2 + hstep, voffA);
            PG8_WAIT_V(8); PG8_WAIT_L(0); PG8_BAR; PG8_MMA(0, 0, At, B0); PG8_MMA(0, 1, At, B1); PG8_BAR; PG8_SCHED;
            PG8_LDA(At, 1, 1); PG8_STAGE(PG8_SB(1, 0), b3, voffB); PG8_STAGE(PG8_SB(1, 1), b3 + hstep, voffB); PG8_STAGE(PG8_SA(1, 0), a3, voffA);
            PG8_WAIT_V(8); PG8_WAIT_L(0); PG8_BAR; PG8_MMA(1, 0, At, B0); PG8_MMA(1, 1, At, B1); PG8_BAR; PG8_SCHED;
            } else {
            PG8_LDB(B0, 0, 0); PG8_SCHED; PG8_LDA(At, 0, 0); PG8_STAGE(PG8_SA(1, 1), a1 + hstep, voffA);
            PG8_WAIT_L(8); PG8_BAR; PG8_WAIT_L(0); PG8_MMA(0, 0, At, B0); PG8_BAR; PG8_SCHED;
            PG8_LDB(B1, 0, 1); PG8_STAGE(PG8_SB(0, 0), b2, voffB);
            PG8_BAR; PG8_WAIT_L(0); PG8_MMA(0, 1, At, B1); PG8_BAR;
            PG8_LDA(At, 0, 1); PG8_STAGE(PG8_SA(0, 0), a2, voffA);
            PG8_BAR; PG8_WAIT_L(0); PG8_MMA(1, 0, At, B0); PG8_BAR; PG8_SCHED;
            PG8_STAGE(PG8_SB(0, 1), b2 + hstep, voffB);
            PG8_WAIT_V(6); PG8_BAR; PG8_MMA(1, 1, At, B1); PG8_BAR;
            PG8_LDB(B0, 1, 0); PG8_SCHED; PG8_LDA(At, 1, 0); PG8_STAGE(PG8_SA(0, 1), a2 + hstep, voffA);
            PG8_WAIT_L(8); PG8_BAR; PG8_WAIT_L(0); PG8_MMA(0, 0, At, B0); PG8_BAR; PG8_SCHED;
            PG8_LDB(B1, 1, 1); PG8_STAGE(PG8_SB(1, 0), b3, voffB);
            PG8_BAR; PG8_WAIT_L(0); PG8_MMA(0, 1, At, B1); PG8_BAR;
            PG8_LDA(At, 1, 1); PG8_STAGE(PG8_SA(1, 0), a3, voffA);
            PG8_BAR; PG8_WAIT_L(0); PG8_MMA(1, 0, At, B0); PG8_BAR; PG8_SCHED;
            PG8_STAGE(PG8_SB(1, 1), b3 + hstep, voffB);
            PG8_WAIT_V(6); PG8_BAR; PG8_MMA(1, 1, At, B1); PG8_BAR;
            }
        }
        if constexpr (ALIGN_EPI) { if (wr == 0) PG8_BAR; }
        if constexpr (!Epi::AFTER_DRAIN) { E(acc, cur, wr, wc, fr, fq); S.done(cur); }
        if (!has_next) break;
#pragma unroll
        for (int a = 0; a < 2; ++a)
#pragma unroll
            for (int b = 0; b < 2; ++b)
#pragma unroll
                for (int m = 0; m < 4; ++m)
#pragma unroll
                    for (int n = 0; n < 2; ++n) acc[a][b][m][n] = (f32x4){0.f, 0.f, 0.f, 0.f};
        cur = nxt; cA = nA; cB = nB; ++ui;
        if constexpr (ALIGN_EPI) { if (wr == 1) PG8_BAR; }
    }
    PG8_WAIT_V(0);
    if constexpr (!ALIGN_EPI) { if (wr == 0) PG8_BAR; }
    PG8_BAR;
    if constexpr (Epi::AFTER_DRAIN) { E.fused(acc, cur, wr, wc, fr, fq, lds, wid, lane); S.done(cur); }
#undef PG8_SA
#undef PG8_SB
#undef PG8_STAGE
#undef PG8_LDA
#undef PG8_LDB
#undef PG8_MMA
#undef PG8_WAIT_V
#undef PG8_WAIT_L
#undef PG8_BAR
#undef PG8_SCHED
}
}
namespace cg = cooperative_groups;
#define LAS __attribute__((address_space(3)))
typedef unsigned short bf16;
typedef short bf16x8 __attribute__((ext_vector_type(8)));
typedef float f32x4 __attribute__((ext_vector_type(4)));
typedef unsigned u32x4 __attribute__((ext_vector_type(4)));
typedef unsigned u32x2 __attribute__((ext_vector_type(2)));

constexpr int DM = 1024, NB = 4, SEQ = 8192, DEPTH = 2, CTXL = 256;
constexpr int MLAT = NB * SEQ, MCTX = NB * CTXL, MT = MLAT + MCTX;
constexpr int DFF = 2816, NMOD = 9, WIN = 5120;
constexpr int NTHREADS = 512, NWAVES = 8;
constexpr float LN_EPS = 1e-6f;
constexpr float DN_ALPHA = 1.41421356237309515f;
constexpr int NCHUNK = 132;
constexpr float TWO_PI = 6.283185307179586f;

constexpr size_t al256(size_t x) { return (x + 255) & ~(size_t)255; }
constexpr size_t WS_CTL = 0, CTL_BYTES = 65536;
constexpr size_t WS_MOD = WS_CTL + CTL_BYTES;
constexpr size_t WS_HC = al256(WS_MOD + (size_t)DEPTH * 5 * 9216 * 4);
constexpr size_t WS_TBL = WS_HC + (size_t)MCTX * DM * 4;
constexpr size_t T_PNEG = 0;
constexpr size_t T_PPOS = T_PNEG + 2 * 16 * 2 * 64 * 64 * 4;
constexpr size_t T_BBT = T_PPOS + 2 * 16 * 2 * 64 * 64 * 4;
constexpr size_t T_CCT = T_BBT + 2 * 16 * 128 * 16 * 2;
constexpr size_t T_APOW = T_CCT + 2 * 16 * 4 * 16 * 32 * 2;
constexpr size_t T_WCB = T_APOW + 3 * 2 * 16 * 2 * 64 * 4;
constexpr size_t T_FA64 = T_WCB + 128 * 64 * 2;
constexpr size_t T_FA16 = T_FA64 + 2 * 64 * 4 * 32 * 2;
constexpr size_t T_FC128 = T_FA16 + 2 * 16 * 32 * 2;
constexpr size_t T_FC16 = T_FC128 + 128 * 256 * 2;
constexpr size_t T_ROPE = T_FC16 + 16 * 32 * 2;
constexpr size_t T_END = T_ROPE + 2 * 128 * 16 * 4;
constexpr size_t WS_SLOC = al256(WS_TBL + T_END);
constexpr size_t WS_WA = al256(WS_SLOC + (size_t)4 * 16 * 2 * NCHUNK * 128 * 4);
constexpr size_t WA_GU = 0, WA_DN = (size_t)5632 * 1024 * 2, WA_BYTES = WA_DN + (size_t)1024 * 2816 * 2;
constexpr size_t WS_WB = al256(WS_WA + WA_BYTES);
constexpr size_t WB_IN = 0, WB_GLU = WB_IN + (size_t)WIN * 1024 * 2, WB_BRS = WB_GLU + 256 * 256 * 2, WB_BRF = WB_BRS + 1024 * 256 * 2,
                 WB_BRN = WB_BRF + 1024 * 256 * 2, WB_OUT = WB_BRN + 1024 * 512 * 2, WB_BYTES = WB_OUT + 1024 * 1024 * 2;
constexpr size_t WS_U = al256(WS_WB + WB_BYTES);
constexpr size_t SZ_U = (size_t)MT * 1024 * 2;
constexpr size_t WS_RES = WS_U + SZ_U;
constexpr size_t WS_Z = WS_RES + SZ_U;
constexpr size_t SZ_256 = (size_t)MT * 256 * 2, SZ_512 = (size_t)MT * 512 * 2;
constexpr int VLD = SEQ;
constexpr size_t SZ_VT = al256((size_t)NB * 512 * VLD * 2 + (size_t)NB * 512 * CTXL * 2);
constexpr size_t Z_K = 0, Z_Q = Z_K + SZ_512, Z_VT = Z_Q + SZ_512, Z_SSMU = Z_VT + SZ_VT, Z_F = Z_SSMU + SZ_256, Z_G = Z_F + SZ_256, Z_END = Z_G + (size_t)MT * 3072 * 2;
constexpr size_t WS_END = WS_Z + Z_END;
constexpr size_t OV_YPRE = 0, OV_TBL = SZ_256, OV_TBC = OV_TBL + (size_t)16 * 64 * 2 * 64 * 128 * 2;
static_assert(OV_TBC + (size_t)16 * 16 * 2 * 64 * 16 * 2 <= SZ_U, "U overlay");
static_assert(SZ_256 * 2 + SZ_512 == SZ_U, "RES overlay");
constexpr size_t RESP_OFF = al256((size_t)MT * 2816 * 2);
static_assert(RESP_OFF + (size_t)11 * MCTX * DM * 2 <= Z_END, "ACT + RESP overlay");
static_assert(WS_END <= (size_t)536870912, "d_ws map exceeds 512 MiB");

#define QCTR(l, s) (4096 + 64 * (1 + (l) * 3 + (s)))

__device__ __forceinline__ unsigned f2bf(float f) { unsigned u = __builtin_bit_cast(unsigned, f); return (u + 0x7fffu + ((u >> 16) & 1u)) >> 16; }
__device__ __forceinline__ float bf2f(unsigned b) { return __builtin_bit_cast(float, b << 16); }
typedef __bf16 bf16x2_t __attribute__((ext_vector_type(2)));
typedef float f32x2_t __attribute__((ext_vector_type(2)));
__device__ __forceinline__ unsigned pk2(float lo, float hi) { const f32x2_t v = {lo, hi}; const bf16x2_t r = __builtin_convertvector(v, bf16x2_t); return __builtin_bit_cast(unsigned, r); }
__device__ __forceinline__ float bflo(unsigned w) { return __builtin_bit_cast(float, w << 16); }
__device__ __forceinline__ float bfhi(unsigned w) { return __builtin_bit_cast(float, w & 0xffff0000u); }
__device__ __forceinline__ float fsigmoid(float x) { return __builtin_amdgcn_rcpf(1.f + __expf(-x)); }
__device__ __forceinline__ float fsilu(float x) { return x * fsigmoid(x); }
__device__ __forceinline__ float gelu_tanh(float x) { const float z = 0.7978845608028654f * (x + 0.044715f * x * x * x); return x * fsigmoid(2.f * z); }
__device__ __forceinline__ f32x4 mfma16(bf16x8 a, bf16x8 b, f32x4 c) { return __builtin_amdgcn_mfma_f32_16x16x32_bf16(a, b, c, 0, 0, 0); }
__device__ __forceinline__ bf16x8 as_bf16x8(u32x4 v) { return __builtin_bit_cast(bf16x8, v); }
__device__ __forceinline__ bf16x8 pack8(f32x4 a, f32x4 b) { u32x4 w; w.x = pk2(a[0], a[1]); w.y = pk2(a[2], a[3]); w.z = pk2(b[0], b[1]); w.w = pk2(b[2], b[3]); return as_bf16x8(w); }
__device__ __forceinline__ float wave_sum(float v) {
#pragma unroll
    for (int o = 1; o < 64; o <<= 1) v += __shfl_xor(v, o);
    return v;
}
constexpr f32x4 F4Z = {0.f, 0.f, 0.f, 0.f};

struct Params {
    const float* in[27];
    float* out;
    unsigned char* ws;
};

struct Frame {
    LAS unsigned char* lds;
    int tid, lane, wave, gw, ngw;
};

__device__ __forceinline__ void tr_item(const float* __restrict__ W, int N, int k0, int n0, bf16* __restrict__ WT, int ldk, int drow0, LAS float* scr, int lane) {
#pragma unroll 8
    for (int i = 0; i < 32; ++i) { const int kk = 2 * i + (lane >> 5); scr[kk * 33 + (lane & 31)] = W[(size_t)(k0 + kk) * N + n0 + (lane & 31)]; }
    asm volatile("s_waitcnt lgkmcnt(0)" ::: "memory");
    const int c = lane & 7;
#pragma unroll
    for (int j = 0; j < 4; ++j) { const int n = (lane >> 3) + 8 * j; const LAS float* s = scr + (8 * c) * 33 + n;
        u32x4 o; o.x = pk2(s[0 * 33], s[1 * 33]); o.y = pk2(s[2 * 33], s[3 * 33]); o.z = pk2(s[4 * 33], s[5 * 33]); o.w = pk2(s[6 * 33], s[7 * 33]);
        *(u32x4*)(WT + (size_t)(drow0 + n) * ldk + k0 + 8 * c) = o; }
    asm volatile("s_waitcnt lgkmcnt(0)" ::: "memory");
}

constexpr int FFN_CONV_ITEMS = 2 * (DM / 64) * (DFF / 32) + (DFF / 64) * (DM / 32);
__device__ __forceinline__ void convert_ffn_item(const Params& P, LAS unsigned char* lds, int wave, int lane, int l, int f, int it) {
    LAS float* scr = (LAS float*)(lds + wave * 16384);
    const float* wg = P.in[8] + (size_t)(l * 2 + f) * DM * DFF;
    const float* wu = P.in[9] + (size_t)(l * 2 + f) * DM * DFF;
    const float* wd = P.in[10] + (size_t)(l * 2 + f) * DFF * DM;
    bf16* gu = (bf16*)(P.ws + WS_WA + WA_GU); bf16* dn = (bf16*)(P.ws + WS_WA + WA_DN);
    constexpr int I_G = (DM / 64) * (DFF / 32);
    int r = it;
    if (r < 2 * I_G) { const int up = r >= I_G; if (up) r -= I_G; const int nblk = DFF / 32, kb = r / nblk, nb = r % nblk, n0 = nb * 32;
        tr_item(up ? wu : wg, DFF, kb * 64, n0, gu, DM, 256 * (n0 / 128) + (n0 % 128) + (up ? 128 : 0), scr, lane); return; }
    r -= 2 * I_G; { const int nblk = DM / 32, kb = r / nblk, nb = r % nblk; tr_item(wd, DM, kb * 64, nb * 32, dn, DFF, nb * 32, scr, lane); }
}
__device__ __forceinline__ void convert_ffn(const Frame& F, const Params& P, int l, int f) {
    for (int it = F.gw; it < FFN_CONV_ITEMS; it += F.ngw) convert_ffn_item(P, F.lds, F.wave, F.lane, l, f, it);
}
__device__ __forceinline__ void convert_mixer(const Frame& F, const Params& P, int l) {
    LAS float* scr = (LAS float*)(F.lds + F.wave * 16384);
    constexpr int I_IN = (DM / 64) * (WIN / 32), I_GLU = 4 * 8, I_BRS = 4 * 32, I_BRF = 4 * 32, I_BRN = 8 * 32, I_OUT = 16 * 32;
    for (int it = F.gw; it < I_IN + I_GLU + I_BRS + I_BRF + I_BRN + I_OUT; it += F.ngw) {
        int r = it;
        if (r < I_IN) { const int nblk = WIN / 32; tr_item(P.in[11] + (size_t)l * DM * WIN, WIN, (r / nblk) * 64, (r % nblk) * 32, (bf16*)(P.ws + WS_WB + WB_IN), DM, (r % nblk) * 32, scr, F.lane); continue; } r -= I_IN;
        if (r < I_GLU) { tr_item(P.in[20] + (size_t)l * 256 * 256, 256, (r / 8) * 64, (r % 8) * 32, (bf16*)(P.ws + WS_WB + WB_GLU), 256, (r % 8) * 32, scr, F.lane); continue; } r -= I_GLU;
        if (r < I_BRS) { tr_item(P.in[23] + (size_t)l * 256 * DM, DM, (r / 32) * 64, (r % 32) * 32, (bf16*)(P.ws + WS_WB + WB_BRS), 1024, (r % 32) * 32, scr, F.lane); continue; } r -= I_BRS;
        if (r < I_BRF) { tr_item(P.in[24] + (size_t)l * 256 * DM, DM, (r / 32) * 64, (r % 32) * 32, (bf16*)(P.ws + WS_WB + WB_BRS) + 256, 1024, (r % 32) * 32, scr, F.lane); continue; } r -= I_BRF;
        if (r < I_BRN) { tr_item(P.in[25] + (size_t)l * 512 * DM, DM, (r / 32) * 64, (r % 32) * 32, (bf16*)(P.ws + WS_WB + WB_BRS) + 512, 1024, (r % 32) * 32, scr, F.lane); continue; } r -= I_BRN;
        tr_item(P.in[26] + (size_t)l * DM * DM, DM, (r / 32) * 64, (r % 32) * 32, (bf16*)(P.ws + WS_WB + WB_OUT), DM, (r % 32) * 32, scr, F.lane);
    }
}

__device__ __forceinline__ void make_s5_tables(const Frame& F, const Params& P, int l) {
    unsigned char* tb = P.ws + WS_TBL;
    float* pneg = (float*)(tb + T_PNEG); float* ppos = (float*)(tb + T_PPOS); bf16* bbt = (bf16*)(tb + T_BBT); bf16* cct = (bf16*)(tb + T_CCT); float* apow = (float*)(tb + T_APOW);
    const float* log_dt = P.in[12] + l * 32; const float* a_re = P.in[13] + l * 2048; const float* a_im = P.in[14] + l * 2048;
    const float* b_re = P.in[15] + (size_t)l * 32768; const float* b_im = P.in[16] + (size_t)l * 32768;
    const float* c_re = P.in[17] + (size_t)l * 32768; const float* c_im = P.in[18] + (size_t)l * 32768;
    const int gt = F.gw * 64 + F.lane, ngt = F.ngw * 64;
    for (int i = gt; i < 32 * 64 * 64; i += ngt) {
        const int t = i & 63, p = (i >> 6) & 63, dg = i >> 12, dir = dg >> 4;
        const float dt = expf(log_dt[dg]), ar = a_re[dg * 64 + p] * dt, ai = a_im[dg * 64 + p] * dt;
        const float e = (float)(dir ? 63 - t : t);
        float sn, cs; sincosf(e * ai, &sn, &cs);
        const float mp = expf(e * ar), mn = expf(-e * ar);
        pneg[((size_t)(dg * 2 + 0) * 64 + p) * 64 + t] = mn * cs; pneg[((size_t)(dg * 2 + 1) * 64 + p) * 64 + t] = -mn * sn;
        ppos[((size_t)(dg * 2 + 0) * 64 + t) * 64 + p] = mp * cs; ppos[((size_t)(dg * 2 + 1) * 64 + t) * 64 + p] = mp * sn;
    }
    for (int i = gt; i < 32 * 64; i += ngt) {
        const int p = i & 63, dg = i >> 6;
        const float dt = expf(log_dt[dg]), are = a_re[dg * 64 + p], aim = a_im[dg * 64 + p], ar = are * dt, ai = aim * dt;
        const float es[3] = {1.f, 63.f, 64.f};
#pragma unroll
        for (int k = 0; k < 3; ++k) { float sn, cs; sincosf(es[k] * ai, &sn, &cs); const float m = expf(es[k] * ar);
            apow[((size_t)(k * 32 + dg) * 2 + 0) * 64 + p] = m * cs; apow[((size_t)(k * 32 + dg) * 2 + 1) * 64 + p] = m * sn; }
        float sn, cs; sincosf(ai, &sn, &cs); const float mag = expf(ar);
        const float abr = mag * cs, abi = mag * sn, den = are * are + aim * aim, nr = abr - 1.f, ni = abi;
        const float fr = (nr * are + ni * aim) / den, fi = (ni * are - nr * aim) / den;
#pragma unroll
        for (int c = 0; c < 16; ++c) {
            const float br = b_re[((size_t)dg * 64 + p) * 16 + c], bi = b_im[((size_t)dg * 64 + p) * 16 + c];
            bbt[((size_t)dg * 128 + p) * 16 + c] = (bf16)f2bf(fr * br - fi * bi);
            bbt[((size_t)dg * 128 + 64 + p) * 16 + c] = (bf16)f2bf(fr * bi + fi * br);
        }
    }
    for (int i = gt; i < 32 * 4 * 16 * 4 * 8; i += ngt) {
        const int s = i & 7, G = (i >> 3) & 3, c = (i >> 5) & 15, mt = (i >> 9) & 3, dg = i >> 11;
        const int p = 16 * mt + 4 * G + (s & 3);
        const float v = (s < 4) ? c_re[((size_t)dg * 16 + c) * 64 + p] : -c_im[((size_t)dg * 16 + c) * 64 + p];
        cct[i] = (bf16)f2bf(v);
    }
}
__device__ __forceinline__ void make_static_tables(const Frame& F, const Params& P) {
    unsigned char* tb = P.ws + WS_TBL;
    const int gt = F.gw * 64 + F.lane, ngt = F.ngw * 64;
    bf16* wcb = (bf16*)(tb + T_WCB);
    for (int i = gt; i < 128 * 64; i += ngt) { const int c = i & 63, mp = i >> 6, m = mp & 63; float sn, cs; sincospif(2.f * (float)((m * c) & 63) / 64.f, &sn, &cs);
        wcb[i] = (bf16)f2bf((mp < 64 ? cs : -sn) * 0.125f); }
    bf16* fa64 = (bf16*)(tb + T_FA64);
    for (int i = gt; i < 2 * 64 * 4 * 32; i += ngt) { const int s = i & 7, G = (i >> 3) & 3, lt = (i >> 5) & 3, k1 = (i >> 7) & 63, po = i >> 13;
        const int l1 = 16 * lt + 4 * G + (s & 3); float sn, cs; sincospif(2.f * (float)((k1 * l1) & 63) / 64.f, &sn, &cs);
        const float v = (po == 0) ? ((s < 4) ? cs : sn) : ((s < 4) ? -sn : cs); fa64[i] = (bf16)f2bf(v * 0.125f); }
    bf16* fa16 = (bf16*)(tb + T_FA16);
    for (int i = gt; i < 2 * 16 * 32; i += ngt) { const int s = i & 7, G = (i >> 3) & 3, k1 = (i >> 5) & 15, po = i >> 9;
        const int l1 = 4 * G + (s & 3); float sn, cs; sincospif(2.f * (float)((k1 * l1) & 15) / 16.f, &sn, &cs);
        const float v = (po == 0) ? ((s < 4) ? cs : sn) : ((s < 4) ? -sn : cs); fa16[i] = (bf16)f2bf(v * 0.25f); }
    bf16* fc128 = (bf16*)(tb + T_FC128);
    for (int i = gt; i < 128 * 256; i += ngt) { const int kap = i & 255, k2 = i >> 8, part = kap >> 7, l2 = kap & 127; float sn, cs; sincospif(2.f * (float)((k2 * l2) & 127) / 128.f, &sn, &cs);
        fc128[i] = (bf16)f2bf((part ? sn : cs) * 0.08838834764831845f); }
    bf16* fc16 = (bf16*)(tb + T_FC16);
    for (int i = gt; i < 16 * 32; i += ngt) { const int kap = i & 31, k2 = i >> 5, part = kap >> 4, l2 = kap & 15; float sn, cs; sincospif(2.f * (float)((k2 * l2) & 15) / 16.f, &sn, &cs);
        fc16[i] = (bf16)f2bf((part ? sn : cs) * 0.25f); }
    float* rope = (float*)(tb + T_ROPE);
    for (int i = gt; i < 128 * 16; i += ngt) { const int f = i & 15, pos = i >> 4; const float inv = powf(10000.f, -(float)f / 16.f); const float ang = (float)pos * inv;
        rope[i] = cosf(ang); rope[128 * 16 + i] = sinf(ang); }
}

__device__ __forceinline__ void mod_phase(const Frame& F, const Params& P) {
    LAS float* sc = (LAS float*)(F.lds + 8 * 16384);
    LAS float* part = (LAS float*)(F.lds);
    for (int i = F.tid; i < 5 * DM; i += NTHREADS) { const float v = (i < 4 * DM) ? P.in[1][i] : P.in[3][i - 4 * DM]; sc[i] = fsilu(v); }
    __syncthreads();
    float* mod = (float*)(P.ws + WS_MOD);
    for (int task = blockIdx.x; task < 288; task += gridDim.x) {
        const int l = task / 144, j = (task % 144) * 64 + F.lane, k0 = F.wave * 128;
        const float* w = P.in[4] + (size_t)l * DM * 9216 + (size_t)k0 * 9216 + j;
        float a0 = 0.f, a1 = 0.f, a2 = 0.f, a3 = 0.f, a4 = 0.f;
#pragma unroll 16
        for (int k = 0; k < 128; ++k) { const float wv = w[(size_t)k * 9216]; a0 += sc[k0 + k] * wv; a1 += sc[DM + k0 + k] * wv; a2 += sc[2 * DM + k0 + k] * wv; a3 += sc[3 * DM + k0 + k] * wv; a4 += sc[4 * DM + k0 + k] * wv; }
        LAS float* pw = part + F.wave * 320 + F.lane;
        pw[0] = a0; pw[64] = a1; pw[128] = a2; pw[192] = a3; pw[256] = a4;
        __syncthreads();
        if (F.tid < 320) { float s = 0.f;
#pragma unroll
            for (int wv = 0; wv < 8; ++wv) s += part[wv * 320 + F.tid];
            const int r = F.tid >> 6, jj = (task % 144) * 64 + (F.tid & 63); mod[((size_t)l * 5 + r) * 9216 + jj] = s + P.in[5][l * 9216 + jj]; }
        __syncthreads();
    }
}

__device__ __forceinline__ const float* mod_vec(const Params& P, int l, int bidx, int i) { return (const float*)(P.ws + WS_MOD) + ((size_t)l * 5 + bidx) * 9216 + i * DM; }
template <int MODE>
__device__ __forceinline__ void rowwise_phase(const Frame& F, const Params& P, int l, int gi, float gscale, int lni, int lu, int si, bool do_u, bool first_h, int nrows, int nparts) {
    bf16* U = (bf16*)(P.ws + WS_U); const bf16* RES = (const bf16*)(P.ws + WS_RES); float* HC = (float*)(P.ws + WS_HC);
    const int r_lo = (int)(((long long)nrows * F.gw) / F.ngw), r_hi = (int)(((long long)nrows * (F.gw + 1)) / F.ngw);
    int cur_b = -1;
    f32x4 vg[4], vlg[4], vlb[4], vsh[4], vsc[4];
    {
#pragma unroll 2
        for (int row = r_lo; row < r_hi; ++row) {
            const bool lat = row < MLAT; const int bidx = lat ? row / SEQ : 4;
            if (bidx != cur_b) { cur_b = bidx;
#pragma unroll
                for (int j = 0; j < 4; ++j) { const int c = 4 * F.lane + 256 * j;
                    if (MODE == 1) { vg[j] = *(const f32x4*)(mod_vec(P, l, bidx, gi) + c) * gscale; vlg[j] = *(const f32x4*)(P.in[6] + (size_t)(l * 3 + lni) * DM + c); vlb[j] = *(const f32x4*)(P.in[7] + (size_t)(l * 3 + lni) * DM + c); }
                    if (do_u) { vsh[j] = *(const f32x4*)(mod_vec(P, lu, bidx, si) + c); vsc[j] = *(const f32x4*)(mod_vec(P, lu, bidx, si + 1) + c) + 1.f; } } }
            const float* hin; float* hout;
            if (lat) { hin = (first_h ? P.in[0] : P.out) + (size_t)row * DM; hout = P.out + (size_t)row * DM; }
            else { hin = (first_h ? P.in[2] : HC) + (size_t)(row - MLAT) * DM; hout = HC + (size_t)(row - MLAT) * DM; }
            f32x4 v[4];
#pragma unroll
            for (int j = 0; j < 4; ++j) v[j] = *(const f32x4*)(hin + 4 * F.lane + 256 * j);
            if (MODE == 1) {
                float s = 0.f;
#pragma unroll
                for (int j = 0; j < 4; ++j) { const int c = 4 * F.lane + 256 * j; u32x2 r;
                    if (lat || nparts == 1) r = *(const u32x2*)(RES + (size_t)row * DM + c);
                    else { const bf16* rp = (const bf16*)(P.ws + WS_Z + RESP_OFF) + (size_t)(row - MLAT) * DM + c; float a0 = 0.f, a1 = 0.f, a2 = 0.f, a3 = 0.f;
                        for (int k = 0; k < nparts; ++k) { const u32x2 q = *(const u32x2*)(rp + (size_t)k * MCTX * DM); a0 += bflo(q.x); a1 += bfhi(q.x); a2 += bflo(q.y); a3 += bfhi(q.y); }
                        r.x = pk2(a0, a1); r.y = pk2(a2, a3); }
                    v[j][0] = DN_ALPHA * v[j][0] + vg[j][0] * bflo(r.x); v[j][1] = DN_ALPHA * v[j][1] + vg[j][1] * bfhi(r.x);
                    v[j][2] = DN_ALPHA * v[j][2] + vg[j][2] * bflo(r.y); v[j][3] = DN_ALPHA * v[j][3] + vg[j][3] * bfhi(r.y);
                    s += (v[j][0] + v[j][1]) + (v[j][2] + v[j][3]); }
                const float mean = wave_sum(s) * (1.f / DM); float s2 = 0.f;
#pragma unroll
                for (int j = 0; j < 4; ++j) { v[j] = v[j] - mean; s2 += (v[j][0] * v[j][0] + v[j][1] * v[j][1]) + (v[j][2] * v[j][2] + v[j][3] * v[j][3]); }
                const float rstd = rsqrtf(wave_sum(s2) * (1.f / DM) + LN_EPS);
#pragma unroll
                for (int j = 0; j < 4; ++j) { const int c = 4 * F.lane + 256 * j; v[j] = v[j] * rstd * vlg[j] + vlb[j]; *(f32x4*)(hout + c) = v[j]; }
            }
            if (do_u) {
                float s = 0.f;
#pragma unroll
                for (int j = 0; j < 4; ++j) s += (v[j][0] + v[j][1]) + (v[j][2] + v[j][3]);
                const float mean = wave_sum(s) * (1.f / DM); float s2 = 0.f;
#pragma unroll
                for (int j = 0; j < 4; ++j) { v[j] = v[j] - mean; s2 += (v[j][0] * v[j][0] + v[j][1] * v[j][1]) + (v[j][2] * v[j][2] + v[j][3] * v[j][3]); }
                const float rstd = rsqrtf(wave_sum(s2) * (1.f / DM) + LN_EPS);
#pragma unroll
                for (int j = 0; j < 4; ++j) { const int c = 4 * F.lane + 256 * j; const f32x4 o = v[j] * rstd * vsc[j] + vsh[j]; u32x2 w; w.x = pk2(o[0], o[1]); w.y = pk2(o[2], o[3]); *(u32x2*)(U + (size_t)row * DM + c) = w; }
            }
        }
    }
}
#define XB_TMO      128
#define XB_XCNT(j)  (256  + 64 * (j))
#define XB_XSUB(j)  (1280 + 64 * (j))
#define XB_XGEN(j)  (2304 + 64 * (j))
#define XB_TOP      3328
#define XB_TOPGEN   3392
#define XCD_BAR_WORDS 3456
#define XB_SPIN_CAP (1u << 30)

__device__ __forceinline__ unsigned xb_ld(unsigned* p)              { return __hip_atomic_load(p, __ATOMIC_RELAXED, __HIP_MEMORY_SCOPE_AGENT); }
__device__ __forceinline__ unsigned xb_add(unsigned* p, unsigned v) { return __hip_atomic_fetch_add(p, v, __ATOMIC_RELAXED, __HIP_MEMORY_SCOPE_AGENT); }
__device__ __forceinline__ unsigned xb_xcc_id() { return (unsigned)__builtin_amdgcn_s_getreg((3 << 11) | 20) & 0xFu; }
#define XB_SPIN(cond, bar) do { unsigned _sp = 0; while (cond) { __builtin_amdgcn_s_sleep(1); \
    if ((++_sp & 255u) == 0u) { if (xb_ld(&(bar)[XB_TMO])) break; if (_sp > XB_SPIN_CAP) { atomicAdd(&(bar)[XB_TMO], 1u); break; } } } } while (0)

struct XcdBarrier {
    unsigned* bar; unsigned x;
    volatile LAS unsigned* st;
};

__device__ __forceinline__ XcdBarrier xcd_barrier_post(unsigned* bar, volatile LAS unsigned* st, int tid) {
    XcdBarrier b; b.bar = bar; b.x = xb_xcc_id(); b.st = st;
    if (tid == 0) (void)xb_add(&bar[XB_XCNT(b.x)], 1u);
    return b;
}
__device__ __forceinline__ void xcd_barrier_complete(unsigned* bar, unsigned x, unsigned& nloc, unsigned& nx) {
    const unsigned G = gridDim.x * gridDim.y * gridDim.z;
    unsigned sum, cnt, mine, sp = 0u;
    for (;;) {
        sum = 0u; cnt = 0u; mine = 0u;
#pragma unroll
        for (unsigned j = 0; j < 16; ++j) { const unsigned c = xb_ld(&bar[XB_XCNT(j)]); sum += c; cnt += (c > 0u) ? 1u : 0u; mine = (j == x) ? c : mine; }
        if (sum == G) break;
        __builtin_amdgcn_s_sleep(1);
        if ((++sp & 255u) == 0u) { if (xb_ld(&bar[XB_TMO])) break; if (sp > XB_SPIN_CAP) { atomicAdd(&bar[XB_TMO], 1u); break; } }
    }
    nloc = mine > 0u ? mine : 1u; nx = cnt > 0u ? cnt : 1u;
}

__device__ __forceinline__ void xcd_barrier(const XcdBarrier& b, int tid) {
    asm volatile("s_waitcnt vmcnt(0)" ::: "memory");
    __syncthreads();
    if (tid == 0) {
        unsigned* bar = b.bar;
        __builtin_amdgcn_s_waitcnt(0);
        unsigned nloc = b.st[0], nx = b.st[1];
        if (nloc == 0u) { xcd_barrier_complete(bar, b.x, nloc, nx); b.st[0] = nloc; b.st[1] = nx; }
        const unsigned old = xb_add(&bar[XB_XSUB(b.x)], 1u);
        const unsigned gen = old / nloc;
        if (old + 1u == (gen + 1u) * nloc) {
            __builtin_amdgcn_fence(__ATOMIC_RELEASE, "agent");
            asm volatile("s_waitcnt vmcnt(0)" ::: "memory");
            const unsigned og = xb_add(&bar[XB_TOP], 1u);
            const unsigned tg = og / nx;
            if (og + 1u == (tg + 1u) * nx) xb_add(&bar[XB_TOPGEN], 1u);
            else XB_SPIN(xb_ld(&bar[XB_TOPGEN]) == tg, bar);
            __builtin_amdgcn_fence(__ATOMIC_ACQUIRE, "agent");
            xb_add(&bar[XB_XGEN(b.x)], 1u);
            asm volatile("s_waitcnt vmcnt(0)" ::: "memory");
        } else {
            XB_SPIN(xb_ld(&bar[XB_XGEN(b.x)]) == gen, bar);
            __builtin_amdgcn_fence(__ATOMIC_ACQUIRE, "agent");
            asm volatile("s_waitcnt vmcnt(0)" ::: "memory");
        }
    }
    __syncthreads();
}
typedef f32x4 AccT[2][2][4][2];
__device__ __forceinline__ const void* uni_ptr(const void* p) { const unsigned long long v = (unsigned long long)p; unsigned lo = __builtin_amdgcn_readfirstlane((unsigned)v), hi = __builtin_amdgcn_readfirstlane((unsigned)(v >> 32));
    asm volatile("" : "+s"(lo), "+s"(hi)); return (const void*)(((unsigned long long)hi << 32) | lo); }
#define EPI_ROWS(u, wr, fr, ai, m) ((u).pm * 256 + (ai) * 128 + (wr) * 64 + (m) * 16 + (fr))

struct EpiGU {
    static constexpr bool PERM = true, AFTER_DRAIN = false, KHOOK = false;
    bf16* O;
    __device__ __forceinline__ void operator()(const AccT& acc, const pg8::Unit& u, int wr, int wc, int fr, int fq) const {
        asm volatile("" : "+v"(fr), "+v"(fq));
        const int col = u.pn * 128 + wc * 32 + 8 * fq;
#pragma unroll
        for (int ai = 0; ai < 2; ++ai)
#pragma unroll
            for (int m = 0; m < 4; ++m) {
                const size_t row = EPI_ROWS(u, wr, fr, ai, m);
                const f32x4 g0 = acc[ai][0][m][0], g1 = acc[ai][0][m][1], u0 = acc[ai][1][m][0], u1 = acc[ai][1][m][1];
                u32x4 w; w.x = pk2(fsilu(g0[0]) * u0[0], fsilu(g0[1]) * u0[1]); w.y = pk2(fsilu(g0[2]) * u0[2], fsilu(g0[3]) * u0[3]);
                w.z = pk2(fsilu(g1[0]) * u1[0], fsilu(g1[1]) * u1[1]); w.w = pk2(fsilu(g1[2]) * u1[2], fsilu(g1[3]) * u1[3]);
                *(u32x4*)(O + row * DFF + col) = w;
            }
    }
};
struct EpiStore {
    static constexpr bool PERM = true, AFTER_DRAIN = false, KHOOK = false;
    bf16* O; int ldc;
    __device__ __forceinline__ void operator()(const AccT& acc, const pg8::Unit& u, int wr, int wc, int fr, int fq) const {
        asm volatile("" : "+v"(fr), "+v"(fq));
#pragma unroll
        for (int ai = 0; ai < 2; ++ai)
#pragma unroll
            for (int m = 0; m < 4; ++m) {
                const size_t row = EPI_ROWS(u, wr, fr, ai, m);
#pragma unroll
                for (int bj = 0; bj < 2; ++bj) { const int col = u.pn * 256 + bj * 128 + wc * 32 + 8 * fq; const f32x4 v0 = acc[ai][bj][m][0], v1 = acc[ai][bj][m][1];
                    u32x4 w; w.x = pk2(v0[0], v0[1]); w.y = pk2(v0[2], v0[3]); w.z = pk2(v1[0], v1[1]); w.w = pk2(v1[2], v1[3]);
                    *(u32x4*)(O + row * ldc + col) = w; }
            }
    }
};
struct EpiGLU {
    static constexpr bool PERM = true, AFTER_DRAIN = false, KHOOK = false;
    const bf16* Y; const float* bias; bf16* O;
    __device__ __forceinline__ void operator()(const AccT& acc, const pg8::Unit& u, int wr, int wc, int fr, int fq) const {
        asm volatile("" : "+v"(fr), "+v"(fq));
#pragma unroll
        for (int ai = 0; ai < 2; ++ai)
#pragma unroll
            for (int m = 0; m < 4; ++m) {
                const size_t row = EPI_ROWS(u, wr, fr, ai, m);
#pragma unroll
                for (int bj = 0; bj < 2; ++bj) {
                    const int col = bj * 128 + wc * 32 + 8 * fq;
                    const f32x4 b0 = *(const f32x4*)(bias + col), b1 = *(const f32x4*)(bias + col + 4);
                    const u32x4 y = *(const u32x4*)(Y + row * 256 + col); const f32x4 v0 = acc[ai][bj][m][0] + b0, v1 = acc[ai][bj][m][1] + b1;
                    u32x4 w; w.x = pk2(bflo(y.x) * fsigmoid(v0[0]), bfhi(y.x) * fsigmoid(v0[1])); w.y = pk2(bflo(y.y) * fsigmoid(v0[2]), bfhi(y.y) * fsigmoid(v0[3]));
                    w.z = pk2(bflo(y.z) * fsigmoid(v1[0]), bfhi(y.z) * fsigmoid(v1[1])); w.w = pk2(bflo(y.w) * fsigmoid(v1[2]), bfhi(y.w) * fsigmoid(v1[3]));
                    *(u32x4*)(O + row * 1024 + col) = w;
                    asm volatile("" ::: "memory");
                }
            }
    }
};
template <bool FIRST> struct EpiMerge {
    static constexpr bool PERM = true, AFTER_DRAIN = false, KHOOK = false;
    const bf16* G; int gi; bf16* O;
    __device__ __forceinline__ void operator()(const AccT& acc, const pg8::Unit& u, int wr, int wc, int fr, int fq) const {
        asm volatile("" : "+v"(fr), "+v"(fq));
#pragma unroll
        for (int ai = 0; ai < 2; ++ai)
#pragma unroll
            for (int m = 0; m < 4; ++m) {
                const size_t row = EPI_ROWS(u, wr, fr, ai, m);
#pragma unroll
                for (int bj = 0; bj < 2; ++bj) { const int col = u.pn * 256 + bj * 128 + wc * 32 + 8 * fq;
                    const u32x4 g = *(const u32x4*)(G + row * 3072 + gi * 1024 + col); const f32x4 v0 = acc[ai][bj][m][0], v1 = acc[ai][bj][m][1];
                    float o[8] = {bflo(g.x) * v0[0], bfhi(g.x) * v0[1], bflo(g.y) * v0[2], bfhi(g.y) * v0[3], bflo(g.z) * v1[0], bfhi(g.z) * v1[1], bflo(g.w) * v1[2], bfhi(g.w) * v1[3]};
                    if (!FIRST) { const u32x4 p = *(const u32x4*)(O + row * DM + col);
                        o[0] += bflo(p.x); o[1] += bfhi(p.x); o[2] += bflo(p.y); o[3] += bfhi(p.y); o[4] += bflo(p.z); o[5] += bfhi(p.z); o[6] += bflo(p.w); o[7] += bfhi(p.w); }
                    u32x4 w; w.x = pk2(o[0], o[1]); w.y = pk2(o[2], o[3]); w.z = pk2(o[4], o[5]); w.w = pk2(o[6], o[7]);
                    *(u32x4*)(O + row * DM + col) = w; asm volatile("" ::: "memory"); }
            }
    }
};
struct EpiMergeK {
    static constexpr bool PERM = true, AFTER_DRAIN = false, KHOOK = true;
    const bf16* G; bf16* O;
    __device__ __forceinline__ void khook(AccT& acc, const pg8::Unit& u, int wr, int wc, int fr, int fq, int t) const {
        asm volatile("" : "+v"(fr), "+v"(fq));
        const int ga = (t == 4) ? 0 : 1024, gb = ga + 1024;
#pragma unroll
        for (int ai = 0; ai < 2; ++ai)
#pragma unroll
            for (int m = 0; m < 4; ++m) {
                const size_t row = EPI_ROWS(u, wr, fr, ai, m);
#pragma unroll
                for (int bj = 0; bj < 2; ++bj) { const int col = u.pn * 256 + bj * 128 + wc * 32 + 8 * fq;
                    const u32x4 a = *(const u32x4*)(G + row * 3072 + ga + col), b = *(const u32x4*)(G + row * 3072 + gb + col);
                    acc[ai][bj][m][0][0] *= bflo(a.x) * __builtin_amdgcn_rcpf(1e-30f + bflo(b.x)); acc[ai][bj][m][0][1] *= bfhi(a.x) * __builtin_amdgcn_rcpf(1e-30f + bfhi(b.x));
                    acc[ai][bj][m][0][2] *= bflo(a.y) * __builtin_amdgcn_rcpf(1e-30f + bflo(b.y)); acc[ai][bj][m][0][3] *= bfhi(a.y) * __builtin_amdgcn_rcpf(1e-30f + bfhi(b.y));
                    acc[ai][bj][m][1][0] *= bflo(a.z) * __builtin_amdgcn_rcpf(1e-30f + bflo(b.z)); acc[ai][bj][m][1][1] *= bfhi(a.z) * __builtin_amdgcn_rcpf(1e-30f + bfhi(b.z));
                    acc[ai][bj][m][1][2] *= bflo(a.w) * __builtin_amdgcn_rcpf(1e-30f + bflo(b.w)); acc[ai][bj][m][1][3] *= bfhi(a.w) * __builtin_amdgcn_rcpf(1e-30f + bfhi(b.w));
                    asm volatile("" ::: "memory"); }
            }
    }
    __device__ __forceinline__ void operator()(const AccT& acc, const pg8::Unit& u, int wr, int wc, int fr, int fq) const {
        asm volatile("" : "+v"(fr), "+v"(fq));
#pragma unroll
        for (int ai = 0; ai < 2; ++ai)
#pragma unroll
            for (int m = 0; m < 4; ++m) {
                const size_t row = EPI_ROWS(u, wr, fr, ai, m);
#pragma unroll
                for (int bj = 0; bj < 2; ++bj) { const int col = u.pn * 256 + bj * 128 + wc * 32 + 8 * fq;
                    const u32x4 g = *(const u32x4*)(G + row * 3072 + 2048 + col); const f32x4 v0 = acc[ai][bj][m][0], v1 = acc[ai][bj][m][1];
                    u32x4 w; w.x = pk2(bflo(g.x) * v0[0], bfhi(g.x) * v0[1]); w.y = pk2(bflo(g.y) * v0[2], bfhi(g.y) * v0[3]); w.z = pk2(bflo(g.z) * v1[0], bfhi(g.z) * v1[1]); w.w = pk2(bflo(g.w) * v1[2], bfhi(g.w) * v1[3]);
                    *(u32x4*)(O + row * DM + col) = w; asm volatile("" ::: "memory"); }
            }
    }
};
struct EpiWin {
    static constexpr bool PERM = true, AFTER_DRAIN = false, KHOOK = false;
    unsigned char* z; const float* rope;
    __device__ __forceinline__ void operator()(const AccT& acc, const pg8::Unit& u, int wr, int wc, int fr, int fq) const {
        asm volatile("" : "+v"(fr), "+v"(fq));
        const int pn = u.pn;
        unsigned char* z = (unsigned char*)uni_ptr(this->z); const float* rope = (const float*)uni_ptr(this->rope);
        if (pn == 0 || pn == 5 || pn >= 8) {
            bf16* O; int ldc, cb; const bool sig = pn >= 8;
            if (pn == 0) { O = (bf16*)(z + Z_SSMU); ldc = 256; cb = 0; } else if (pn == 5) { O = (bf16*)(z + Z_F); ldc = 256; cb = 0; } else { O = (bf16*)(z + Z_G); ldc = 3072; cb = (pn - 8) * 256; }
#pragma unroll
            for (int ai = 0; ai < 2; ++ai)
#pragma unroll
                for (int m = 0; m < 4; ++m) {
                    const size_t row = EPI_ROWS(u, wr, fr, ai, m);
#pragma unroll
                    for (int bj = 0; bj < 2; ++bj) { const int col = cb + bj * 128 + wc * 32 + 8 * fq; f32x4 v0 = acc[ai][bj][m][0], v1 = acc[ai][bj][m][1];
                        if (sig) {
#pragma unroll
                            for (int j = 0; j < 4; ++j) { v0[j] = fsigmoid(v0[j]); v1[j] = fsigmoid(v1[j]); } }
                        u32x4 w; w.x = pk2(v0[0], v0[1]); w.y = pk2(v0[2], v0[3]); w.z = pk2(v1[0], v1[1]); w.w = pk2(v1[2], v1[3]);
                        *(u32x4*)(O + row * ldc + col) = w; }
                }
        } else if (pn == 3 || pn == 4) {
            bf16* VT = (bf16*)(z + Z_VT); bf16* VCT = VT + (size_t)NB * 512 * VLD;
#pragma unroll
            for (int ai = 0; ai < 2; ++ai)
#pragma unroll
                for (int m = 0; m < 4; ++m) {
                    const int row = EPI_ROWS(u, wr, fr, ai, m);
                    bf16* base; int ldt;
                    if (row < MLAT) { const int b = row / SEQ, t = row % SEQ; base = VT + (size_t)b * 512 * VLD + t; ldt = VLD; }
                    else { const int rc = row - MLAT, b = rc / CTXL, t = rc % CTXL; base = VCT + (size_t)b * 512 * CTXL + t; ldt = CTXL; }
#pragma unroll
                    for (int bj = 0; bj < 2; ++bj) { const int vc = (pn - 3) * 256 + bj * 128 + wc * 32 + 8 * fq;
#pragma unroll
                        for (int n = 0; n < 2; ++n)
#pragma unroll
                            for (int j = 0; j < 4; ++j) base[(size_t)(vc + 4 * n + j) * ldt] = (bf16)f2bf(acc[ai][bj][m][n][j]); }
                }
        } else {
            const bool isq = pn >= 6; bf16* O = (bf16*)(z + (isq ? Z_Q : Z_K)); const int cb = (pn - (isq ? 6 : 1)) * 256; const float qs = isq ? 0.125f : 1.f;
            const bool latent = u.pm < MLAT / 256;
            const int ax = wc & 1, ph = fq >> 1, f0 = 8 * (fq & 1);
#pragma unroll
            for (int ai = 0; ai < 2; ++ai)
#pragma unroll
                for (int m = 0; m < 4; ++m) {
                    const int row = EPI_ROWS(u, wr, fr, ai, m);
                    f32x4 c0 = {1.f, 1.f, 1.f, 1.f}, c1 = c0, s0 = F4Z, s1 = F4Z;
                    if (latent) { const int t = row % SEQ, pos = ax ? (t & 63) : (t >> 6); const float* rc = rope + pos * 16 + f0;
                        c0 = *(const f32x4*)rc; c1 = *(const f32x4*)(rc + 4); s0 = *(const f32x4*)(rc + 2048); s1 = *(const f32x4*)(rc + 2048 + 4); }
#pragma unroll
                    for (int bj = 0; bj < 2; ++bj) { const int col = cb + bj * 128 + wc * 32 + 8 * fq; f32x4 v0 = acc[ai][bj][m][0], v1 = acc[ai][bj][m][1], o0, o1;
#pragma unroll
                        for (int j = 0; j < 4; ++j) { const float p0 = __shfl_xor(v0[j], 32), p1 = __shfl_xor(v1[j], 32);
                            o0[j] = (ph ? (v0[j] * c0[j] + p0 * s0[j]) : (v0[j] * c0[j] - p0 * s0[j])) * qs;
                            o1[j] = (ph ? (v1[j] * c1[j] + p1 * s1[j]) : (v1[j] * c1[j] - p1 * s1[j])) * qs; }
                        u32x4 w; w.x = pk2(o0[0], o0[1]); w.y = pk2(o0[2], o0[3]); w.z = pk2(o1[0], o1[1]); w.w = pk2(o1[2], o1[3]);
                        *(u32x4*)(O + (size_t)row * 512 + col) = w; }
                }
        }
    }
};
__device__ __forceinline__ int chunk_row0(int b, int ck) { return ck < 4 ? MLAT + b * CTXL + 64 * ck : b * SEQ + 64 * (ck - 4); }
__device__ __forceinline__ bf16x8 ld_frag(const bf16* p) { return *(const bf16x8*)p; }
constexpr bf16x8 BF8Z = {0, 0, 0, 0, 0, 0, 0, 0};

struct S5T1 { bf16x8 bre, bim; f32x4 pr[4], pi[4]; };
__device__ __forceinline__ void s5_load_t1(const unsigned char* tb, int dg, int nt, int fr, int G, S5T1& T) {
    const bf16* bbt = (const bf16*)(tb + T_BBT); const float* pneg = (const float*)(tb + T_PNEG);
    T.bre = (G < 2) ? ld_frag(bbt + ((size_t)dg * 128 + 16 * nt + fr) * 16 + 8 * G) : BF8Z;
    T.bim = (G < 2) ? ld_frag(bbt + ((size_t)dg * 128 + 64 + 16 * nt + fr) * 16 + 8 * G) : BF8Z;
    const float* pr = pneg + ((size_t)(dg * 2 + 0) * 64 + 16 * nt + fr) * 64 + 4 * G;
#pragma unroll
    for (int tt = 0; tt < 4; ++tt) { T.pr[tt] = *(const f32x4*)(pr + 16 * tt); T.pi[tt] = *(const f32x4*)(pr + 4096 + 16 * tt); }
}
__device__ __forceinline__ void s5_stage1(const S5T1& T, const bf16x8 (&af)[4], f32x4 (&vre)[4], f32x4 (&vim)[4]) {
#pragma unroll
    for (int tt = 0; tt < 4; ++tt) {
        const f32x4 cr = mfma16(af[tt], T.bre, F4Z), ci = mfma16(af[tt], T.bim, F4Z);
        vre[tt] = T.pr[tt] * cr - T.pi[tt] * ci; vim[tt] = T.pr[tt] * ci + T.pi[tt] * cr;
    }
}
__device__ __forceinline__ void s5_load_u(const bf16* SSMU, int row0, int g, int fr, int G, bf16x8 (&af)[4]) {
#pragma unroll
    for (int tt = 0; tt < 4; ++tt) af[tt] = (G < 2) ? ld_frag(SSMU + (size_t)(row0 + 16 * tt + fr) * 256 + 16 * g + 8 * G) : BF8Z;
}

template <int NC>
__device__ __forceinline__ void s5_pass_a(const Params& P, int item, int lane) {
    const int fr = lane & 15, G = lane >> 4;
    const int dir = item & 1, ckb = ((item >> 1) % (NCHUNK / NC)) * NC, bg = (item >> 1) / (NCHUNK / NC), g = bg & 15, b = bg >> 4, dg = dir * 16 + g;
    const unsigned char* tb = P.ws + WS_TBL; const float* apow = (const float*)(tb + T_APOW);
    float* sloc = (float*)(P.ws + WS_SLOC) + ((size_t)((bg * 2 + dir) * NCHUNK + ckb)) * 128;
    bf16x8 af[NC][4];
#pragma unroll
    for (int c = 0; c < NC; ++c) s5_load_u((const bf16*)(P.ws + WS_Z + Z_SSMU), chunk_row0(b, ckb + c), g, fr, G, af[c]);
    S5T1 T[2]; s5_load_t1(tb, dg, 0, fr, G, T[0]);
    float a63r[4], a63i[4];
#pragma unroll
    for (int nt = 0; nt < 4; ++nt) { a63r[nt] = apow[((size_t)(1 * 32 + dg) * 2 + 0) * 64 + 16 * nt + fr]; a63i[nt] = apow[((size_t)(1 * 32 + dg) * 2 + 1) * 64 + 16 * nt + fr]; }
#pragma unroll
    for (int nt = 0; nt < 4; ++nt) {
        if (nt + 1 < 4) s5_load_t1(tb, dg, nt + 1, fr, G, T[(nt + 1) & 1]);
#pragma unroll
        for (int c = 0; c < NC; ++c) {
            f32x4 vre[4], vim[4]; s5_stage1(T[nt & 1], af[c], vre, vim);
            float sr = 0.f, si = 0.f;
#pragma unroll
            for (int tt = 0; tt < 4; ++tt) { sr += (vre[tt][0] + vre[tt][1]) + (vre[tt][2] + vre[tt][3]); si += (vim[tt][0] + vim[tt][1]) + (vim[tt][2] + vim[tt][3]); }
            sr += __shfl_xor(sr, 16); sr += __shfl_xor(sr, 32); si += __shfl_xor(si, 16); si += __shfl_xor(si, 32);
            const int p = 16 * nt + fr;
            if (G == 0) { sloc[c * 128 + p] = a63r[nt] * sr - a63i[nt] * si; sloc[c * 128 + 64 + p] = a63r[nt] * si + a63i[nt] * sr; }
        }
    }
}
__device__ __forceinline__ void s5_pass_b(const Params& P, int item, int lane) {
    const int dir = item & 1, bg = item >> 1, g = bg & 15, dg = dir * 16 + g, p = lane;
    const float* apow = (const float*)(P.ws + WS_TBL + T_APOW);
    const float a1r = apow[((size_t)(0 * 32 + dg) * 2 + 0) * 64 + p], a1i = apow[((size_t)(0 * 32 + dg) * 2 + 1) * 64 + p];
    const float a64r = apow[((size_t)(2 * 32 + dg) * 2 + 0) * 64 + p], a64i = apow[((size_t)(2 * 32 + dg) * 2 + 1) * 64 + p];
    float* sl = (float*)(P.ws + WS_SLOC) + (size_t)(bg * 2 + dir) * NCHUNK * 128;
    float hr = 0.f, hi = 0.f;
    for (int q0 = 0; q0 < NCHUNK; q0 += 12) {
        float sr[12], si[12];
#pragma unroll
        for (int k = 0; k < 12; ++k) { const int q = q0 + k, ck = dir ? (q < 4 ? 3 - q : 135 - q) : q; sr[k] = sl[(size_t)ck * 128 + p]; si[k] = sl[(size_t)ck * 128 + 64 + p]; }
#pragma unroll
        for (int k = 0; k < 12; ++k) { const int q = q0 + k, ck = dir ? (q < 4 ? 3 - q : 135 - q) : q;
            sl[(size_t)ck * 128 + p] = a1r * hr - a1i * hi; sl[(size_t)ck * 128 + 64 + p] = a1r * hi + a1i * hr;
            const float nr = a64r * hr - a64i * hi + sr[k], ni = a64r * hi + a64i * hr + si[k]; hr = nr; hi = ni; }
    }
}
struct S5T3 { f32x4 cr, ci; bf16x8 cfrag; f32x4 qr[4], qi[4]; };
__device__ __forceinline__ void s5_load_t3(const unsigned char* tb, const float* ah, int dg, int nt, int fr, int G, S5T3& T) {
    const float* ppos = (const float*)(tb + T_PPOS); const bf16* cct = (const bf16*)(tb + T_CCT);
    T.cr = *(const f32x4*)(ah + 16 * nt + 4 * G); T.ci = *(const f32x4*)(ah + 64 + 16 * nt + 4 * G);
    T.cfrag = ld_frag(cct + ((((size_t)dg * 4 + nt) * 16 + fr) * 4 + G) * 8);
#pragma unroll
    for (int nto = 0; nto < 4; ++nto) { const float* pp = ppos + ((size_t)(dg * 2 + 0) * 64 + 16 * nto + fr) * 64 + 16 * nt + 4 * G; T.qr[nto] = *(const f32x4*)pp; T.qi[nto] = *(const f32x4*)(pp + 4096); }
}
template <int NC>
__device__ __forceinline__ void s5_pass_c(const Params& P, int l, int item, int nck, int ck0, int lane) {
    const int fr = lane & 15, G = lane >> 4;
    const int ckb = ck0 + (item * NC) % nck, bg = (item * NC) / nck, g = bg & 15, b = bg >> 4;
    const unsigned char* tb = P.ws + WS_TBL;
    const bf16* SSMU = (const bf16*)(P.ws + WS_Z + Z_SSMU);
    bf16x8 af[NC][4]; f32x4 yt[NC][4];
#pragma unroll
    for (int c = 0; c < NC; ++c) { s5_load_u(SSMU, chunk_row0(b, ckb + c), g, fr, G, af[c]);
#pragma unroll
        for (int q = 0; q < 4; ++q) yt[c][q] = F4Z; }
#pragma unroll 1
    for (int dir = 0; dir < 2; ++dir) {
        const int dg = dir * 16 + g;
        const float* ah = (const float*)(P.ws + WS_SLOC) + ((size_t)((bg * 2 + dir) * NCHUNK + ckb)) * 128;
        bf16x8 la, lb;
        { u32x4 wa, wb;
#pragma unroll
            for (int wi = 0; wi < 4; ++wi) { const int s0 = 16 * (wi >> 1) + 4 * G + 2 * (wi & 1), s1 = s0 + 1;
                const unsigned alo = (dir ? (s0 >= fr) : (s0 <= fr)) ? 0x3F80u : 0u, ahi = (dir ? (s1 >= fr) : (s1 <= fr)) ? 0x3F80u : 0u;
                const unsigned blo = (dir ? (s0 >= 16 + fr) : (s0 <= 16 + fr)) ? 0x3F80u : 0u, bhi = (dir ? (s1 >= 16 + fr) : (s1 <= 16 + fr)) ? 0x3F80u : 0u;
                wa[wi] = alo | (ahi << 16); wb[wi] = blo | (bhi << 16); }
            la = as_bf16x8(wa); lb = as_bf16x8(wb); }
        const u32x4 w1 = {0x3F803F80u, 0x3F803F80u, 0x3F803F80u, 0x3F803F80u}; const bf16x8 lones = as_bf16x8(w1);
#pragma unroll
        for (int nt = 0; nt < 4; ++nt) {
            S5T1 T1; s5_load_t1(tb, dg, nt, fr, G, T1);
            const float* ppos = (const float*)(tb + T_PPOS); const bf16* cct = (const bf16*)(tb + T_CCT);
            const bf16x8 cfrag = ld_frag(cct + ((((size_t)dg * 4 + nt) * 16 + fr) * 4 + G) * 8);
#pragma unroll
            for (int c = 0; c < NC; ++c) {
                const f32x4 cr = *(const f32x4*)(ah + c * 128 + 16 * nt + 4 * G), ci = *(const f32x4*)(ah + c * 128 + 64 + 16 * nt + 4 * G);
                f32x4 vre[4], vim[4]; s5_stage1(T1, af[c], vre, vim);
                const bf16x8 are0 = pack8(vre[0], vre[1]), are1 = pack8(vre[2], vre[3]), aim0 = pack8(vim[0], vim[1]), aim1 = pack8(vim[2], vim[3]);
#pragma unroll
                for (int nto = 0; nto < 4; ++nto) {
                    const bf16x8 lm = (nto & 1) ? lb : la; const bool mixed_k1 = (nto >> 1) != 0;
                    f32x4 hr = mfma16(mixed_k1 ? are1 : are0, lm, F4Z), hi = mfma16(mixed_k1 ? aim1 : aim0, lm, F4Z);
                    if (dir == 0 && mixed_k1) { hr = mfma16(are0, lones, hr); hi = mfma16(aim0, lones, hi); }
                    if (dir == 1 && !mixed_k1) { hr = mfma16(are1, lones, hr); hi = mfma16(aim1, lones, hi); }
                    hr = hr + cr; hi = hi + ci;
                    const float* pp = ppos + ((size_t)(dg * 2 + 0) * 64 + 16 * nto + fr) * 64 + 16 * nt + 4 * G; const f32x4 qr = *(const f32x4*)pp, qi = *(const f32x4*)(pp + 4096);
                    const f32x4 sr = qr * hr - qi * hi, si = qr * hi + qi * hr;
                    yt[c][nto] = mfma16(cfrag, pack8(sr, si), yt[c][nto]);
                }
            }
        }
    }
    const float* dvec = P.in[19] + l * 256 + 16 * g + 4 * G; const f32x4 dv = *(const f32x4*)dvec;
    bf16* YPRE = (bf16*)(P.ws + WS_U + OV_YPRE);
#pragma unroll
    for (int c = 0; c < NC; ++c) { const int row0 = chunk_row0(b, ckb + c);
#pragma unroll
        for (int nto = 0; nto < 4; ++nto) { const size_t row = row0 + 16 * nto + fr; const u32x2 uu = *(const u32x2*)(SSMU + row * 256 + 16 * g + 4 * G);
            const float y0 = gelu_tanh(yt[c][nto][0] + dv[0] * bflo(uu.x)), y1 = gelu_tanh(yt[c][nto][1] + dv[1] * bfhi(uu.x)), y2 = gelu_tanh(yt[c][nto][2] + dv[2] * bflo(uu.y)), y3 = gelu_tanh(yt[c][nto][3] + dv[3] * bfhi(uu.y));
            u32x2 w; w.x = pk2(y0, y1); w.y = pk2(y2, y3); *(u32x2*)(YPRE + row * 256 + 16 * g + 4 * G) = w; } }
}

template <int N1, int N2>
__device__ __forceinline__ void fnet_a(const Params& P, int item, int lane) {
    constexpr int LT = N1 / 16, NOCT = N2 / 8, L = N1 * N2, NK = 1, NKG = LT / NK;
    const int fr = lane & 15, G = lane >> 4;
    const int kg = item % NKG, mt = (item / NKG) & 3, oct = (item / (NKG * 4)) % NOCT, bg = item / (NKG * 4 * NOCT), g = bg & 3, b = bg >> 2;
    const unsigned char* tb = P.ws + WS_TBL; const bf16* wcb = (const bf16*)(tb + T_WCB); const bf16* fa = (const bf16*)(tb + (N1 == 64 ? T_FA64 : T_FA16));
    const bf16* FB = (const bf16*)(P.ws + WS_Z + Z_F); bf16* TB = (bf16*)(P.ws + WS_U + (N1 == 64 ? OV_TBL : OV_TBC));
    const int rbase = (N1 == 64) ? b * SEQ : MLAT + b * CTXL;
    bf16x8 wre[2], wim[2], far[NK][LT], fai[NK][LT];
#pragma unroll
    for (int kk = 0; kk < 2; ++kk) { wre[kk] = ld_frag(wcb + (size_t)(16 * mt + fr) * 64 + 32 * kk + 8 * G); wim[kk] = ld_frag(wcb + (size_t)(64 + 16 * mt + fr) * 64 + 32 * kk + 8 * G); }
#pragma unroll
    for (int q = 0; q < NK; ++q)
#pragma unroll
        for (int lt = 0; lt < LT; ++lt) { const int kt1 = kg * NK + q;
            far[q][lt] = ld_frag(fa + ((((size_t)0 * N1 + 16 * kt1 + fr) * LT + lt) * 4 + G) * 8); fai[q][lt] = ld_frag(fa + ((((size_t)1 * N1 + 16 * kt1 + fr) * LT + lt) * 4 + G) * 8); }
    unsigned ore[NK][4][4], oim[NK][4][4];
#pragma unroll
    for (int e2 = 0; e2 < 4; ++e2) {
        f32x4 tr2[NK][2], ti2[NK][2];
#pragma unroll
        for (int eo = 0; eo < 2; ++eo) {
            const int l2 = 8 * oct + 2 * e2 + eo;
            f32x4 tre[NK], tim[NK];
#pragma unroll
            for (int q = 0; q < NK; ++q) { tre[q] = F4Z; tim[q] = F4Z; }
#pragma unroll
            for (int lt = 0; lt < LT; ++lt) {
                const bf16* rp = FB + (size_t)(rbase + (16 * lt + fr) * N2 + l2) * 256 + g * 64 + 8 * G;
                const bf16x8 a0 = ld_frag(rp), a1 = ld_frag(rp + 32);
                f32x4 xr = mfma16(a0, wre[0], F4Z); xr = mfma16(a1, wre[1], xr);
                f32x4 xi = mfma16(a0, wim[0], F4Z); xi = mfma16(a1, wim[1], xi);
                const bf16x8 xf = pack8(xr, xi);
#pragma unroll
                for (int q = 0; q < NK; ++q) { tre[q] = mfma16(far[q][lt], xf, tre[q]); tim[q] = mfma16(fai[q][lt], xf, tim[q]); }
            }
#pragma unroll
            for (int q = 0; q < NK; ++q)
#pragma unroll
                for (int r = 0; r < 4; ++r) { const int k1 = 16 * (kg * NK + q) + 4 * G + r; const float rev = (float)((k1 * l2) % L) * (1.f / (float)L); const float sn = __builtin_amdgcn_sinf(rev), cs = __builtin_amdgcn_cosf(rev);
                    const float a = tre[q][r], bb = tim[q][r]; tre[q][r] = a * cs + bb * sn; tim[q][r] = bb * cs - a * sn; }
#pragma unroll
            for (int q = 0; q < NK; ++q) { tr2[q][eo] = tre[q]; ti2[q][eo] = tim[q]; }
        }
#pragma unroll
        for (int q = 0; q < NK; ++q)
#pragma unroll
            for (int r = 0; r < 4; ++r) { ore[q][r][e2] = pk2(tr2[q][0][r], tr2[q][1][r]); oim[q][r][e2] = pk2(ti2[q][0][r], ti2[q][1][r]); }
    }
    const int m = 16 * mt + fr;
#pragma unroll
    for (int q = 0; q < NK; ++q)
#pragma unroll
        for (int r = 0; r < 4; ++r) { const int k1 = 16 * (kg * NK + q) + 4 * G + r;
            bf16* o = TB + ((((size_t)bg * N1 + k1) * 2 + 0) * 64 + m) * N2 + 8 * oct;
            u32x4 w0 = {ore[q][r][0], ore[q][r][1], ore[q][r][2], ore[q][r][3]}, w1 = {oim[q][r][0], oim[q][r][1], oim[q][r][2], oim[q][r][3]};
            *(u32x4*)o = w0; *(u32x4*)(o + (size_t)64 * N2) = w1; }
}
template <int N1, int N2>
__device__ __forceinline__ void fnet_c(const Params& P, int item, int lane) {
    constexpr int KT2 = N2 / 16, NKB = 2 * N2 / 32;
    const int fr = lane & 15, G = lane >> 4;
    const int mt0 = 2 * (item & 1), k1 = (item >> 1) % N1, bg = (item >> 1) / N1, g = bg & 3, b = bg >> 2;
    const unsigned char* tb = P.ws + WS_TBL; const bf16* fc = (const bf16*)(tb + (N2 == 128 ? T_FC128 : T_FC16));
    const bf16* TB = (const bf16*)(P.ws + WS_U + (N1 == 64 ? OV_TBL : OV_TBC)); bf16* YF = (bf16*)(P.ws + WS_RES) + 256;
    const int rbase = (N1 == 64) ? b * SEQ : MLAT + b * CTXL;
    f32x4 acc[2][KT2];
#pragma unroll
    for (int k = 0; k < KT2; ++k) { acc[0][k] = F4Z; acc[1][k] = F4Z; }
#pragma unroll 2
    for (int kb = 0; kb < NKB; ++kb) {
        const int kap = 32 * kb + 8 * G, part = kap / N2, l2 = kap % N2;
        const bf16* tp = TB + ((((size_t)bg * N1 + k1) * 2 + part) * 64 + 16 * mt0 + fr) * N2 + l2;
        const bf16x8 tf0 = ld_frag(tp), tf1 = ld_frag(tp + (size_t)16 * N2);
#pragma unroll
        for (int k = 0; k < KT2; ++k) { const bf16x8 ff = ld_frag(fc + (size_t)(16 * k + fr) * (2 * N2) + kap); acc[0][k] = mfma16(tf0, ff, acc[0][k]); acc[1][k] = mfma16(tf1, ff, acc[1][k]); }
    }
#pragma unroll
    for (int q = 0; q < 2; ++q)
#pragma unroll
        for (int k = 0; k < KT2; ++k) { const size_t row = rbase + k1 + N1 * (16 * k + fr); u32x2 w; w.x = pk2(acc[q][k][0], acc[q][k][1]); w.y = pk2(acc[q][k][2], acc[q][k][3]);
            *(u32x2*)(YF + row * 1024 + g * 64 + 16 * (mt0 + q) + 4 * G) = w; }
}
struct KVFrag { bf16x8 k[2][2]; bf16x8 v[4]; };
__device__ __forceinline__ void attn_load2(const char* kbase, const char* vbase, unsigned koff, unsigned voff, unsigned vdstep, KVFrag& f) {
#pragma unroll
    for (int t = 0; t < 2; ++t)
#pragma unroll
        for (int kt = 0; kt < 2; ++kt) f.k[t][kt] = *(const bf16x8*)(kbase + koff + (t * 4 * 512 + 32 * kt) * 2);
#pragma unroll
    for (int dt = 0; dt < 4; ++dt) f.v[dt] = *(const bf16x8*)(vbase + (size_t)dt * vdstep + voff);
}
template <bool CTXQ>
__device__ __forceinline__ void attn_item(const Params& P, const LAS float* rpb, int item, int lane) {
    constexpr int NCH = CTXQ ? 8 : 16;
    const int fr = lane & 15, G = lane >> 4;
    const char* KB = (const char*)(P.ws + WS_Z + Z_K); const bf16* QB = (const bf16*)(P.ws + WS_Z + Z_Q);
    const char* VT = (const char*)(P.ws + WS_Z + Z_VT); const char* VCT = VT + (size_t)NB * 512 * VLD * 2;
    bf16* YN = (bf16*)(P.ws + WS_RES) + 512;
    int b, h, r = 0, cg = 0, r0 = 0, cb = 0; size_t qrow0;
    if (!CTXQ) { cg = item & 3; r = (item >> 2) & 127; h = (item >> 9) & 7; b = item >> 12; r0 = min(max(r - 4, 0), 120); cb = (cg == 0) ? 0 : (cg == 1) ? 8 : (cg == 2) ? 24 : 32;
        qrow0 = (size_t)b * SEQ + r * 64 + 16 * cg; }
    else { const int qt = item & 15; h = (item >> 4) & 7; b = item >> 7; qrow0 = (size_t)MLAT + b * CTXL + 16 * qt; }
    bf16x8 qf[2];
#pragma unroll
    for (int kt = 0; kt < 2; ++kt) qf[kt] = *(const bf16x8*)(QB + (qrow0 + fr) * 512 + h * 64 + 32 * kt + 8 * G);
    const unsigned koff = (unsigned)(((8 * (fr >> 2) + (fr & 3)) * 512 + 8 * G) * 2);
    const unsigned voff_l = (unsigned)((fr * VLD + 8 * G) * 2), voff_c = (unsigned)((fr * CTXL + 8 * G) * 2);
    const char* kloc = KB + ((size_t)b * SEQ + (size_t)r0 * 64 + cb) * 1024 + h * 128;
    const char* kctx = KB + ((size_t)MLAT + (size_t)b * CTXL) * 1024 + h * 128;
    const char* vloc = VT + ((size_t)(b * 512 + h * 64) * VLD + (size_t)r0 * 64 + cb) * 2;
    const char* vctx = VCT + ((size_t)(b * 512 + h * 64) * CTXL) * 2;
    const int qc = 16 * cg + fr, c0 = min(max(qc - 8, 0), 48);
    int boff[2][4];
#pragma unroll
    for (int t = 0; t < 2; ++t)
#pragma unroll
        for (int j = 0; j < 4; ++j) { const int kc = cb + 8 * G + 4 * t + j; const bool ok = (kc >= c0) && (kc < c0 + 16); boff[t][j] = h * (15 * 32) + (ok ? (kc - qc + 15) : 31) + (r0 - r + 7) * 32; }
    f32x4 ot[4] = {F4Z, F4Z, F4Z, F4Z};
    float mrun = -1e30f, lsum = 0.f;
    KVFrag fb[4];
#define ATT_LOAD(CH, DST) do { const int _ch = (CH); if (!CTXQ && _ch < 8) attn_load2(kloc + (size_t)_ch * 65536, vloc + (size_t)_ch * 128, koff, voff_l, 16 * VLD * 2, DST); \
        else { const int _cc = CTXQ ? _ch : _ch - 8; attn_load2(kctx + (size_t)_cc * 32768, vctx + (size_t)_cc * 64, koff, voff_c, 16 * CTXL * 2, DST); } } while (0)
    ATT_LOAD(0, fb[0]); ATT_LOAD(1, fb[1]); ATT_LOAD(2, fb[2]);
#pragma unroll 1
    for (int o = 0; o < NCH / 4; ++o) {
#pragma unroll
        for (int i = 0; i < 4; ++i) {
            const int ch = 4 * o + i;
            if (ch + 3 < NCH) ATT_LOAD(ch + 3, fb[(i + 3) & 3]);
            const KVFrag& cur = fb[i];
            f32x4 s[2];
#pragma unroll
            for (int t = 0; t < 2; ++t) { s[t] = mfma16(cur.k[t][0], qf[0], F4Z); s[t] = mfma16(cur.k[t][1], qf[1], s[t]); }
            if (!CTXQ && ch < 8) {
#pragma unroll
                for (int t = 0; t < 2; ++t)
#pragma unroll
                    for (int j = 0; j < 4; ++j) s[t][j] += rpb[boff[t][j] + ch * 32];
            }
            float cm = fmaxf(fmaxf(fmaxf(s[0][0], s[0][1]), fmaxf(s[0][2], s[0][3])), fmaxf(fmaxf(s[1][0], s[1][1]), fmaxf(s[1][2], s[1][3])));
            cm = fmaxf(cm, __shfl_xor(cm, 16)); cm = fmaxf(cm, __shfl_xor(cm, 32));
            const float mnew = fmaxf(mrun, cm), alpha = __expf(mrun - mnew); mrun = mnew;
            f32x4 p0, p1; float ps = 0.f;
#pragma unroll
            for (int j = 0; j < 4; ++j) { p0[j] = __expf(s[0][j] - mnew); p1[j] = __expf(s[1][j] - mnew); ps += p0[j] + p1[j]; }
            lsum = lsum * alpha + ps;
            const bf16x8 pf = pack8(p0, p1);
#pragma unroll
            for (int dt = 0; dt < 4; ++dt) ot[dt] = mfma16(cur.v[dt], pf, ot[dt] * alpha);
            asm volatile("" ::: "memory");
        }
    }
#undef ATT_LOAD
    lsum += __shfl_xor(lsum, 16); lsum += __shfl_xor(lsum, 32);
    const float inv = 1.f / lsum;
#pragma unroll
    for (int dt = 0; dt < 4; ++dt) { u32x2 w; w.x = pk2(ot[dt][0] * inv, ot[dt][1] * inv); w.y = pk2(ot[dt][2] * inv, ot[dt][3] * inv);
        *(u32x2*)(YN + (qrow0 + fr) * 1024 + h * 64 + 16 * dt + 4 * G) = w; }
}
constexpr int LDS_CTL_OFF = 8 * 16384 + 5 * DM * 4;
constexpr int LDS_BYTES = LDS_CTL_OFF + 128;
__device__ __forceinline__ int q_raw_lds(LAS unsigned* ctr, int lane) { unsigned v = 0; if (lane == 0) v = __hip_atomic_fetch_add(ctr, 1u, __ATOMIC_RELAXED, __HIP_MEMORY_SCOPE_WORKGROUP); return (int)__builtin_amdgcn_readfirstlane(v); }
#define WG_RANGE(n, lo, cnt) const int lo = (int)(((long long)(n) * (int)blockIdx.x) / (int)gridDim.x), cnt = (int)(((long long)(n) * ((int)blockIdx.x + 1)) / (int)gridDim.x) - lo
__device__ __forceinline__ int q_next_lds(LAS unsigned* ctr, int lane) { unsigned v = 0; if (lane == 0) v = __hip_atomic_fetch_add(ctr, 1u, __ATOMIC_RELAXED, __HIP_MEMORY_SCOPE_WORKGROUP); return (int)__builtin_amdgcn_readfirstlane(v) * (int)gridDim.x + (int)blockIdx.x; }
__device__ __forceinline__ int q_next(unsigned* ctr, int lane) { unsigned v = 0; if (lane == 0) v = atomicAdd(ctr, 1u); return (int)__builtin_amdgcn_readfirstlane(v); }

template <class Epi>
__device__ __forceinline__ void run_gemm(const Frame& F, const bf16* A, const bf16* Bt, int M, int N, int K, const Epi& E) {
    pg8::Gemm g{A, Bt, M, N, K, K}; pg8::StaticOrder S; S.init(M, N, (int)gridDim.x, (int)blockIdx.x);
    pg8::gemm_phase<Epi, pg8::StaticOrder, true, true>((PG8_LAS unsigned char*)F.lds, g, S, E, F.tid);
}
struct OneUnit {
    int pm, pn; bool have;
    __device__ __forceinline__ bool next(int i, pg8::Unit& u) const { if (i > 0 || !have) return false; u.pm = pm; u.pn = pn; return true; }
    __device__ __forceinline__ void a_ready(const pg8::Unit&) const {}
    __device__ __forceinline__ void done(const pg8::Unit&) const {}
};
template <int NSL>
__device__ __forceinline__ void ctx_split_gemm(const Frame& F, const bf16* A, const bf16* Bt, int ldk, bf16* resp) {
    const int c = blockIdx.x; OneUnit S; S.have = c < 16 * NSL; const int sl = c >> 4; S.pm = (MLAT / 256) + ((c & 15) >> 2); S.pn = c & 3;
    pg8::Gemm g{A + sl * 256, Bt + sl * 256, MT, DM, 256, ldk};
    EpiStore E{resp + (size_t)sl * MCTX * DM - (size_t)MLAT * DM, DM};
    pg8::gemm_phase<EpiStore, OneUnit, true, true>((PG8_LAS unsigned char*)F.lds, g, S, E, F.tid);
}

__device__ __forceinline__ Frame mkframe(unsigned char* lds_raw, int wv) {
    Frame Fr; asm volatile("" : "+s"(wv)); int ln = (int)__builtin_amdgcn_mbcnt_hi(~0u, __builtin_amdgcn_mbcnt_lo(~0u, 0u)); asm volatile("" : "+v"(ln));
    Fr.lds = (LAS unsigned char*)lds_raw; Fr.lane = ln; Fr.wave = wv; Fr.tid = wv * 64 + ln;
    Fr.gw = blockIdx.x * NWAVES + wv; Fr.ngw = gridDim.x * NWAVES; return Fr;
}
__device__ __forceinline__ const Params& getP() { const Params* kp = (const Params*)__builtin_amdgcn_kernarg_segment_ptr(); asm volatile("" : "+s"(kp)); return *kp; }
#define PP getP()
#define WSP(off) (getP().ws + (off))
#define F mkframe(lds_raw, wv0)
#define GRID_SYNC() do { XcdBarrier bb; bb.bar = (unsigned*)WSP(WS_CTL); bb.x = xb_xcc_id(); bb.st = (volatile LAS unsigned*)((LAS unsigned char*)lds_raw + LDS_CTL_OFF); xcd_barrier(bb, F.tid); } while (0)


#ifndef DIAG_TIME
#define DIAG_TIME 0
#endif
#define TSTAMP(k) do { if (DIAG_TIME) { const Frame Ft = F; if (blockIdx.x == 0 && Ft.tid == 0) ((unsigned long long*)(WSP(WS_CTL) + 32768))[k] = __builtin_amdgcn_s_memrealtime(); } } while (0)
#ifndef DIAG_REPEAT
#define DIAG_REPEAT 0
#endif
#ifndef DIAG_STOP
#define DIAG_STOP 0
#endif
__device__ __forceinline__ void diag_dump(const Frame& Fr, const Params& P, const bf16* src, int ld, int ncols) {
    for (size_t i = (size_t)Fr.gw * 64 + Fr.lane; i < (size_t)MLAT * DM; i += (size_t)Fr.ngw * 64) { const size_t row = i >> 10; const int c = (int)(i & 1023);
        float v = bf2f(src[row * ld + (c % ncols)]); v = (__builtin_fabsf(v) < 1e30f) ? v : 12345.f; P.out[i] = v; }
}

__device__ __forceinline__ void diag_dump3(const Frame& Fr, const Params& P, int mode) {
    const bf16* ypre = (const bf16*)(P.ws + WS_U + OV_YPRE); const bf16* yf = (const bf16*)(P.ws + WS_RES + SZ_256); const bf16* yn = (const bf16*)(P.ws + WS_RES + 2 * SZ_256);
    for (size_t i = (size_t)Fr.gw * 64 + Fr.lane; i < (size_t)MLAT * DM; i += (size_t)Fr.ngw * 64) { const size_t row = i >> 10; const int c = (int)(i & 1023);
        float v = 0.f;
        if (c < 256) { if (mode & 1) v = bf2f(ypre[row * 256 + c]); } else if (c < 512) { if (mode & 2) v = bf2f(yf[row * 256 + c - 256]); } else { if (mode & 4) v = bf2f(yn[row * 512 + c - 512]); }
        v = (__builtin_fabsf(v) < 1e30f) ? v : 12345.f; P.out[i] = v; }
}
#define DIAG_AT(n, src, ld, ncols) do { if (DIAG_STOP == (n)) { GRID_SYNC(); diag_dump(F, PP, (const bf16*)(src), ld, ncols); return true; } } while (0)
template <int l>
__device__ __forceinline__ bool layer_body(unsigned char* lds_raw, const int wv0) {
    constexpr bool last = (l == DEPTH - 1);

        const int Mx = last ? MLAT : MT;
        run_gemm(F, (const bf16*)WSP(WS_U), (const bf16*)WSP(WS_WA + WA_GU), MT, 2 * DFF, DM, EpiGU{(bf16*)WSP(WS_Z)});
        if (l == 0 && DIAG_REPEAT == 6) run_gemm(F, (const bf16*)WSP(WS_U), (const bf16*)WSP(WS_WA + WA_GU), MT, 2 * DFF, DM, EpiGU{(bf16*)WSP(WS_Z)});
        if (l == 0) DIAG_AT(2, WSP(WS_Z), DFF, 1024);
        GRID_SYNC();
        run_gemm(F, (const bf16*)WSP(WS_Z), (const bf16*)WSP(WS_WA + WA_DN), MT, DM, DFF, EpiStore{(bf16*)WSP(WS_RES), DM});
        if (l == 0) DIAG_AT(3, WSP(WS_RES), DM, 1024);
        GRID_SYNC();
        rowwise_phase<1>(F, PP, l, 2, 0.5f, 0, l, 3, true, l == 0, MT, 1);
        GRID_SYNC();
        run_gemm(F, (const bf16*)WSP(WS_U), (const bf16*)WSP(WS_WB + WB_IN), MT, WIN, DM, EpiWin{WSP(WS_Z), (const float*)WSP(WS_TBL + T_ROPE)});
        if (l == 0) DIAG_AT(5, WSP(WS_Z + Z_K), 512, 512);
        if (l == 0) DIAG_AT(6, WSP(WS_Z + Z_G), 3072, 1024);
        GRID_SYNC();
        if (l == 0) TSTAMP(1);
        {
            const Frame Fl = F;
            LAS float* rpb = (LAS float*)(Fl.lds + 8 * 16384);
            for (int i = Fl.tid; i < 8 * 15 * 32; i += NTHREADS) rpb[i] = ((i & 31) < 31) ? PP.in[22][l * 8 * 15 * 31 + (i >> 5) * 31 + (i & 31)] : -1e30f;
            LAS unsigned* qc = (LAS unsigned*)(Fl.lds + LDS_CTL_OFF) + 8;
            if (Fl.tid < 4) qc[Fl.tid] = 0u;
            __syncthreads();
            const int n_fa = 4096, n_fac = last ? 0 : 128, n_s5a = 4 * 16 * NCHUNK * 2;
            const int e0 = n_fa, e1 = e0 + n_fac, e2 = e1 + n_s5a;
            for (int it = q_next_lds(qc, Fl.lane); it < e1; it = q_next_lds(qc, Fl.lane)) { if (it < e0) fnet_a<64, 128>(PP, it, Fl.lane); else fnet_a<16, 16>(PP, it - e0, Fl.lane); }
            for (int it = q_next_lds(qc + 1, Fl.lane); it < n_s5a / 4; it = q_next_lds(qc + 1, Fl.lane)) s5_pass_a<4>(PP, it, Fl.lane);
        }
        GRID_SYNC();
        if (l == 0) TSTAMP(2);
        {
            const Frame Fl = F;
            LAS float* rpb = (LAS float*)(Fl.lds + 8 * 16384);
            const int n_b = 128, n_att = 16384, n_attc = last ? 0 : 512, n_fc = 2048, n_fcc = last ? 0 : 512;
            const int e0 = n_b, e1 = e0 + n_att, e2 = e1 + n_attc, e3 = e2 + n_fc, e4 = e3 + n_fcc;
            LAS unsigned* qc = (LAS unsigned*)(Fl.lds + LDS_CTL_OFF) + 8;
            for (int it = q_next_lds(qc + 2, Fl.lane); it < e4; it = q_next_lds(qc + 2, Fl.lane)) {
                if (it < e0) s5_pass_b(PP, it, Fl.lane);
                else if (it < e1) attn_item<false>(PP, rpb, it - e0, Fl.lane);
                else if (it < e2) attn_item<true>(PP, rpb, it - e1, Fl.lane);
                else if (it < e3) fnet_c<64, 128>(PP, it - e2, Fl.lane);
                else fnet_c<16, 16>(PP, it - e3, Fl.lane);
            }
        }
        GRID_SYNC();
        if (l == 0) TSTAMP(3);
        {
            const Frame Fl = F;
            const int nck = last ? 128 : NCHUNK, ck0 = last ? 4 : 0, n_c = 64 * nck;
            LAS unsigned* qc = (LAS unsigned*)(Fl.lds + LDS_CTL_OFF) + 8;
            const int n_lat = 64 * 64, n_ctx = last ? 0 : 64 * 4;
            for (int it = q_next_lds(qc + 3, Fl.lane); it < n_lat + n_ctx; it = q_next_lds(qc + 3, Fl.lane)) {
                if (it < n_lat) s5_pass_c<2>(PP, l, it, 128, 4, Fl.lane); else s5_pass_c<1>(PP, l, it - n_lat, 4, 0, Fl.lane); }
        }
        GRID_SYNC();
        if (l == 0) TSTAMP(4);
        {
            const int nun = Mx / 256;
            if ((int)blockIdx.x >= nun && (int)gridDim.x > nun) { Frame Fc = F; Fc.gw = ((int)blockIdx.x - nun) * NWAVES + Fc.wave; Fc.ngw = ((int)gridDim.x - nun) * NWAVES; convert_ffn(Fc, PP, l, 1); }
            else if ((int)gridDim.x <= nun) convert_ffn(F, PP, l, 1);
        }
        run_gemm(F, (const bf16*)WSP(WS_U + OV_YPRE), (const bf16*)WSP(WS_WB + WB_GLU), Mx, 256, 256, EpiGLU{(const bf16*)WSP(WS_U + OV_YPRE), PP.in[21] + l * 256, (bf16*)WSP(WS_RES)});
        GRID_SYNC();
        run_gemm(F, (const bf16*)WSP(WS_RES), (const bf16*)WSP(WS_WB + WB_BRS), Mx, DM, DM, EpiMergeK{(const bf16*)WSP(WS_Z + Z_G), (bf16*)WSP(WS_Z + Z_K)});
        GRID_SYNC();
        run_gemm(F, (const bf16*)WSP(WS_Z + Z_K), (const bf16*)WSP(WS_WB + WB_OUT), Mx, DM, DM, EpiStore{(bf16*)WSP(WS_RES), DM});
        if (l == 0) DIAG_AT(22, WSP(WS_RES), DM, 1024);
        GRID_SYNC();
        rowwise_phase<1>(F, PP, l, 5, 1.0f, 1, l, 6, true, false, Mx, 1);
        if (l == 0) DIAG_AT(23, WSP(WS_U), DM, 1024);
        GRID_SYNC();
        run_gemm(F, (const bf16*)WSP(WS_U), (const bf16*)WSP(WS_WA + WA_GU), Mx, 2 * DFF, DM, EpiGU{(bf16*)WSP(WS_Z)});
        GRID_SYNC();
        run_gemm(F, (const bf16*)WSP(WS_Z), (const bf16*)WSP(WS_WA + WA_DN), Mx, DM, DFF, EpiStore{(bf16*)WSP(WS_RES), DM});
        if (l == 0) DIAG_AT(24, WSP(WS_RES), DM, 1024);
        GRID_SYNC();
        rowwise_phase<1>(F, PP, l, 8, 0.5f, 2, last ? l : l + 1, 0, !last, false, Mx, 1);
        if (!last) { convert_ffn(F, PP, l + 1, 0); convert_mixer(F, PP, l + 1); make_s5_tables(F, PP, l + 1); GRID_SYNC(); }
        return false;
}
__global__ void __launch_bounds__(NTHREADS, 2) hybrid_fwd(Params Parg) {
    extern __shared__ __attribute__((aligned(16))) unsigned char lds_raw[];
    cg::grid_group grid = cg::this_grid();
    const int wv0 = __builtin_amdgcn_readfirstlane((int)threadIdx.x >> 6);
    {
        const int t0 = threadIdx.x;
        if (t0 < 32) ((LAS unsigned*)(lds_raw))[LDS_CTL_OFF / 4 + t0] = 0u;
        if (blockIdx.x == 0) { unsigned* ctlw = (unsigned*)(getP().ws + WS_CTL); for (int i = t0; i < (int)(CTL_BYTES / 4); i += NTHREADS) __hip_atomic_store(ctlw + i, 0u, __ATOMIC_RELAXED, __HIP_MEMORY_SCOPE_AGENT); }
        __threadfence();
        __syncthreads();
        grid.sync();
    }
    XcdBarrier bar = xcd_barrier_post((unsigned*)WSP(WS_CTL), (volatile LAS unsigned*)((LAS unsigned char*)lds_raw + LDS_CTL_OFF), F.tid);
    (void)bar;
    TSTAMP(0);
#if defined(DIAG_BARTEST)
    {
        unsigned* slots = (unsigned*)(WSP(WS_Z));
        unsigned* errs = (unsigned*)(WSP(WS_CTL)) + 12288;
        unsigned bad = 0;
        for (int rnd = 1; rnd <= 64; ++rnd) {
            const Frame Fb = F;
            if ((blockIdx.x + rnd) % 7 == 0) { for (int d = 0; d < 2000; ++d) __builtin_amdgcn_s_sleep(20); }
            for (int i = Fb.tid; i < 4096; i += NTHREADS) slots[(size_t)blockIdx.x * 4096 + i] = (unsigned)(rnd * 65536 + blockIdx.x * 16 + (i & 15));
            GRID_SYNC();
            for (int j = 0; j < 8; ++j) { const int ob = (blockIdx.x * 37 + j * 31 + rnd) % (int)gridDim.x;
                for (int i = Fb.tid; i < 4096; i += NTHREADS) { const unsigned v = slots[(size_t)ob * 4096 + i]; if (v != (unsigned)(rnd * 65536 + ob * 16 + (i & 15))) ++bad; } }
            GRID_SYNC();
        }
        if (bad) atomicAdd(errs, bad);
        GRID_SYNC();
        const Frame Fd = F; const unsigned e = __hip_atomic_load(errs, __ATOMIC_RELAXED, __HIP_MEMORY_SCOPE_AGENT);
        float* o = getP().out;
        for (size_t i = (size_t)Fd.gw * 64 + Fd.lane; i < (size_t)MLAT * DM; i += (size_t)Fd.ngw * 64) o[i] = (i == 0 && e) ? 4096.f : 0.f;
        return;
    }
#endif
    mod_phase(F, PP);
    convert_ffn(F, PP, 0, 0); convert_mixer(F, PP, 0); make_s5_tables(F, PP, 0); make_static_tables(F, PP);
    if (DIAG_REPEAT == 8) { convert_ffn(F, PP, 0, 0); convert_mixer(F, PP, 0); }
    if (DIAG_REPEAT == 7) { for (int k = 0; k < 10; ++k) GRID_SYNC(); }
    if (DIAG_REPEAT == 9) { mod_phase(F, PP); make_s5_tables(F, PP, 0); make_static_tables(F, PP); }
    GRID_SYNC();
    rowwise_phase<0>(F, PP, 0, 0, 0.f, 0, 0, 0, true, true, MT, 1);
    GRID_SYNC();
    if (DIAG_STOP == 1) { GRID_SYNC(); diag_dump(F, PP, (const bf16*)WSP(WS_U), DM, 1024); return; }

    if (layer_body<0>(lds_raw, wv0)) return;
    if (layer_body<1>(lds_raw, wv0)) return;
    if (DIAG_TIME) {
        TSTAMP(5); GRID_SYNC();
        const Frame Fd = F; const unsigned long long* ts = (const unsigned long long*)(WSP(WS_CTL) + 32768);
        const float X = exp2f(floorf(log2f((float)(ts[DIAG_TX1] - ts[DIAG_TX0]) * 0.01f)));
        const float C = floorf(2.f * log2f((float)(ts[DIAG_TC1] - ts[DIAG_TC0]) * 0.01f));
        float* o = getP().out;
        for (size_t i = (size_t)Fd.gw * 64 + Fd.lane; i < (size_t)MLAT * DM; i += (size_t)Fd.ngw * 64) o[i] = (i == 0) ? X : C;
    }
}

extern "C" void kernel_launch(void* const* d_in, const int* in_sizes, int n_in, void* d_out, int out_size, void* d_ws, size_t ws_size, hipStream_t stream) {
    static int grid_blocks = 0;
    if (grid_blocks == 0) {
        if (n_in != 27 || ws_size < WS_END) { fprintf(stderr, "kernel_launch: unexpected n_in %d or ws_size %zu (< %zu)\n", n_in, ws_size, (size_t)WS_END); grid_blocks = -1; return; }
        int dev = 0, cus = 0, per_cu = 0;
        hipGetDevice(&dev); hipDeviceGetAttribute(&cus, hipDeviceAttributeMultiprocessorCount, dev);
        hipFuncSetAttribute((const void*)hybrid_fwd, hipFuncAttributeMaxDynamicSharedMemorySize, LDS_BYTES);
        if (hipOccupancyMaxActiveBlocksPerMultiprocessor(&per_cu, (const void*)hybrid_fwd, NTHREADS, LDS_BYTES) != hipSuccess || per_cu < 1) per_cu = 1;
        (void)hipGetLastError();
        grid_blocks = cus * 1;
    }
    if (grid_blocks < 0) return;
    hipMemsetAsync((char*)d_ws + WS_CTL, 0, CTL_BYTES, stream);
    Params p{};
    for (int i = 0; i < 27; ++i) p.in[i] = (const float*)d_in[i];
    p.out = (float*)d_out; p.ws = (unsigned char*)d_ws;
    void* args[] = {&p};
    hipError_t e = hipLaunchCooperativeKernel((const void*)hybrid_fwd, dim3(grid_blocks), dim3(NTHREADS), args, LDS_BYTES, stream);
    if (e != hipSuccess) fprintf(stderr, "cooperative launch failed: %s (grid %d)\n", hipGetErrorString(e), grid_blocks);
}
```

```cpp
#define DIAG_STOP 0
#define DIAG_TX0 0
#define DIAG_TX1 5
#define DIAG_TC0 1
#define DIAG_TC1 2
#define DIAG_REPEAT 0
#include <hip/hip_runtime.h>
#include <hip/hip_cooperative_groups.h>
#include <cstdio>
#include <cstdint>
namespace pg8 {
#define PG8_LAS __attribute__((address_space(3)))
typedef unsigned short bf16_t;
typedef short bf16x8 __attribute__((ext_vector_type(8)));
typedef float f32x4 __attribute__((ext_vector_type(4)));
typedef unsigned u32x4 __attribute__((ext_vector_type(4)));
constexpr int BM = 256, BK = 64, HALF = 128, HTB = HALF * BK * 2  , STAGE_BYTES = 8 * HTB, NXCD = 8, WGM = 8;

__host__ __device__ __forceinline__ int lds_byte(int r, int c) { const int st = (r >> 4) * 2 + (c >> 5), rr = r & 15, cc = c & 31, ob = rr * 64 + cc * 2; return st * 1024 + (ob ^ (((ob >> 9) & 1) << 5)); }
__host__ __device__ __forceinline__ void stage_rc(int b, int& R, int& C) { const int st = b / 1024, sb = b % 1024, swz = sb ^ (((sb >> 9) & 1) << 5); R = (st >> 1) * 16 + swz / 64; C = (st & 1) * 32 + (swz % 64) / 2; }
__host__ __device__ __forceinline__ int perm32(int rho) { const int n = rho >> 4, i = rho & 15; return 8 * (i >> 2) + 4 * n + (i & 3); }

struct Unit { int pm, pn; };
struct Gemm { const bf16_t* A; const bf16_t* Bt; int M, N, K, ld; };

struct StaticOrder {
    int nM, nN, nwg, G, c;
    __host__ __device__ void init(int M, int N, int G_, int c_) { nM = M / BM; nN = N / BM; nwg = nM * nN; G = G_; c = c_; }
    __host__ __device__ bool next(int i, Unit& u) const {
        const long L = (long)i * G + c; if (L >= nwg) return false;
        int wgid = (int)L; { const int q = nwg / NXCD, r = nwg % NXCD, xcd = wgid % NXCD, off = wgid / NXCD; wgid = (xcd < r ? xcd * (q + 1) : r * (q + 1) + (xcd - r) * q) + off; }
        const int nig = WGM * nN, gid = wgid / nig, fm = gid * WGM, gsz = (nM - fm) < WGM ? (nM - fm) : WGM;
        u.pm = fm + ((wgid % nig) % gsz); u.pn = (wgid % nig) / gsz; return true;
    }
    __device__ __forceinline__ void a_ready(const Unit&) const {}
    __device__ __forceinline__ void done(const Unit&) const {}
};

__device__ __forceinline__ unsigned cvt_pk_bf16(float lo, float hi) { unsigned r; asm volatile("v_cvt_pk_bf16_f32 %0, %1, %2" : "=v"(r) : "v"(lo), "v"(hi)); return r; }
typedef float f32x2 __attribute__((ext_vector_type(2)));
template <class Epi, class Sched, bool ALIGN_EPI = false, bool SP2 = false>
__device__ __forceinline__ void gemm_phase(PG8_LAS unsigned char* lds, const Gemm g, const Sched& S, const Epi& E, int tid_in) {
    int tid_l = tid_in; asm volatile("" : "+v"(tid_l));
    const int tid = tid_l, wid = __builtin_amdgcn_readfirstlane(tid >> 6), lane = tid & 63, wr = wid >> 2, wc = wid & 3, fr = lane & 15, fq = lane >> 4;
    const int K = g.K, nt = K / BK;
    unsigned voffA[2], voffB[2];
#pragma unroll
    for (int i = 0; i < 2; ++i) { int R, C; stage_rc(tid * 16 + i * 8192, R, C); const int Rb = Epi::PERM ? ((R & ~31) + perm32(R & 31)) : R;
        voffA[i] = (unsigned)(R * g.ld + C) * 2u; voffB[i] = (unsigned)(Rb * g.ld + C) * 2u; }
    const size_t kstep = (size_t)(BK * 2);
    const size_t hstep = (size_t)HALF * g.ld * 2;
    const size_t tstep = 2 * hstep;
    const unsigned ldsw = (unsigned)wid * 1024u;
    const int aoff = lds_byte(wr * 64 + fr, fq * 8), boff = lds_byte(wc * 32 + fr, fq * 8);
#define PG8_SA(b, h) (((b) * 2 + (h)) * HTB)
#define PG8_SB(b, h) ((4 + (b) * 2 + (h)) * HTB)
#define PG8_STAGE(bufoff, gbase, voff) do { _Pragma("unroll") for (int _i = 0; _i < 2; ++_i) \
        __builtin_amdgcn_global_load_lds((const unsigned*)((const char*)(gbase) + (voff)[_i]), (PG8_LAS unsigned*)(lds + (bufoff) + ldsw + _i * 8192), 16, 0, 0); } while (0)
#define PG8_LDA(dst, b, h) do { _Pragma("unroll") for (int m = 0; m < 4; ++m) _Pragma("unroll") for (int k = 0; k < 2; ++k) dst[m][k] = *(const PG8_LAS bf16x8*)(lds + PG8_SA(b, h) + aoff + m * 2048 + k * 1024); } while (0)
#define PG8_LDB(dst, b, h) do { _Pragma("unroll") for (int n = 0; n < 2; ++n) _Pragma("unroll") for (int k = 0; k < 2; ++k) dst[n][k] = *(const PG8_LAS bf16x8*)(lds + PG8_SB(b, h) + boff + n * 2048 + k * 1024); } while (0)
#define PG8_MMA(ai, bj, At, Bt) do { __builtin_amdgcn_s_setprio(1); _Pragma("unroll") for (int m = 0; m < 4; ++m) _Pragma("unroll") for (int n = 0; n < 2; ++n) _Pragma("unroll") for (int k = 0; k < 2; ++k) \
        acc[ai][bj][m][n] = __builtin_amdgcn_mfma_f32_16x16x32_bf16(Bt[n][k], At[m][k], acc[ai][bj][m][n], 0, 0, 0); __builtin_amdgcn_s_setprio(0); } while (0)
#define PG8_WAIT_V(n) asm volatile("s_waitcnt vmcnt(" #n ")" ::: "memory")
#define PG8_WAIT_L(n) asm volatile("s_waitcnt lgkmcnt(" #n ")" ::: "memory")
#define PG8_BAR __builtin_amdgcn_s_barrier()
#define PG8_SCHED __builtin_amdgcn_sched_barrier(0)
    Unit cur, nxt; int ui = 0;
    if (!S.next(0, cur)) return;
    f32x4 acc[2][2][4][2];
#pragma unroll
    for (int a = 0; a < 2; ++a)
#pragma unroll
        for (int b = 0; b < 2; ++b)
#pragma unroll
            for (int m = 0; m < 4; ++m)
#pragma unroll
                for (int n = 0; n < 2; ++n) acc[a][b][m][n] = (f32x4){0.f, 0.f, 0.f, 0.f};
    bf16x8 At[4][2], B0[2][2], B1[2][2];
    const char* cA = (const char*)g.A + (size_t)cur.pm * tstep; const char* cB = (const char*)g.Bt + (size_t)cur.pn * tstep;
    S.a_ready(cur);
    if constexpr (SP2) {
        PG8_STAGE(PG8_SB(0, 0), cB, voffB); PG8_STAGE(PG8_SB(0, 1), cB + hstep, voffB); PG8_STAGE(PG8_SA(0, 0), cA, voffA); PG8_STAGE(PG8_SA(0, 1), cA + hstep, voffA);
        if (wr == 1) PG8_BAR;
        PG8_WAIT_V(2); PG8_BAR;
        PG8_STAGE(PG8_SB(1, 0), cB + kstep, voffB); PG8_STAGE(PG8_SA(1, 0), cA + kstep, voffA); PG8_STAGE(PG8_SB(1, 1), cB + hstep + kstep, voffB);
        PG8_WAIT_V(6); PG8_BAR;
    } else {
        PG8_STAGE(PG8_SB(0, 0), cB, voffB); PG8_STAGE(PG8_SA(0, 0), cA, voffA); PG8_STAGE(PG8_SB(0, 1), cB + hstep, voffB); PG8_STAGE(PG8_SA(0, 1), cA + hstep, voffA);
        if (wr == 1) PG8_BAR;
        PG8_WAIT_V(4); PG8_BAR;
        PG8_STAGE(PG8_SB(1, 0), cB + kstep, voffB); PG8_STAGE(PG8_SA(1, 0), cA + kstep, voffA); PG8_STAGE(PG8_SB(1, 1), cB + hstep + kstep, voffB);
        PG8_WAIT_V(6); PG8_BAR;
    }
#pragma unroll 1
    for (;;) {
        const bool has_next = S.next(ui + 1, nxt);
        const char* nA = has_next ? (const char*)g.A + (size_t)nxt.pm * tstep : cA; const char* nB = has_next ? (const char*)g.Bt + (size_t)nxt.pn * tstep : cB;
#pragma unroll 1
        for (int t = 0; t < nt; t += 2) {
            const bool last = (t == nt - 2);
            const char* a1 = cA + (size_t)(t + 1) * kstep;
            const char* a2 = last ? nA : cA + (size_t)(t + 2) * kstep; const char* b2 = last ? nB : cB + (size_t)(t + 2) * kstep;
            const char* a3 = a2 + kstep; const char* b3 = b2 + kstep;
            if (last && has_next) S.a_ready(nxt);
            if constexpr (Epi::KHOOK) { if (t == 4 || t == 8) E.khook(acc, cur, wr, wc, fr, fq, t); }
            if constexpr (SP2) {
            PG8_LDB(B0, 0, 0); PG8_LDB(B1, 0, 1); PG8_SCHED; PG8_LDA(At, 0, 0); PG8_STAGE(PG8_SA(1, 1), a1 + hstep, voffA);
            PG8_WAIT_V(8); PG8_WAIT_L(0); PG8_BAR; PG8_MMA(0, 0, At, B0); PG8_MMA(0, 1, At, B1); PG8_BAR; PG8_SCHED;
            PG8_LDA(At, 0, 1); PG8_STAGE(PG8_SB(0, 0), b2, voffB); PG8_STAGE(PG8_SB(0, 1), b2 + hstep, voffB); PG8_STAGE(PG8_SA(0, 0), a2, voffA);
            PG8_WAIT_V(8); PG8_WAIT_L(0); PG8_BAR; PG8_MMA(1, 0, At, B0); PG8_MMA(1, 1, At, B1); PG8_BAR; PG8_SCHED;
            PG8_LDB(B0, 1, 0); PG8_LDB(B1, 1, 1); PG8_SCHED; PG8_LDA(At, 1, 0); PG8_STAGE(PG8_SA(0, 1), a2 + hstep, voffA);
            PG8_WAIT_V(8); PG8_WAIT_L(0); PG8_BAR; PG8_MMA(0, 0, At, B0); PG8_MMA(0, 1, At, B1); PG8_BAR; PG8_SCHED;
            PG8_LDA(At, 1, 1); PG8_STAGE(PG8_SB(1, 0), b3, voffB); PG8_STAGE(PG8_SB(1, 1), b3 + hstep, voffB); PG8_STAGE(PG8_SA(1, 0), a3, voffA);
            PG8_WAIT_V(8); PG8_WAIT_L(0); PG8_BAR; PG8_MMA(1, 0, At, B0); PG8_MMA(1, 1, At, B1); PG8_BAR; PG8_SCHED;
            } else {
            PG8_LDB(B0, 0, 0); PG8_SCHED; PG8_LDA(At, 0, 0); PG8_STAGE(PG8_SA(1, 1), a1 + hstep, voffA);
            PG8_WAIT_L(8); PG8_BAR; PG8_WAIT_L(0); PG8_MMA(0, 0, At, B0); PG8_BAR; PG8_SCHED;
            PG8_LDB(B1, 0, 1); PG8_STAGE(PG8_SB(0, 0), b2, voffB);
            PG8_BAR; PG8_WAIT_L(0); PG8_MMA(0, 1, At, B1); PG8_BAR;
            PG8_LDA(At, 0, 1); PG8_STAGE(PG8_SA(0, 0), a2, voffA);
            PG8_BAR; PG8_WAIT_L(0); PG8_MMA(1, 0, At, B0); PG8_BAR; PG8_SCHED;
            PG8_STAGE(PG8_SB(0, 1), b2 + hstep, voffB);
            PG8_WAIT_V(6); PG8_BAR; PG8_MMA(1, 1, At, B1); PG8_BAR;
            PG8_LDB(B0, 1, 0); PG8_SCHED; PG8_LDA(At, 1, 0); PG8_STAGE(PG8_SA(0, 1), a2 + hstep, voffA);
            PG8_WAIT_L(8); PG8_BAR; PG8_WAIT_L(0); PG8_MMA(0, 0, At, B0); PG8_BAR; PG8_SCHED;
            PG8_LDB(B1, 1, 1); PG8_STAGE(PG8_SB(1, 0), b3, voffB);
            PG8_BAR; PG8_WAIT_L(0); PG8_MMA(0, 1, At, B1); PG8_BAR;
            PG8_LDA(At, 1, 1); PG8_STAGE(PG8_SA(1, 0), a3, voffA);
            PG8_BAR; PG8_WAIT_L(0); PG8_MMA(1, 0, At, B0); PG8_BAR; PG8_SCHED;
            PG8_STAGE(PG8_SB(1, 1), b3 + hstep, voffB);
            PG8_WAIT_V(6); PG8_BAR; PG8_MMA(1, 1, At, B1); PG8_BAR;
            }
        }
        if constexpr (ALIGN_EPI) { if (wr == 0) PG8_BAR; }
        if constexpr (!Epi::AFTER_DRAIN) { E(acc, cur, wr, wc, fr, fq); S.done(cur); }
        if (!has_next) break;
#pragma unroll
        for (int a = 0; a < 2; ++a)
#pragma unroll
            for (int b = 0; b < 2; ++b)
#pragma unroll
                for (int m = 0; m < 4; ++m)
#pragma unroll
                    for (int n = 0; n < 2; ++n) acc[a][b][m][n] = (f32x4){0.f, 0.f, 0.f, 0.f};
        cur = nxt; cA = nA; cB = nB; ++ui;
        if constexpr (ALIGN_EPI) { if (wr == 1) PG8_BAR; }
    }
    PG8_WAIT_V(0);
    if constexpr (!ALIGN_EPI) { if (wr == 0) PG8_BAR; }
    PG8_BAR;
    if constexpr (Epi::AFTER_DRAIN) { E.fused(acc, cur, wr, wc, fr, fq, lds, wid, lane); S.done(cur); }
#undef PG8_SA
#undef PG8_SB
#undef PG8_STAGE
#undef PG8_LDA
#undef PG8_LDB
#undef PG8_MMA
#undef PG8_WAIT_V
#undef PG8_WAIT_L
#undef PG8_BAR
#undef PG8_SCHED
}
}
namespace cg = cooperative_groups;
#define LAS __attribute__((address_space(3)))
typedef unsigned short bf16;
typedef short bf16x8 __attribute__((ext_vector_type(8)));
typedef float f32x4 __attribute__((ext_vector_type(4)));
typedef unsigned u32x4 __attribute__((ext_vector_type(4)));
typedef unsigned u32x2 __attribute__((ext_vector_type(2)));

constexpr int DM = 1024, NB = 4, SEQ = 8192, DEPTH = 2, CTXL = 256;
constexpr int MLAT = NB * SEQ, MCTX = NB * CTXL, MT = MLAT + MCTX;
constexpr int DFF = 2816, NMOD = 9, WIN = 5120;
constexpr int NTHREADS = 512, NWAVES = 8;
constexpr float LN_EPS = 1e-6f;
constexpr float DN_ALPHA = 1.41421356237309515f;
constexpr int NCHUNK = 132;
constexpr float TWO_PI = 6.283185307179586f;

constexpr size_t al256(size_t x) { return (x + 255) & ~(size_t)255; }
constexpr size_t WS_CTL = 0, CTL_BYTES = 65536;
constexpr size_t WS_MOD = WS_CTL + CTL_BYTES;
constexpr size_t WS_HC = al256(WS_MOD + (size_t)DEPTH * 5 * 9216 * 4);
constexpr size_t WS_TBL = WS_HC + (size_t)MCTX * DM * 4;
constexpr size_t T_PNEG = 0;
constexpr size_t T_PPOS = T_PNEG + 2 * 16 * 2 * 64 * 64 * 4;
constexpr size_t T_BBT = T_PPOS + 2 * 16 * 2 * 64 * 64 * 4;
constexpr size_t T_CCT = T_BBT + 2 * 16 * 128 * 16 * 2;
constexpr size_t T_APOW = T_CCT + 2 * 16 * 4 * 16 * 32 * 2;
constexpr size_t T_WCB = T_APOW + 3 * 2 * 16 * 2 * 64 * 4;
constexpr size_t T_FA64 = T_WCB + 128 * 64 * 2;
constexpr size_t T_FA16 = T_FA64 + 2 * 64 * 4 * 32 * 2;
constexpr size_t T_FC128 = T_FA16 + 2 * 16 * 32 * 2;
constexpr size_t T_FC16 = T_FC128 + 128 * 256 * 2;
constexpr size_t T_ROPE = T_FC16 + 16 * 32 * 2;
constexpr size_t T_END = T_ROPE + 2 * 128 * 16 * 4;
constexpr size_t WS_SLOC = al256(WS_TBL + T_END);
constexpr size_t WS_WA = al256(WS_SLOC + (size_t)4 * 16 * 2 * NCHUNK * 128 * 4);
constexpr size_t WA_GU = 0, WA_DN = (size_t)5632 * 1024 * 2, WA_BYTES = WA_DN + (size_t)1024 * 2816 * 2;
constexpr size_t WS_WB = al256(WS_WA + WA_BYTES);
constexpr size_t WB_IN = 0, WB_GLU = WB_IN + (size_t)WIN * 1024 * 2, WB_BRS = WB_GLU + 256 * 256 * 2, WB_BRF = WB_BRS + 1024 * 256 * 2,
                 WB_BRN = WB_BRF + 1024 * 256 * 2, WB_OUT = WB_BRN + 1024 * 512 * 2, WB_BYTES = WB_OUT + 1024 * 1024 * 2;
constexpr size_t WS_U = al256(WS_WB + WB_BYTES);
constexpr size_t SZ_U = (size_t)MT * 1024 * 2;
constexpr size_t WS_RES = WS_U + SZ_U;
constexpr size_t WS_Z = WS_RES + SZ_U;
constexpr size_t SZ_256 = (size_t)MT * 256 * 2, SZ_512 = (size_t)MT * 512 * 2;
constexpr int VLD = SEQ;
constexpr size_t SZ_VT = al256((size_t)NB * 512 * VLD * 2 + (size_t)NB * 512 * CTXL * 2);
constexpr size_t Z_K = 0, Z_Q = Z_K + SZ_512, Z_VT = Z_Q + SZ_512, Z_SSMU = Z_VT + SZ_VT, Z_F = Z_SSMU + SZ_256, Z_G = Z_F + SZ_256, Z_END = Z_G + (size_t)MT * 3072 * 2;
constexpr size_t WS_END = WS_Z + Z_END;
constexpr size_t OV_YPRE = 0, OV_TBL = SZ_256, OV_TBC = OV_TBL + (size_t)16 * 64 * 2 * 64 * 128 * 2;
static_assert(OV_TBC + (size_t)16 * 16 * 2 * 64 * 16 * 2 <= SZ_U, "U overlay");
static_assert(SZ_256 * 2 + SZ_512 == SZ_U, "RES overlay");
constexpr size_t RESP_OFF = al256((size_t)MT * 2816 * 2);
static_assert(RESP_OFF + (size_t)11 * MCTX * DM * 2 <= Z_END, "ACT + RESP overlay");
static_assert(WS_END <= (size_t)536870912, "d_ws map exceeds 512 MiB");

#define QCTR(l, s) (4096 + 64 * (1 + (l) * 3 + (s)))

__device__ __forceinline__ unsigned f2bf(float f) { unsigned u = __builtin_bit_cast(unsigned, f); return (u + 0x7fffu + ((u >> 16) & 1u)) >> 16; }
__device__ __forceinline__ float bf2f(unsigned b) { return __builtin_bit_cast(float, b << 16); }
typedef __bf16 bf16x2_t __attribute__((ext_vector_type(2)));
typedef float f32x2_t __attribute__((ext_vector_type(2)));
__device__ __forceinline__ unsigned pk2(float lo, float hi) { const f32x2_t v = {lo, hi}; const bf16x2_t r = __builtin_convertvector(v, bf16x2_t); return __builtin_bit_cast(unsigned, r); }
__device__ __forceinline__ float bflo(unsigned w) { return __builtin_bit_cast(float, w << 16); }
__device__ __forceinline__ float bfhi(unsigned w) { return __builtin_bit_cast(float, w & 0xffff0000u); }
__device__ __forceinline__ float fsigmoid(float x) { return __builtin_amdgcn_rcpf(1.f + __expf(-x)); }
__device__ __forceinline__ float fsilu(float x) { return x * fsigmoid(x); }
__device__ __forceinline__ float gelu_tanh(float x) { const float z = 0.7978845608028654f * (x + 0.044715f * x * x * x); return x * fsigmoid(2.f * z); }
__device__ __forceinline__ f32x4 mfma16(bf16x8 a, bf16x8 b, f32x4 c) { return __builtin_amdgcn_mfma_f32_16x16x32_bf16(a, b, c, 0, 0, 0); }
__device__ __forceinline__ bf16x8 as_bf16x8(u32x4 v) { return __builtin_bit_cast(bf16x8, v); }
__device__ __forceinline__ bf16x8 pack8(f32x4 a, f32x4 b) { u32x4 w; w.x = pk2(a[0], a[1]); w.y = pk2(a[2], a[3]); w.z = pk2(b[0], b[1]); w.w = pk2(b[2], b[3]); return as_bf16x8(w); }
__device__ __forceinline__ float wave_sum(float v) {
#pragma unroll
    for (int o = 1; o < 64; o <<= 1) v += __shfl_xor(v, o);
    return v;
}
constexpr f32x4 F4Z = {0.f, 0.f, 0.f, 0.f};

struct Params {
    const float* in[27];
    float* out;
    unsigned char* ws;
};

struct Frame {
    LAS unsigned char* lds;
    int tid, lane, wave, gw, ngw;
};

__device__ __forceinline__ void tr_item(const float* __restrict__ W, int N, int k0, int n0, bf16* __restrict__ WT, int ldk, int drow0, LAS float* scr, int lane) {
#pragma unroll 8
    for (int i = 0; i < 32; ++i) { const int kk = 2 * i + (lane >> 5); scr[kk * 33 + (lane & 31)] = W[(size_t)(k0 + kk) * N + n0 + (lane & 31)]; }
    asm volatile("s_waitcnt lgkmcnt(0)" ::: "memory");
    const int c = lane & 7;
#pragma unroll
    for (int j = 0; j < 4; ++j) { const int n = (lane >> 3) + 8 * j; const LAS float* s = scr + (8 * c) * 33 + n;
        u32x4 o; o.x = pk2(s[0 * 33], s[1 * 33]); o.y = pk2(s[2 * 33], s[3 * 33]); o.z = pk2(s[4 * 33], s[5 * 33]); o.w = pk2(s[6 * 33], s[7 * 33]);
        *(u32x4*)(WT + (size_t)(drow0 + n) * ldk + k0 + 8 * c) = o; }
    asm volatile("s_waitcnt lgkmcnt(0)" ::: "memory");
}

constexpr int FFN_CONV_ITEMS = 2 * (DM / 64) * (DFF / 32) + (DFF / 64) * (DM / 32);
__device__ __forceinline__ void convert_ffn_item(const Params& P, LAS unsigned char* lds, int wave, int lane, int l, int f, int it) {
    LAS float* scr = (LAS float*)(lds + wave * 16384);
    const float* wg = P.in[8] + (size_t)(l * 2 + f) * DM * DFF;
    const float* wu = P.in[9] + (size_t)(l * 2 + f) * DM * DFF;
    const float* wd = P.in[10] + (size_t)(l * 2 + f) * DFF * DM;
    bf16* gu = (bf16*)(P.ws + WS_WA + WA_GU); bf16* dn = (bf16*)(P.ws + WS_WA + WA_DN);
    constexpr int I_G = (DM / 64) * (DFF / 32);
    int r = it;
    if (r < 2 * I_G) { const int up = r >= I_G; if (up) r -= I_G; const int nblk = DFF / 32, kb = r / nblk, nb = r % nblk, n0 = nb * 32;
        tr_item(up ? wu : wg, DFF, kb * 64, n0, gu, DM, 256 * (n0 / 128) + (n0 % 128) + (up ? 128 : 0), scr, lane); return; }
    r -= 2 * I_G; { const int nblk = DM / 32, kb = r / nblk, nb = r % nblk; tr_item(wd, DM, kb * 64, nb * 32, dn, DFF, nb * 32, scr, lane); }
}
__device__ __forceinline__ void convert_ffn(const Frame& F, const Params& P, int l, int f) {
    for (int it = F.gw; it < FFN_CONV_ITEMS; it += F.ngw) convert_ffn_item(P, F.lds, F.wave, F.lane, l, f, it);
}
__device__ __forceinline__ void convert_mixer(const Frame& F, const Params& P, int l) {
    LAS float* scr = (LAS float*)(F.lds + F.wave * 16384);
    constexpr int I_IN = (DM / 64) * (WIN / 32), I_GLU = 4 * 8, I_BRS = 4 * 32, I_BRF = 4 * 32, I_BRN = 8 * 32, I_OUT = 16 * 32;
    for (int it = F.gw; it < I_IN + I_GLU + I_BRS + I_BRF + I_BRN + I_OUT; it += F.ngw) {
        int r = it;
        if (r < I_IN) { const int nblk = WIN / 32; tr_item(P.in[11] + (size_t)l * DM * WIN, WIN, (r / nblk) * 64, (r % nblk) * 32, (bf16*)(P.ws + WS_WB + WB_IN), DM, (r % nblk) * 32, scr, F.lane); continue; } r -= I_IN;
        if (r < I_GLU) { tr_item(P.in[20] + (size_t)l * 256 * 256, 256, (r / 8) * 64, (r % 8) * 32, (bf16*)(P.ws + WS_WB + WB_GLU), 256, (r % 8) * 32, scr, F.lane); continue; } r -= I_GLU;
        if (r < I_BRS) { tr_item(P.in[23] + (size_t)l * 256 * DM, DM, (r / 32) * 64, (r % 32) * 32, (bf16*)(P.ws + WS_WB + WB_BRS), 1024, (r % 32) * 32, scr, F.lane); continue; } r -= I_BRS;
        if (r < I_BRF) { tr_item(P.in[24] + (size_t)l * 256 * DM, DM, (r / 32) * 64, (r % 32) * 32, (bf16*)(P.ws + WS_WB + WB_BRS) + 256, 1024, (r % 32) * 32, scr, F.lane); continue; } r -= I_BRF;
        if (r < I_BRN) { tr_item(P.in[25] + (size_t)l * 512 * DM, DM, (r / 32) * 64, (r % 32) * 32, (bf16*)(P.ws + WS_WB + WB_BRS) + 512, 1024, (r % 32) * 32, scr, F.lane); continue; } r -= I_BRN;
        tr_item(P.in[26] + (size_t)l * DM * DM, DM, (r / 32) * 64, (r % 32) * 32, (bf16*)(P.ws + WS_WB + WB_OUT), DM, (r % 32) * 32, scr, F.lane);
    }
}

__device__ __forceinline__ void make_s5_tables(const Frame& F, const Params& P, int l) {
    unsigned char* tb = P.ws + WS_TBL;
    float* pneg = (float*)(tb + T_PNEG); float* ppos = (float*)(tb + T_PPOS); bf16* bbt = (bf16*)(tb + T_BBT); bf16* cct = (bf16*)(tb + T_CCT); float* apow = (float*)(tb + T_APOW);
    const float* log_dt = P.in[12] + l * 32; const float* a_re = P.in[13] + l * 2048; const float* a_im = P.in[14] + l * 2048;
    const float* b_re = P.in[15] + (size_t)l * 32768; const float* b_im = P.in[16] + (size_t)l * 32768;
    const float* c_re = P.in[17] + (size_t)l * 32768; const float* c_im = P.in[18] + (size_t)l * 32768;
    const int gt = F.gw * 64 + F.lane, ngt = F.ngw * 64;
    for (int i = gt; i < 32 * 64 * 64; i += ngt) {
        const int t = i & 63, p = (i >> 6) & 63, dg = i >> 12, dir = dg >> 4;
        const float dt = expf(log_dt[dg]), ar = a_re[dg * 64 + p] * dt, ai = a_im[dg * 64 + p] * dt;
        const float e = (float)(dir ? 63 - t : t);
        float sn, cs; sincosf(e * ai, &sn, &cs);
        const float mp = expf(e * ar), mn = expf(-e * ar);
        pneg[((size_t)(dg * 2 + 0) * 64 + p) * 64 + t] = mn * cs; pneg[((size_t)(dg * 2 + 1) * 64 + p) * 64 + t] = -mn * sn;
        ppos[((size_t)(dg * 2 + 0) * 64 + t) * 64 + p] = mp * cs; ppos[((size_t)(dg * 2 + 1) * 64 + t) * 64 + p] = mp * sn;
    }
    for (int i = gt; i < 32 * 64; i += ngt) {
        const int p = i & 63, dg = i >> 6;
        const float dt = expf(log_dt[dg]), are = a_re[dg * 64 + p], aim = a_im[dg * 64 + p], ar = are * dt, ai = aim * dt;
        const float es[3] = {1.f, 63.f, 64.f};
#pragma unroll
        for (int k = 0; k < 3; ++k) { float sn, cs; sincosf(es[k] * ai, &sn, &cs); const float m = expf(es[k] * ar);
            apow[((size_t)(k * 32 + dg) * 2 + 0) * 64 + p] = m * cs; apow[((size_t)(k * 32 + dg) * 2 + 1) * 64 + p] = m * sn; }
        float sn, cs; sincosf(ai, &sn, &cs); const float mag = expf(ar);
        const float abr = mag * cs, abi = mag * sn, den = are * are + aim * aim, nr = abr - 1.f, ni = abi;
        const float fr = (nr * are + ni * aim) / den, fi = (ni * are - nr * aim) / den;
#pragma unroll
        for (int c = 0; c < 16; ++c) {
            const float br = b_re[((size_t)dg * 64 + p) * 16 + c], bi = b_im[((size_t)dg * 64 + p) * 16 + c];
            bbt[((size_t)dg * 128 + p) * 16 + c] = (bf16)f2bf(fr * br - fi * bi);
            bbt[((size_t)dg * 128 + 64 + p) * 16 + c] = (bf16)f2bf(fr * bi + fi * br);
        }
    }
    for (int i = gt; i < 32 * 4 * 16 * 4 * 8; i += ngt) {
        const int s = i & 7, G = (i >> 3) & 3, c = (i >> 5) & 15, mt = (i >> 9) & 3, dg = i >> 11;
        const int p = 16 * mt + 4 * G + (s & 3);
        const float v = (s < 4) ? c_re[((size_t)dg * 16 + c) * 64 + p] : -c_im[((size_t)dg * 16 + c) * 64 + p];
        cct[i] = (bf16)f2bf(v);
    }
}
__device__ __forceinline__ void make_static_tables(const Frame& F, const Params& P) {
    unsigned char* tb = P.ws + WS_TBL;
    const int gt = F.gw * 64 + F.lane, ngt = F.ngw * 64;
    bf16* wcb = (bf16*)(tb + T_WCB);
    for (int i = gt; i < 128 * 64; i += ngt) { const int c = i & 63, mp = i >> 6, m = mp & 63; float sn, cs; sincospif(2.f * (float)((m * c) & 63) / 64.f, &sn, &cs);
        wcb[i] = (bf16)f2bf((mp < 64 ? cs : -sn) * 0.125f); }
    bf16* fa64 = (bf16*)(tb + T_FA64);
    for (int i = gt; i < 2 * 64 * 4 * 32; i += ngt) { const int s = i & 7, G = (i >> 3) & 3, lt = (i >> 5) & 3, k1 = (i >> 7) & 63, po = i >> 13;
        const int l1 = 16 * lt + 4 * G + (s & 3); float sn, cs; sincospif(2.f * (float)((k1 * l1) & 63) / 64.f, &sn, &cs);
        const float v = (po == 0) ? ((s < 4) ? cs : sn) : ((s < 4) ? -sn : cs); fa64[i] = (bf16)f2bf(v * 0.125f); }
    bf16* fa16 = (bf16*)(tb + T_FA16);
    for (int i = gt; i < 2 * 16 * 32; i += ngt) { const int s = i & 7, G = (i >> 3) & 3, k1 = (i >> 5) & 15, po = i >> 9;
        const int l1 = 4 * G + (s & 3); float sn, cs; sincospif(2.f * (float)((k1 * l1) & 15) / 16.f, &sn, &cs);
        const float v = (po == 0) ? ((s < 4) ? cs : sn) : ((s < 4) ? -sn : cs); fa16[i] = (bf16)f2bf(v * 0.25f); }
    bf16* fc128 = (bf16*)(tb + T_FC128);
    for (int i = gt; i < 128 * 256; i += ngt) { const int kap = i & 255, k2 = i >> 8, part = kap >> 7, l2 = kap & 127; float sn, cs; sincospif(2.f * (float)((k2 * l2) & 127) / 128.f, &sn, &cs);
        fc128[i] = (bf16)f2bf((part ? sn : cs) * 0.08838834764831845f); }
    bf16* fc16 = (bf16*)(tb + T_FC16);
    for (int i = gt; i < 16 * 32; i += ngt) { const int kap = i & 31, k2 = i >> 5, part = kap >> 4, l2 = kap & 15; float sn, cs; sincospif(2.f * (float)((k2 * l2) & 15) / 16.f, &sn, &cs);
        fc16[i] = (bf16)f2bf((part ? sn : cs) * 0.25f); }
    float* rope = (float*)(tb + T_ROPE);
    for (int i = gt; i < 128 * 16; i += ngt) { const int f = i & 15, pos = i >> 4; const float inv = powf(10000.f, -(float)f / 16.f); const float ang = (float)pos * inv;
        rope[i] = cosf(ang); rope[128 * 16 + i] = sinf(ang); }
}

__device__ __forceinline__ void mod_phase(const Frame& F, const Params& P) {
    LAS float* sc = (LAS float*)(F.lds + 8 * 16384);
    LAS float* part = (LAS float*)(F.lds);
    for (int i = F.tid; i < 5 * DM; i += NTHREADS) { const float v = (i < 4 * DM) ? P.in[1][i] : P.in[3][i - 4 * DM]; sc[i] = fsilu(v); }
    __syncthreads();
    float* mod = (float*)(P.ws + WS_MOD);
    for (int task = blockIdx.x; task < 288; task += gridDim.x) {
        const int l = task / 144, j = (task % 144) * 64 + F.lane, k0 = F.wave * 128;
        const float* w = P.in[4] + (size_t)l * DM * 9216 + (size_t)k0 * 9216 + j;
        float a0 = 0.f, a1 = 0.f, a2 = 0.f, a3 = 0.f, a4 = 0.f;
#pragma unroll 16
        for (int k = 0; k < 128; ++k) { const float wv = w[(size_t)k * 9216]; a0 += sc[k0 + k] * wv; a1 += sc[DM + k0 + k] * wv; a2 += sc[2 * DM + k0 + k] * wv; a3 += sc[3 * DM + k0 + k] * wv; a4 += sc[4 * DM + k0 + k] * wv; }
        LAS float* pw = part + F.wave * 320 + F.lane;
        pw[0] = a0; pw[64] = a1; pw[128] = a2; pw[192] = a3; pw[256] = a4;
        __syncthreads();
        if (F.tid < 320) { float s = 0.f;
#pragma unroll
            for (int wv = 0; wv < 8; ++wv) s += part[wv * 320 + F.tid];
            const int r = F.tid >> 6, jj = (task % 144) * 64 + (F.tid & 63); mod[((size_t)l * 5 + r) * 9216 + jj] = s + P.in[5][l * 9216 + jj]; }
        __syncthreads();
    }
}

__device__ __forceinline__ const float* mod_vec(const Params& P, int l, int bidx, int i) { return (const float*)(P.ws + WS_MOD) + ((size_t)l * 5 + bidx) * 9216 + i * DM; }
template <int MODE>
__device__ __forceinline__ void rowwise_phase(const Frame& F, const Params& P, int l, int gi, float gscale, int lni, int lu, int si, bool do_u, bool first_h, int nrows, int nparts) {
    bf16* U = (bf16*)(P.ws + WS_U); const bf16* RES = (const bf16*)(P.ws + WS_RES); float* HC = (float*)(P.ws + WS_HC);
    const int r_lo = (int)(((long long)nrows * F.gw) / F.ngw), r_hi = (int)(((long long)nrows * (F.gw + 1)) / F.ngw);
    int cur_b = -1;
    f32x4 vg[4], vlg[4], vlb[4], vsh[4], vsc[4];
    {
#pragma unroll 2
        for (int row = r_lo; row < r_hi; ++row) {
            const bool lat = row < MLAT; const int bidx = lat ? row / SEQ : 4;
            if (bidx != cur_b) { cur_b = bidx;
#pragma unroll
                for (int j = 0; j < 4; ++j) { const int c = 4 * F.lane + 256 * j;
                    if (MODE == 1) { vg[j] = *(const f32x4*)(mod_vec(P, l, bidx, gi) + c) * gscale; vlg[j] = *(const f32x4*)(P.in[6] + (size_t)(l * 3 + lni) * DM + c); vlb[j] = *(const f32x4*)(P.in[7] + (size_t)(l * 3 + lni) * DM + c); }
                    if (do_u) { vsh[j] = *(const f32x4*)(mod_vec(P, lu, bidx, si) + c); vsc[j] = *(const f32x4*)(mod_vec(P, lu, bidx, si + 1) + c) + 1.f; } } }
            const float* hin; float* hout;
            if (lat) { hin = (first_h ? P.in[0] : P.out) + (size_t)row * DM; hout = P.out + (size_t)row * DM; }
            else { hin = (first_h ? P.in[2] : HC) + (size_t)(row - MLAT) * DM; hout = HC + (size_t)(row - MLAT) * DM; }
            f32x4 v[4];
#pragma unroll
            for (int j = 0; j < 4; ++j) v[j] = *(const f32x4*)(hin + 4 * F.lane + 256 * j);
            if (MODE == 1) {
                float s = 0.f;
#pragma unroll
                for (int j = 0; j < 4; ++j) { const int c = 4 * F.lane + 256 * j; u32x2 r;
                    if (lat || nparts == 1) r = *(const u32x2*)(RES + (size_t)row * DM + c);
                    else { const bf16* rp = (const bf16*)(P.ws + WS_Z + RESP_OFF) + (size_t)(row - MLAT) * DM + c; float a0 = 0.f, a1 = 0.f, a2 = 0.f, a3 = 0.f;
                        for (int k = 0; k < nparts; ++k) { const u32x2 q = *(const u32x2*)(rp + (size_t)k * MCTX * DM); a0 += bflo(q.x); a1 += bfhi(q.x); a2 += bflo(q.y); a3 += bfhi(q.y); }
                        r.x = pk2(a0, a1); r.y = pk2(a2, a3); }
                    v[j][0] = DN_ALPHA * v[j][0] + vg[j][0] * bflo(r.x); v[j][1] = DN_ALPHA * v[j][1] + vg[j][1] * bfhi(r.x);
                    v[j][2] = DN_ALPHA * v[j][2] + vg[j][2] * bflo(r.y); v[j][3] = DN_ALPHA * v[j][3] + vg[j][3] * bfhi(r.y);
                    s += (v[j][0] + v[j][1]) + (v[j][2] + v[j][3]); }
                const float mean = wave_sum(s) * (1.f / DM); float s2 = 0.f;
#pragma unroll
                for (int j = 0; j < 4; ++j) { v[j] = v[j] - mean; s2 += (v[j][0] * v[j][0] + v[j][1] * v[j][1]) + (v[j][2] * v[j][2] + v[j][3] * v[j][3]); }
                const float rstd = rsqrtf(wave_sum(s2) * (1.f / DM) + LN_EPS);
#pragma unroll
                for (int j = 0; j < 4; ++j) { const int c = 4 * F.lane + 256 * j; v[j] = v[j] * rstd * vlg[j] + vlb[j]; *(f32x4*)(hout + c) = v[j]; }
            }
            if (do_u) {
                float s = 0.f;
#pragma unroll
                for (int j = 0; j < 4; ++j) s += (v[j][0] + v[j][1]) + (v[j][2] + v[j][3]);
                const float mean = wave_sum(s) * (1.f / DM); float s2 = 0.f;
#pragma unroll
                for (int j = 0; j < 4; ++j) { v[j] = v[j] - mean; s2 += (v[j][0] * v[j][0] + v[j][1] * v[j][1]) + (v[j][2] * v[j][2] + v[j][3] * v[j][3]); }
                const float rstd = rsqrtf(wave_sum(s2) * (1.f / DM) + LN_EPS);
#pragma unroll
                for (int j = 0; j < 4; ++j) { const int c = 4 * F.lane + 256 * j; const f32x4 o = v[j] * rstd * vsc[j] + vsh[j]; u32x2 w; w.x = pk2(o[0], o[1]); w.y = pk2(o[2], o[3]); *(u32x2*)(U + (size_t)row * DM + c) = w; }
            }
        }
    }
}
#define XB_TMO      128
#define XB_XCNT(j)  (256  + 64 * (j))
#define XB_XSUB(j)  (1280 + 64 * (j))
#define XB_XGEN(j)  (2304 + 64 * (j))
#define XB_TOP      3328
#define XB_TOPGEN   3392
#define XCD_BAR_WORDS 3456
#define XB_SPIN_CAP (1u << 30)

__device__ __forceinline__ unsigned xb_ld(unsigned* p)              { return __hip_atomic_load(p, __ATOMIC_RELAXED, __HIP_MEMORY_SCOPE_AGENT); }
__device__ __forceinline__ unsigned xb_add(unsigned* p, unsigned v) { return __hip_atomic_fetch_add(p, v, __ATOMIC_RELAXED, __HIP_MEMORY_SCOPE_AGENT); }
__device__ __forceinline__ unsigned xb_xcc_id() { return (unsigned)__builtin_amdgcn_s_getreg((3 << 11) | 20) & 0xFu; }
#define XB_SPIN(cond, bar) do { unsigned _sp = 0; while (cond) { __builtin_amdgcn_s_sleep(1); \
    if ((++_sp & 255u) == 0u) { if (xb_ld(&(bar)[XB_TMO])) break; if (_sp > XB_SPIN_CAP) { atomicAdd(&(bar)[XB_TMO], 1u); break; } } } } while (0)

struct XcdBarrier {
    unsigned* bar; unsigned x;
    volatile LAS unsigned* st;
};

__device__ __forceinline__ XcdBarrier xcd_barrier_post(unsigned* bar, volatile LAS unsigned* st, int tid) {
    XcdBarrier b; b.bar = bar; b.x = xb_xcc_id(); b.st = st;
    if (tid == 0) (void)xb_add(&bar[XB_XCNT(b.x)], 1u);
    return b;
}
__device__ __forceinline__ void xcd_barrier_complete(unsigned* bar, unsigned x, unsigned& nloc, unsigned& nx) {
    const unsigned G = gridDim.x * gridDim.y * gridDim.z;
    unsigned sum, cnt, mine, sp = 0u;
    for (;;) {
        sum = 0u; cnt = 0u; mine = 0u;
#pragma unroll
        for (unsigned j = 0; j < 16; ++j) { const unsigned c = xb_ld(&bar[XB_XCNT(j)]); sum += c; cnt += (c > 0u) ? 1u : 0u; mine = (j == x) ? c : mine; }
        if (sum == G) break;
        __builtin_amdgcn_s_sleep(1);
        if ((++sp & 255u) == 0u) { if (xb_ld(&bar[XB_TMO])) break; if (sp > XB_SPIN_CAP) { atomicAdd(&bar[XB_TMO], 1u); break; } }
    }
    nloc = mine > 0u ? mine : 1u; nx = cnt > 0u ? cnt : 1u;
}

__device__ __forceinline__ void xcd_barrier(const XcdBarrier& b, int tid) {
    asm volatile("s_waitcnt vmcnt(0)" ::: "memory");
    __syncthreads();
    if (tid == 0) {
        unsigned* bar = b.bar;
        __builtin_amdgcn_s_waitcnt(0);
        unsigned nloc = b.st[0], nx = b.st[1];
        if (nloc == 0u) { xcd_barrier_complete(bar, b.x, nloc, nx); b.st[0] = nloc; b.st[1] = nx; }
        const unsigned old = xb_add(&bar[XB_XSUB(b.x)], 1u);
        const unsigned gen = old / nloc;
        if (old + 1u == (gen + 1u) * nloc) {
            __builtin_amdgcn_fence(__ATOMIC_RELEASE, "agent");
            asm volatile("s_waitcnt vmcnt(0)" ::: "memory");
            const unsigned og = xb_add(&bar[XB_TOP], 1u);
            const unsigned tg = og / nx;
            if (og + 1u == (tg + 1u) * nx) xb_add(&bar[XB_TOPGEN], 1u);
            else XB_SPIN(xb_ld(&bar[XB_TOPGEN]) == tg, bar);
            __builtin_amdgcn_fence(__ATOMIC_ACQUIRE, "agent");
            xb_add(&bar[XB_XGEN(b.x)], 1u);
            asm volatile("s_waitcnt vmcnt(0)" ::: "memory");
        } else {
            XB_SPIN(xb_ld(&bar[XB_XGEN(b.x)]) == gen, bar);
            __builtin_amdgcn_fence(__ATOMIC_ACQUIRE, "agent");
            asm volatile("s_waitcnt vmcnt(0)" ::: "memory");
        }
    }
    __syncthreads();
}
typedef f32x4 AccT[2][2][4][2];
__device__ __forceinline__ const void* uni_ptr(const void* p) { const unsigned long long v = (unsigned long long)p; unsigned lo = __builtin_amdgcn_readfirstlane((unsigned)v), hi = __builtin_amdgcn_readfirstlane((unsigned)(v >> 32));
    asm volatile("" : "+s"(lo), "+s"(hi)); return (const void*)(((unsigned long long)hi << 32) | lo); }
#define EPI_ROWS(u, wr, fr, ai, m) ((u).pm * 256 + (ai) * 128 + (wr) * 64 + (m) * 16 + (fr))

struct EpiGU {
    static constexpr bool PERM = true, AFTER_DRAIN = false, KHOOK = false;
    bf16* O;
    __device__ __forceinline__ void operator()(const AccT& acc, const pg8::Unit& u, int wr, int wc, int fr, int fq) const {
        asm volatile("" : "+v"(fr), "+v"(fq));
        const int col = u.pn * 128 + wc * 32 + 8 * fq;
#pragma unroll
        for (int ai = 0; ai < 2; ++ai)
#pragma unroll
            for (int m = 0; m < 4; ++m) {
                const size_t row = EPI_ROWS(u, wr, fr, ai, m);
                const f32x4 g0 = acc[ai][0][m][0], g1 = acc[ai][0][m][1], u0 = acc[ai][1][m][0], u1 = acc[ai][1][m][1];
                u32x4 w; w.x = pk2(fsilu(g0[0]) * u0[0], fsilu(g0[1]) * u0[1]); w.y = pk2(fsilu(g0[2]) * u0[2], fsilu(g0[3]) * u0[3]);
                w.z = pk2(fsilu(g1[0]) * u1[0], fsilu(g1[1]) * u1[1]); w.w = pk2(fsilu(g1[2]) * u1[2], fsilu(g1[3]) * u1[3]);
                *(u32x4*)(O + row * DFF + col) = w;
            }
    }
};
struct EpiStore {
    static constexpr bool PERM = true, AFTER_DRAIN = false, KHOOK = false;
    bf16* O; int ldc;
    __device__ __forceinline__ void operator()(const AccT& acc, const pg8::Unit& u, int wr, int wc, int fr, int fq) const {
        asm volatile("" : "+v"(fr), "+v"(fq));
#pragma unroll
        for (int ai = 0; ai < 2; ++ai)
#pragma unroll
            for (int m = 0; m < 4; ++m) {
                const size_t row = EPI_ROWS(u, wr, fr, ai, m);
#pragma unroll
                for (int bj = 0; bj < 2; ++bj) { const int col = u.pn * 256 + bj * 128 + wc * 32 + 8 * fq; const f32x4 v0 = acc[ai][bj][m][0], v1 = acc[ai][bj][m][1];
                    u32x4 w; w.x = pk2(v0[0], v0[1]); w.y = pk2(v0[2], v0[3]); w.z = pk2(v1[0], v1[1]); w.w = pk2(v1[2], v1[3]);
                    *(u32x4*)(O + row * ldc + col) = w; }
            }
    }
};
struct EpiGLU {
    static constexpr bool PERM = true, AFTER_DRAIN = false, KHOOK = false;
    const bf16* Y; const float* bias; bf16* O;
    __device__ __forceinline__ void operator()(const AccT& acc, const pg8::Unit& u, int wr, int wc, int fr, int fq) const {
        asm volatile("" : "+v"(fr), "+v"(fq));
#pragma unroll
        for (int ai = 0; ai < 2; ++ai)
#pragma unroll
            for (int m = 0; m < 4; ++m) {
                const size_t row = EPI_ROWS(u, wr, fr, ai, m);
#pragma unroll
                for (int bj = 0; bj < 2; ++bj) {
                    const int col = bj * 128 + wc * 32 + 8 * fq;
                    const f32x4 b0 = *(const f32x4*)(bias + col), b1 = *(const f32x4*)(bias + col + 4);
                    const u32x4 y = *(const u32x4*)(Y + row * 256 + col); const f32x4 v0 = acc[ai][bj][m][0] + b0, v1 = acc[ai][bj][m][1] + b1;
                    u32x4 w; w.x = pk2(bflo(y.x) * fsigmoid(v0[0]), bfhi(y.x) * fsigmoid(v0[1])); w.y = pk2(bflo(y.y) * fsigmoid(v0[2]), bfhi(y.y) * fsigmoid(v0[3]));
                    w.z = pk2(bflo(y.z) * fsigmoid(v1[0]), bfhi(y.z) * fsigmoid(v1[1])); w.w = pk2(bflo(y.w) * fsigmoid(v1[2]), bfhi(y.w) * fsigmoid(v1[3]));
                    *(u32x4*)(O + row * 1024 + col) = w;
                    asm volatile("" ::: "memory");
                }
            }
    }
};
template <bool FIRST> struct EpiMerge {
    static constexpr bool PERM = true, AFTER_DRAIN = false, KHOOK = false;
    const bf16* G; int gi; bf16* O;
    __device__ __forceinline__ void operator()(const AccT& acc, const pg8::Unit& u, int wr, int wc, int fr, int fq) const {
        asm volatile("" : "+v"(fr), "+v"(fq));
#pragma unroll
        for (int ai = 0; ai < 2; ++ai)
#pragma unroll
            for (int m = 0; m < 4; ++m) {
                const size_t row = EPI_ROWS(u, wr, fr, ai, m);
#pragma unroll
                for (int bj = 0; bj < 2; ++bj) { const int col = u.pn * 256 + bj * 128 + wc * 32 + 8 * fq;
                    const u32x4 g = *(const u32x4*)(G + row * 3072 + gi * 1024 + col); const f32x4 v0 = acc[ai][bj][m][0], v1 = acc[ai][bj][m][1];
                    float o[8] = {bflo(g.x) * v0[0], bfhi(g.x) * v0[1], bflo(g.y) * v0[2], bfhi(g.y) * v0[3], bflo(g.z) * v1[0], bfhi(g.z) * v1[1], bflo(g.w) * v1[2], bfhi(g.w) * v1[3]};
                    if (!FIRST) { const u32x4 p = *(const u32x4*)(O + row * DM + col);
                        o[0] += bflo(p.x); o[1] += bfhi(p.x); o[2] += bflo(p.y); o[3] += bfhi(p.y); o[4] += bflo(p.z); o[5] += bfhi(p.z); o[6] += bflo(p.w); o[7] += bfhi(p.w); }
                    u32x4 w; w.x = pk2(o[0], o[1]); w.y = pk2(o[2], o[3]); w.z = pk2(o[4], o[5]); w.w = pk2(o[6], o[7]);
                    *(u32x4*)(O + row * DM + col) = w; asm volatile("" ::: "memory"); }
            }
    }
};
struct EpiMergeK {
    static constexpr bool PERM = true, AFTER_DRAIN = false, KHOOK = true;
    const bf16* G; bf16* O;
    __device__ __forceinline__ void khook(AccT& acc, const pg8::Unit& u, int wr, int wc, int fr, int fq, int t) const {
        asm volatile("" : "+v"(fr), "+v"(fq));
        const int ga = (t == 4) ? 0 : 1024, gb = ga + 1024;
#pragma unroll
        for (int ai = 0; ai < 2; ++ai)
#pragma unroll
            for (int m = 0; m < 4; ++m) {
                const size_t row = EPI_ROWS(u, wr, fr, ai, m);
#pragma unroll
                for (int bj = 0; bj < 2; ++bj) { const int col = u.pn * 256 + bj * 128 + wc * 32 + 8 * fq;
                    const u32x4 a = *(const u32x4*)(G + row * 3072 + ga + col), b = *(const u32x4*)(G + row * 3072 + gb + col);
                    acc[ai][bj][m][0][0] *= bflo(a.x) * __builtin_amdgcn_rcpf(1e-30f + bflo(b.x)); acc[ai][bj][m][0][1] *= bfhi(a.x) * __builtin_amdgcn_rcpf(1e-30f + bfhi(b.x));
                    acc[ai][bj][m][0][2] *= bflo(a.y) * __builtin_amdgcn_rcpf(1e-30f + bflo(b.y)); acc[ai][bj][m][0][3] *= bfhi(a.y) * __builtin_amdgcn_rcpf(1e-30f + bfhi(b.y));
                    acc[ai][bj][m][1][0] *= bflo(a.z) * __builtin_amdgcn_rcpf(1e-30f + bflo(b.z)); acc[ai][bj][m][1][1] *= bfhi(a.z) * __builtin_amdgcn_rcpf(1e-30f + bfhi(b.z));
                    acc[ai][bj][m][1][2] *= bflo(a.w) * __builtin_amdgcn_rcpf(1e-30f + bflo(b.w)); acc[ai][bj][m][1][3] *= bfhi(a.w) * __builtin_amdgcn_rcpf(1e-30f + bfhi(b.w));
                    asm volatile("" ::: "memory"); }
            }
    }
    __device__ __forceinline__ void operator()(const AccT& acc, const pg8::Unit& u, int wr, int wc, int fr, int fq) const {
        asm volatile("" : "+v"(fr), "+v"(fq));
#pragma unroll
        for (int ai = 0; ai < 2; ++ai)
#pragma unroll
            for (int m = 0; m < 4; ++m) {
                const size_t row = EPI_ROWS(u, wr, fr, ai, m);
#pragma unroll
                for (int bj = 0; bj < 2; ++bj) { const int col = u.pn * 256 + bj * 128 + wc * 32 + 8 * fq;
                    const u32x4 g = *(const u32x4*)(G + row * 3072 + 2048 + col); const f32x4 v0 = acc[ai][bj][m][0], v1 = acc[ai][bj][m][1];
                    u32x4 w; w.x = pk2(bflo(g.x) * v0[0], bfhi(g.x) * v0[1]); w.y = pk2(bflo(g.y) * v0[2], bfhi(g.y) * v0[3]); w.z = pk2(bflo(g.z) * v1[0], bfhi(g.z) * v1[1]); w.w = pk2(bflo(g.w) * v1[2], bfhi(g.w) * v1[3]);
                    *(u32x4*)(O + row * DM + col) = w; asm volatile("" ::: "memory"); }
            }
    }
};
struct EpiWin {
    static constexpr bool PERM = true, AFTER_DRAIN = false, KHOOK = false;
    unsigned char* z; const float* rope;
    __device__ __forceinline__ void operator()(const AccT& acc, const pg8::Unit& u, int wr, int wc, int fr, int fq) const {
        asm volatile("" : "+v"(fr), "+v"(fq));
        const int pn = u.pn;
        unsigned char* z = (unsigned char*)uni_ptr(this->z); const float* rope = (const float*)uni_ptr(this->rope);
        if (pn == 0 || pn == 5 || pn >= 8) {
            bf16* O; int ldc, cb; const bool sig = pn >= 8;
            if (pn == 0) { O = (bf16*)(z + Z_SSMU); ldc = 256; cb = 0; } else if (pn == 5) { O = (bf16*)(z + Z_F); ldc = 256; cb = 0; } else { O = (bf16*)(z + Z_G); ldc = 3072; cb = (pn - 8) * 256; }
#pragma unroll
            for (int ai = 0; ai < 2; ++ai)
#pragma unroll
                for (int m = 0; m < 4; ++m) {
                    const size_t row = EPI_ROWS(u, wr, fr, ai, m);
#pragma unroll
                    for (int bj = 0; bj < 2; ++bj) { const int col = cb + bj * 128 + wc * 32 + 8 * fq; f32x4 v0 = acc[ai][bj][m][0], v1 = acc[ai][bj][m][1];
                        if (sig) {
#pragma unroll
                            for (int j = 0; j < 4; ++j) { v0[j] = fsigmoid(v0[j]); v1[j] = fsigmoid(v1[j]); } }
                        u32x4 w; w.x = pk2(v0[0], v0[1]); w.y = pk2(v0[2], v0[3]); w.z = pk2(v1[0], v1[1]); w.w = pk2(v1[2], v1[3]);
                        *(u32x4*)(O + row * ldc + col) = w; }
                }
        } else if (pn == 3 || pn == 4) {
            bf16* VT = (bf16*)(z + Z_VT); bf16* VCT = VT + (size_t)NB * 512 * VLD;
#pragma unroll
            for (int ai = 0; ai < 2; ++ai)
#pragma unroll
                for (int m = 0; m < 4; ++m) {
                    const int row = EPI_ROWS(u, wr, fr, ai, m);
                    bf16* base; int ldt;
                    if (row < MLAT) { const int b = row / SEQ, t = row % SEQ; base = VT + (size_t)b * 512 * VLD + t; ldt = VLD; }
                    else { const int rc = row - MLAT, b = rc / CTXL, t = rc % CTXL; base = VCT + (size_t)b * 512 * CTXL + t; ldt = CTXL; }
#pragma unroll
                    for (int bj = 0; bj < 2; ++bj) { const int vc = (pn - 3) * 256 + bj * 128 + wc * 32 + 8 * fq;
#pragma unroll
                        for (int n = 0; n < 2; ++n)
#pragma unroll
                            for (int j = 0; j < 4; ++j) base[(size_t)(vc + 4 * n + j) * ldt] = (bf16)f2bf(acc[ai][bj][m][n][j]); }
                }
        } else {
            const bool isq = pn >= 6; bf16* O = (bf16*)(z + (isq ? Z_Q : Z_K)); const int cb = (pn - (isq ? 6 : 1)) * 256; const float qs = isq ? 0.125f * 1.4426950408889634f : 1.f;
            const bool latent = u.pm < MLAT / 256;
            const int ax = wc & 1, ph = fq >> 1, f0 = 8 * (fq & 1);
#pragma unroll
            for (int ai = 0; ai < 2; ++ai)
#pragma unroll
                for (int m = 0; m < 4; ++m) {
                    const int row = EPI_ROWS(u, wr, fr, ai, m);
                    f32x4 c0 = {1.f, 1.f, 1.f, 1.f}, c1 = c0, s0 = F4Z, s1 = F4Z;
                    if (latent) { const int t = row % SEQ, pos = ax ? (t & 63) : (t >> 6); const float* rc = rope + pos * 16 + f0;
                        c0 = *(const f32x4*)rc; c1 = *(const f32x4*)(rc + 4); s0 = *(const f32x4*)(rc + 2048); s1 = *(const f32x4*)(rc + 2048 + 4); }
#pragma unroll
                    for (int bj = 0; bj < 2; ++bj) { const int col = cb + bj * 128 + wc * 32 + 8 * fq; f32x4 v0 = acc[ai][bj][m][0], v1 = acc[ai][bj][m][1], o0, o1;
#pragma unroll
                        for (int j = 0; j < 4; ++j) { const float p0 = __shfl_xor(v0[j], 32), p1 = __shfl_xor(v1[j], 32);
                            o0[j] = (ph ? (v0[j] * c0[j] + p0 * s0[j]) : (v0[j] * c0[j] - p0 * s0[j])) * qs;
                            o1[j] = (ph ? (v1[j] * c1[j] + p1 * s1[j]) : (v1[j] * c1[j] - p1 * s1[j])) * qs; }
                        u32x4 w; w.x = pk2(o0[0], o0[1]); w.y = pk2(o0[2], o0[3]); w.z = pk2(o1[0], o1[1]); w.w = pk2(o1[2], o1[3]);
                        *(u32x4*)(O + (size_t)row * 512 + col) = w; }
                }
        }
    }
};
__device__ __forceinline__ int chunk_row0(int b, int ck) { return ck < 4 ? MLAT + b * CTXL + 64 * ck : b * SEQ + 64 * (ck - 4); }
__device__ __forceinline__ bf16x8 ld_frag(const bf16* p) { return *(const bf16x8*)p; }
constexpr bf16x8 BF8Z = {0, 0, 0, 0, 0, 0, 0, 0};

struct S5T1 { bf16x8 bre, bim; f32x4 pr[4], pi[4]; };
__device__ __forceinline__ void s5_load_t1(const unsigned char* tb, int dg, int nt, int fr, int G, S5T1& T) {
    const bf16* bbt = (const bf16*)(tb + T_BBT); const float* pneg = (const float*)(tb + T_PNEG);
    T.bre = (G < 2) ? ld_frag(bbt + ((size_t)dg * 128 + 16 * nt + fr) * 16 + 8 * G) : BF8Z;
    T.bim = (G < 2) ? ld_frag(bbt + ((size_t)dg * 128 + 64 + 16 * nt + fr) * 16 + 8 * G) : BF8Z;
    const float* pr = pneg + ((size_t)(dg * 2 + 0) * 64 + 16 * nt + fr) * 64 + 4 * G;
#pragma unroll
    for (int tt = 0; tt < 4; ++tt) { T.pr[tt] = *(const f32x4*)(pr + 16 * tt); T.pi[tt] = *(const f32x4*)(pr + 4096 + 16 * tt); }
}
__device__ __forceinline__ void s5_stage1(const S5T1& T, const bf16x8 (&af)[4], f32x4 (&vre)[4], f32x4 (&vim)[4]) {
#pragma unroll
    for (int tt = 0; tt < 4; ++tt) {
        const f32x4 cr = mfma16(af[tt], T.bre, F4Z), ci = mfma16(af[tt], T.bim, F4Z);
        vre[tt] = T.pr[tt] * cr - T.pi[tt] * ci; vim[tt] = T.pr[tt] * ci + T.pi[tt] * cr;
    }
}
__device__ __forceinline__ void s5_load_u(const bf16* SSMU, int row0, int g, int fr, int G, bf16x8 (&af)[4]) {
#pragma unroll
    for (int tt = 0; tt < 4; ++tt) af[tt] = (G < 2) ? ld_frag(SSMU + (size_t)(row0 + 16 * tt + fr) * 256 + 16 * g + 8 * G) : BF8Z;
}

template <int NC>
__device__ __forceinline__ void s5_pass_a(const Params& P, int item, int lane) {
    const int fr = lane & 15, G = lane >> 4;
    const int dir = item & 1, ckb = ((item >> 1) % (NCHUNK / NC)) * NC, bg = (item >> 1) / (NCHUNK / NC), g = bg & 15, b = bg >> 4, dg = dir * 16 + g;
    const unsigned char* tb = P.ws + WS_TBL; const float* apow = (const float*)(tb + T_APOW);
    float* sloc = (float*)(P.ws + WS_SLOC) + ((size_t)((bg * 2 + dir) * NCHUNK + ckb)) * 128;
    bf16x8 af[NC][4];
#pragma unroll
    for (int c = 0; c < NC; ++c) s5_load_u((const bf16*)(P.ws + WS_Z + Z_SSMU), chunk_row0(b, ckb + c), g, fr, G, af[c]);
    S5T1 T[2]; s5_load_t1(tb, dg, 0, fr, G, T[0]);
    float a63r[4], a63i[4];
#pragma unroll
    for (int nt = 0; nt < 4; ++nt) { a63r[nt] = apow[((size_t)(1 * 32 + dg) * 2 + 0) * 64 + 16 * nt + fr]; a63i[nt] = apow[((size_t)(1 * 32 + dg) * 2 + 1) * 64 + 16 * nt + fr]; }
#pragma unroll
    for (int nt = 0; nt < 4; ++nt) {
        if (nt + 1 < 4) s5_load_t1(tb, dg, nt + 1, fr, G, T[(nt + 1) & 1]);
#pragma unroll
        for (int c = 0; c < NC; ++c) {
            f32x4 vre[4], vim[4]; s5_stage1(T[nt & 1], af[c], vre, vim);
            float sr = 0.f, si = 0.f;
#pragma unroll
            for (int tt = 0; tt < 4; ++tt) { sr += (vre[tt][0] + vre[tt][1]) + (vre[tt][2] + vre[tt][3]); si += (vim[tt][0] + vim[tt][1]) + (vim[tt][2] + vim[tt][3]); }
            sr += __shfl_xor(sr, 16); sr += __shfl_xor(sr, 32); si += __shfl_xor(si, 16); si += __shfl_xor(si, 32);
            const int p = 16 * nt + fr;
            if (G == 0) { sloc[c * 128 + p] = a63r[nt] * sr - a63i[nt] * si; sloc[c * 128 + 64 + p] = a63r[nt] * si + a63i[nt] * sr; }
        }
    }
}
__device__ __forceinline__ void s5_pass_b(const Params& P, int item, int lane) {
    const int dir = item & 1, bg = item >> 1, g = bg & 15, dg = dir * 16 + g, p = lane;
    const float* apow = (const float*)(P.ws + WS_TBL + T_APOW);
    const float a1r = apow[((size_t)(0 * 32 + dg) * 2 + 0) * 64 + p], a1i = apow[((size_t)(0 * 32 + dg) * 2 + 1) * 64 + p];
    const float a64r = apow[((size_t)(2 * 32 + dg) * 2 + 0) * 64 + p], a64i = apow[((size_t)(2 * 32 + dg) * 2 + 1) * 64 + p];
    float* sl = (float*)(P.ws + WS_SLOC) + (size_t)(bg * 2 + dir) * NCHUNK * 128;
    float hr = 0.f, hi = 0.f;
    for (int q0 = 0; q0 < NCHUNK; q0 += 12) {
        float sr[12], si[12];
#pragma unroll
        for (int k = 0; k < 12; ++k) { const int q = q0 + k, ck = dir ? (q < 4 ? 3 - q : 135 - q) : q; sr[k] = sl[(size_t)ck * 128 + p]; si[k] = sl[(size_t)ck * 128 + 64 + p]; }
#pragma unroll
        for (int k = 0; k < 12; ++k) { const int q = q0 + k, ck = dir ? (q < 4 ? 3 - q : 135 - q) : q;
            sl[(size_t)ck * 128 + p] = a1r * hr - a1i * hi; sl[(size_t)ck * 128 + 64 + p] = a1r * hi + a1i * hr;
            const float nr = a64r * hr - a64i * hi + sr[k], ni = a64r * hi + a64i * hr + si[k]; hr = nr; hi = ni; }
    }
}
struct S5T3 { f32x4 cr, ci; bf16x8 cfrag; f32x4 qr[4], qi[4]; };
__device__ __forceinline__ void s5_load_t3(const unsigned char* tb, const float* ah, int dg, int nt, int fr, int G, S5T3& T) {
    const float* ppos = (const float*)(tb + T_PPOS); const bf16* cct = (const bf16*)(tb + T_CCT);
    T.cr = *(const f32x4*)(ah + 16 * nt + 4 * G); T.ci = *(const f32x4*)(ah + 64 + 16 * nt + 4 * G);
    T.cfrag = ld_frag(cct + ((((size_t)dg * 4 + nt) * 16 + fr) * 4 + G) * 8);
#pragma unroll
    for (int nto = 0; nto < 4; ++nto) { const float* pp = ppos + ((size_t)(dg * 2 + 0) * 64 + 16 * nto + fr) * 64 + 16 * nt + 4 * G; T.qr[nto] = *(const f32x4*)pp; T.qi[nto] = *(const f32x4*)(pp + 4096); }
}
template <int NC>
__device__ __forceinline__ void s5_pass_c(const Params& P, int l, int item, int nck, int ck0, int lane) {
    const int fr = lane & 15, G = lane >> 4;
    const int ckb = ck0 + (item * NC) % nck, bg = (item * NC) / nck, g = bg & 15, b = bg >> 4;
    const unsigned char* tb = P.ws + WS_TBL;
    const bf16* SSMU = (const bf16*)(P.ws + WS_Z + Z_SSMU);
    bf16x8 af[NC][4]; f32x4 yt[NC][4];
#pragma unroll
    for (int c = 0; c < NC; ++c) { s5_load_u(SSMU, chunk_row0(b, ckb + c), g, fr, G, af[c]);
#pragma unroll
        for (int q = 0; q < 4; ++q) yt[c][q] = F4Z; }
#pragma unroll 1
    for (int dir = 0; dir < 2; ++dir) {
        const int dg = dir * 16 + g;
        const float* ah = (const float*)(P.ws + WS_SLOC) + ((size_t)((bg * 2 + dir) * NCHUNK + ckb)) * 128;
        bf16x8 la, lb;
        { u32x4 wa, wb;
#pragma unroll
            for (int wi = 0; wi < 4; ++wi) { const int s0 = 16 * (wi >> 1) + 4 * G + 2 * (wi & 1), s1 = s0 + 1;
                const unsigned alo = (dir ? (s0 >= fr) : (s0 <= fr)) ? 0x3F80u : 0u, ahi = (dir ? (s1 >= fr) : (s1 <= fr)) ? 0x3F80u : 0u;
                const unsigned blo = (dir ? (s0 >= 16 + fr) : (s0 <= 16 + fr)) ? 0x3F80u : 0u, bhi = (dir ? (s1 >= 16 + fr) : (s1 <= 16 + fr)) ? 0x3F80u : 0u;
                wa[wi] = alo | (ahi << 16); wb[wi] = blo | (bhi << 16); }
            la = as_bf16x8(wa); lb = as_bf16x8(wb); }
        const u32x4 w1 = {0x3F803F80u, 0x3F803F80u, 0x3F803F80u, 0x3F803F80u}; const bf16x8 lones = as_bf16x8(w1);
#pragma unroll
        for (int nt = 0; nt < 4; ++nt) {
            S5T1 T1; s5_load_t1(tb, dg, nt, fr, G, T1);
            const float* ppos = (const float*)(tb + T_PPOS); const bf16* cct = (const bf16*)(tb + T_CCT);
            const bf16x8 cfrag = ld_frag(cct + ((((size_t)dg * 4 + nt) * 16 + fr) * 4 + G) * 8);
#pragma unroll
            for (int c = 0; c < NC; ++c) {
                const f32x4 cr = *(const f32x4*)(ah + c * 128 + 16 * nt + 4 * G), ci = *(const f32x4*)(ah + c * 128 + 64 + 16 * nt + 4 * G);
                f32x4 vre[4], vim[4]; s5_stage1(T1, af[c], vre, vim);
                const bf16x8 are0 = pack8(vre[0], vre[1]), are1 = pack8(vre[2], vre[3]), aim0 = pack8(vim[0], vim[1]), aim1 = pack8(vim[2], vim[3]);
#pragma unroll
                for (int nto = 0; nto < 4; ++nto) {
                    const bf16x8 lm = (nto & 1) ? lb : la; const bool mixed_k1 = (nto >> 1) != 0;
                    f32x4 hr = mfma16(mixed_k1 ? are1 : are0, lm, F4Z), hi = mfma16(mixed_k1 ? aim1 : aim0, lm, F4Z);
                    if (dir == 0 && mixed_k1) { hr = mfma16(are0, lones, hr); hi = mfma16(aim0, lones, hi); }
                    if (dir == 1 && !mixed_k1) { hr = mfma16(are1, lones, hr); hi = mfma16(aim1, lones, hi); }
                    hr = hr + cr; hi = hi + ci;
                    const float* pp = ppos + ((size_t)(dg * 2 + 0) * 64 + 16 * nto + fr) * 64 + 16 * nt + 4 * G; const f32x4 qr = *(const f32x4*)pp, qi = *(const f32x4*)(pp + 4096);
                    const f32x4 sr = qr * hr - qi * hi, si = qr * hi + qi * hr;
                    yt[c][nto] = mfma16(cfrag, pack8(sr, si), yt[c][nto]);
                }
            }
        }
    }
    const float* dvec = P.in[19] + l * 256 + 16 * g + 4 * G; const f32x4 dv = *(const f32x4*)dvec;
    bf16* YPRE = (bf16*)(P.ws + WS_U + OV_YPRE);
#pragma unroll
    for (int c = 0; c < NC; ++c) { const int row0 = chunk_row0(b, ckb + c);
#pragma unroll
        for (int nto = 0; nto < 4; ++nto) { const size_t row = row0 + 16 * nto + fr; const u32x2 uu = *(const u32x2*)(SSMU + row * 256 + 16 * g + 4 * G);
            const float y0 = gelu_tanh(yt[c][nto][0] + dv[0] * bflo(uu.x)), y1 = gelu_tanh(yt[c][nto][1] + dv[1] * bfhi(uu.x)), y2 = gelu_tanh(yt[c][nto][2] + dv[2] * bflo(uu.y)), y3 = gelu_tanh(yt[c][nto][3] + dv[3] * bfhi(uu.y));
            u32x2 w; w.x = pk2(y0, y1); w.y = pk2(y2, y3); *(u32x2*)(YPRE + row * 256 + 16 * g + 4 * G) = w; } }
}

template <int N1, int N2>
__device__ __forceinline__ void fnet_a(const Params& P, int item, int lane) {
    constexpr int LT = N1 / 16, NOCT = N2 / 8, L = N1 * N2, NK = 1, NKG = LT / NK;
    const int fr = lane & 15, G = lane >> 4;
    const int kg = item % NKG, mt = (item / NKG) & 3, oct = (item / (NKG * 4)) % NOCT, bg = item / (NKG * 4 * NOCT), g = bg & 3, b = bg >> 2;
    const unsigned char* tb = P.ws + WS_TBL; const bf16* wcb = (const bf16*)(tb + T_WCB); const bf16* fa = (const bf16*)(tb + (N1 == 64 ? T_FA64 : T_FA16));
    const bf16* FB = (const bf16*)(P.ws + WS_Z + Z_F); bf16* TB = (bf16*)(P.ws + WS_U + (N1 == 64 ? OV_TBL : OV_TBC));
    const int rbase = (N1 == 64) ? b * SEQ : MLAT + b * CTXL;
    bf16x8 wre[2], wim[2], far[NK][LT], fai[NK][LT];
#pragma unroll
    for (int kk = 0; kk < 2; ++kk) { wre[kk] = ld_frag(wcb + (size_t)(16 * mt + fr) * 64 + 32 * kk + 8 * G); wim[kk] = ld_frag(wcb + (size_t)(64 + 16 * mt + fr) * 64 + 32 * kk + 8 * G); }
#pragma unroll
    for (int q = 0; q < NK; ++q)
#pragma unroll
        for (int lt = 0; lt < LT; ++lt) { const int kt1 = kg * NK + q;
            far[q][lt] = ld_frag(fa + ((((size_t)0 * N1 + 16 * kt1 + fr) * LT + lt) * 4 + G) * 8); fai[q][lt] = ld_frag(fa + ((((size_t)1 * N1 + 16 * kt1 + fr) * LT + lt) * 4 + G) * 8); }
    unsigned ore[NK][4][4], oim[NK][4][4];
#pragma unroll
    for (int e2 = 0; e2 < 4; ++e2) {
        f32x4 tr2[NK][2], ti2[NK][2];
#pragma unroll
        for (int eo = 0; eo < 2; ++eo) {
            const int l2 = 8 * oct + 2 * e2 + eo;
            f32x4 tre[NK], tim[NK];
#pragma unroll
            for (int q = 0; q < NK; ++q) { tre[q] = F4Z; tim[q] = F4Z; }
#pragma unroll
            for (int lt = 0; lt < LT; ++lt) {
                const bf16* rp = FB + (size_t)(rbase + (16 * lt + fr) * N2 + l2) * 256 + g * 64 + 8 * G;
                const bf16x8 a0 = ld_frag(rp), a1 = ld_frag(rp + 32);
                f32x4 xr = mfma16(a0, wre[0], F4Z); xr = mfma16(a1, wre[1], xr);
                f32x4 xi = mfma16(a0, wim[0], F4Z); xi = mfma16(a1, wim[1], xi);
                const bf16x8 xf = pack8(xr, xi);
#pragma unroll
                for (int q = 0; q < NK; ++q) { tre[q] = mfma16(far[q][lt], xf, tre[q]); tim[q] = mfma16(fai[q][lt], xf, tim[q]); }
            }
#pragma unroll
            for (int q = 0; q < NK; ++q)
#pragma unroll
                for (int r = 0; r < 4; ++r) { const int k1 = 16 * (kg * NK + q) + 4 * G + r; const float rev = (float)((k1 * l2) % L) * (1.f / (float)L); const float sn = __builtin_amdgcn_sinf(rev), cs = __builtin_amdgcn_cosf(rev);
                    const float a = tre[q][r], bb = tim[q][r]; tre[q][r] = a * cs + bb * sn; tim[q][r] = bb * cs - a * sn; }
#pragma unroll
            for (int q = 0; q < NK; ++q) { tr2[q][eo] = tre[q]; ti2[q][eo] = tim[q]; }
        }
#pragma unroll
        for (int q = 0; q < NK; ++q)
#pragma unroll
            for (int r = 0; r < 4; ++r) { ore[q][r][e2] = pk2(tr2[q][0][r], tr2[q][1][r]); oim[q][r][e2] = pk2(ti2[q][0][r], ti2[q][1][r]); }
    }
    const int m = 16 * mt + fr;
#pragma unroll
    for (int q = 0; q < NK; ++q)
#pragma unroll
        for (int r = 0; r < 4; ++r) { const int k1 = 16 * (kg * NK + q) + 4 * G + r;
            bf16* o = TB + ((((size_t)bg * N1 + k1) * 2 + 0) * 64 + m) * N2 + 8 * oct;
            u32x4 w0 = {ore[q][r][0], ore[q][r][1], ore[q][r][2], ore[q][r][3]}, w1 = {oim[q][r][0], oim[q][r][1], oim[q][r][2], oim[q][r][3]};
            *(u32x4*)o = w0; *(u32x4*)(o + (size_t)64 * N2) = w1; }
}
template <int N1, int N2>
__device__ __forceinline__ void fnet_c(const Params& P, int item, int lane) {
    constexpr int KT2 = N2 / 16, NKB = 2 * N2 / 32;
    const int fr = lane & 15, G = lane >> 4;
    const int mt0 = 2 * (item & 1), k1 = (item >> 1) % N1, bg = (item >> 1) / N1, g = bg & 3, b = bg >> 2;
    const unsigned char* tb = P.ws + WS_TBL; const bf16* fc = (const bf16*)(tb + (N2 == 128 ? T_FC128 : T_FC16));
    const bf16* TB = (const bf16*)(P.ws + WS_U + (N1 == 64 ? OV_TBL : OV_TBC)); bf16* YF = (bf16*)(P.ws + WS_RES) + 256;
    const int rbase = (N1 == 64) ? b * SEQ : MLAT + b * CTXL;
    f32x4 acc[2][KT2];
#pragma unroll
    for (int k = 0; k < KT2; ++k) { acc[0][k] = F4Z; acc[1][k] = F4Z; }
#pragma unroll 2
    for (int kb = 0; kb < NKB; ++kb) {
        const int kap = 32 * kb + 8 * G, part = kap / N2, l2 = kap % N2;
        const bf16* tp = TB + ((((size_t)bg * N1 + k1) * 2 + part) * 64 + 16 * mt0 + fr) * N2 + l2;
        const bf16x8 tf0 = ld_frag(tp), tf1 = ld_frag(tp + (size_t)16 * N2);
#pragma unroll
        for (int k = 0; k < KT2; ++k) { const bf16x8 ff = ld_frag(fc + (size_t)(16 * k + fr) * (2 * N2) + kap); acc[0][k] = mfma16(tf0, ff, acc[0][k]); acc[1][k] = mfma16(tf1, ff, acc[1][k]); }
    }
#pragma unroll
    for (int q = 0; q < 2; ++q)
#pragma unroll
        for (int k = 0; k < KT2; ++k) { const size_t row = rbase + k1 + N1 * (16 * k + fr); u32x2 w; w.x = pk2(acc[q][k][0], acc[q][k][1]); w.y = pk2(acc[q][k][2], acc[q][k][3]);
            *(u32x2*)(YF + row * 1024 + g * 64 + 16 * (mt0 + q) + 4 * G) = w; }
}
struct KVFrag { bf16x8 k[2][2]; bf16x8 v[4]; };
__device__ __forceinline__ void attn_load2(const char* kbase, const char* vbase, unsigned koff, unsigned voff, unsigned vdstep, KVFrag& f) {
#pragma unroll
    for (int t = 0; t < 2; ++t)
#pragma unroll
        for (int kt = 0; kt < 2; ++kt) f.k[t][kt] = *(const bf16x8*)(kbase + koff + (t * 4 * 512 + 32 * kt) * 2);
#pragma unroll
    for (int dt = 0; dt < 4; ++dt) f.v[dt] = *(const bf16x8*)(vbase + (size_t)dt * vdstep + voff);
}
template <bool CTXQ>
__device__ __forceinline__ void attn_item(const Params& P, const LAS float* rpb, int item, int lane) {
    constexpr int NCH = CTXQ ? 8 : 16;
    const int fr = lane & 15, G = lane >> 4;
    const char* KB = (const char*)(P.ws + WS_Z + Z_K); const bf16* QB = (const bf16*)(P.ws + WS_Z + Z_Q);
    const char* VT = (const char*)(P.ws + WS_Z + Z_VT); const char* VCT = VT + (size_t)NB * 512 * VLD * 2;
    bf16* YN = (bf16*)(P.ws + WS_RES) + 512;
    int b, h, r = 0, cg = 0, r0 = 0, cb = 0; size_t qrow0;
    if (!CTXQ) { cg = item & 3; r = (item >> 2) & 127; h = (item >> 9) & 7; b = item >> 12; r0 = min(max(r - 4, 0), 120); cb = (cg == 0) ? 0 : (cg == 1) ? 8 : (cg == 2) ? 24 : 32;
        qrow0 = (size_t)b * SEQ + r * 64 + 16 * cg; }
    else { const int qt = item & 15; h = (item >> 4) & 7; b = item >> 7; qrow0 = (size_t)MLAT + b * CTXL + 16 * qt; }
    bf16x8 qf[2];
#pragma unroll
    for (int kt = 0; kt < 2; ++kt) qf[kt] = *(const bf16x8*)(QB + (qrow0 + fr) * 512 + h * 64 + 32 * kt + 8 * G);
    const unsigned koff = (unsigned)(((8 * (fr >> 2) + (fr & 3)) * 512 + 8 * G) * 2);
    const unsigned voff_l = (unsigned)((fr * VLD + 8 * G) * 2), voff_c = (unsigned)((fr * CTXL + 8 * G) * 2);
    const char* kloc = KB + ((size_t)b * SEQ + (size_t)r0 * 64 + cb) * 1024 + h * 128;
    const char* kctx = KB + ((size_t)MLAT + (size_t)b * CTXL) * 1024 + h * 128;
    const char* vloc = VT + ((size_t)(b * 512 + h * 64) * VLD + (size_t)r0 * 64 + cb) * 2;
    const char* vctx = VCT + ((size_t)(b * 512 + h * 64) * CTXL) * 2;
    const int qc = 16 * cg + fr, c0 = min(max(qc - 8, 0), 48);
    int boff[2][4];
#pragma unroll
    for (int t = 0; t < 2; ++t)
#pragma unroll
        for (int j = 0; j < 4; ++j) { const int kc = cb + 8 * G + 4 * t + j; const bool ok = (kc >= c0) && (kc < c0 + 16); boff[t][j] = h * (15 * 32) + (ok ? (kc - qc + 15) : 31) + (r0 - r + 7) * 32; }
    f32x4 ot[4] = {F4Z, F4Z, F4Z, F4Z};
    float mrun = -1e30f, lsum = 0.f;
    KVFrag fb[4];
#define ATT_LOAD(CH, DST) do { const int _ch = (CH); if (!CTXQ && _ch < 8) attn_load2(kloc + (size_t)_ch * 65536, vloc + (size_t)_ch * 128, koff, voff_l, 16 * VLD * 2, DST); \
        else { const int _cc = CTXQ ? _ch : _ch - 8; attn_load2(kctx + (size_t)_cc * 32768, vctx + (size_t)_cc * 64, koff, voff_c, 16 * CTXL * 2, DST); } } while (0)
    ATT_LOAD(0, fb[0]); ATT_LOAD(1, fb[1]); ATT_LOAD(2, fb[2]);
#pragma unroll 1
    for (int o = 0; o < NCH / 4; ++o) {
#pragma unroll
        for (int i = 0; i < 4; ++i) {
            const int ch = 4 * o + i;
            if (ch + 3 < NCH) ATT_LOAD(ch + 3, fb[(i + 3) & 3]);
            const KVFrag& cur = fb[i];
            f32x4 s[2];
#pragma unroll
            for (int t = 0; t < 2; ++t) { s[t] = mfma16(cur.k[t][0], qf[0], F4Z); s[t] = mfma16(cur.k[t][1], qf[1], s[t]); }
            if (!CTXQ && ch < 8) {
#pragma unroll
                for (int t = 0; t < 2; ++t)
#pragma unroll
                    for (int j = 0; j < 4; ++j) s[t][j] += rpb[boff[t][j] + ch * 32];
            }
            float cm = fmaxf(fmaxf(fmaxf(s[0][0], s[0][1]), fmaxf(s[0][2], s[0][3])), fmaxf(fmaxf(s[1][0], s[1][1]), fmaxf(s[1][2], s[1][3])));
            cm = fmaxf(cm, __shfl_xor(cm, 16)); cm = fmaxf(cm, __shfl_xor(cm, 32));
            const float mnew = fmaxf(mrun, cm), alpha = __builtin_amdgcn_exp2f(mrun - mnew); mrun = mnew;
            f32x4 p0, p1; float ps = 0.f;
#pragma unroll
            for (int j = 0; j < 4; ++j) { p0[j] = __builtin_amdgcn_exp2f(s[0][j] - mnew); p1[j] = __builtin_amdgcn_exp2f(s[1][j] - mnew); ps += p0[j] + p1[j]; }
            lsum = lsum * alpha + ps;
            const bf16x8 pf = pack8(p0, p1);
#pragma unroll
            for (int dt = 0; dt < 4; ++dt) ot[dt] = mfma16(cur.v[dt], pf, ot[dt] * alpha);
            asm volatile("" ::: "memory");
        }
    }
#undef ATT_LOAD
    lsum += __shfl_xor(lsum, 16); lsum += __shfl_xor(lsum, 32);
    const float inv = 1.f / lsum;
#pragma unroll
    for (int dt = 0; dt < 4; ++dt) { u32x2 w; w.x = pk2(ot[dt][0] * inv, ot[dt][1] * inv); w.y = pk2(ot[dt][2] * inv, ot[dt][3] * inv);
        *(u32x2*)(YN + (qrow0 + fr) * 1024 + h * 64 + 16 * dt + 4 * G) = w; }
}
constexpr int LDS_CTL_OFF = 8 * 16384 + 5 * DM * 4;
constexpr int LDS_BYTES = LDS_CTL_OFF + 128;
__device__ __forceinline__ int q_raw_lds(LAS unsigned* ctr, int lane) { unsigned v = 0; if (lane == 0) v = __hip_atomic_fetch_add(ctr, 1u, __ATOMIC_RELAXED, __HIP_MEMORY_SCOPE_WORKGROUP); return (int)__builtin_amdgcn_readfirstlane(v); }
#define WG_RANGE(n, lo, cnt) const int lo = (int)(((long long)(n) * (int)blockIdx.x) / (int)gridDim.x), cnt = (int)(((long long)(n) * ((int)blockIdx.x + 1)) / (int)gridDim.x) - lo
__device__ __forceinline__ int q_next_lds(LAS unsigned* ctr, int lane) { unsigned v = 0; if (lane == 0) v = __hip_atomic_fetch_add(ctr, 1u, __ATOMIC_RELAXED, __HIP_MEMORY_SCOPE_WORKGROUP); return (int)__builtin_amdgcn_readfirstlane(v) * (int)gridDim.x + (int)blockIdx.x; }
__device__ __forceinline__ int q_next(unsigned* ctr, int lane) { unsigned v = 0; if (lane == 0) v = atomicAdd(ctr, 1u); return (int)__builtin_amdgcn_readfirstlane(v); }

template <class Epi>
__device__ __forceinline__ void run_gemm(const Frame& F, const bf16* A, const bf16* Bt, int M, int N, int K, const Epi& E) {
    pg8::Gemm g{A, Bt, M, N, K, K}; pg8::StaticOrder S; S.init(M, N, (int)gridDim.x, (int)blockIdx.x);
    pg8::gemm_phase<Epi, pg8::StaticOrder, true, true>((PG8_LAS unsigned char*)F.lds, g, S, E, F.tid);
}
struct OneUnit {
    int pm, pn; bool have;
    __device__ __forceinline__ bool next(int i, pg8::Unit& u) const { if (i > 0 || !have) return false; u.pm = pm; u.pn = pn; return true; }
    __device__ __forceinline__ void a_ready(const pg8::Unit&) const {}
    __device__ __forceinline__ void done(const pg8::Unit&) const {}
};
template <int NSL>
__device__ __forceinline__ void ctx_split_gemm(const Frame& F, const bf16* A, const bf16* Bt, int ldk, bf16* resp) {
    const int c = blockIdx.x; OneUnit S; S.have = c < 16 * NSL; const int sl = c >> 4; S.pm = (MLAT / 256) + ((c & 15) >> 2); S.pn = c & 3;
    pg8::Gemm g{A + sl * 256, Bt + sl * 256, MT, DM, 256, ldk};
    EpiStore E{resp + (size_t)sl * MCTX * DM - (size_t)MLAT * DM, DM};
    pg8::gemm_phase<EpiStore, OneUnit, true, true>((PG8_LAS unsigned char*)F.lds, g, S, E, F.tid);
}

__device__ __forceinline__ Frame mkframe(unsigned char* lds_raw, int wv) {
    Frame Fr; asm volatile("" : "+s"(wv)); int ln = (int)__builtin_amdgcn_mbcnt_hi(~0u, __builtin_amdgcn_mbcnt_lo(~0u, 0u)); asm volatile("" : "+v"(ln));
    Fr.lds = (LAS unsigned char*)lds_raw; Fr.lane = ln; Fr.wave = wv; Fr.tid = wv * 64 + ln;
    Fr.gw = blockIdx.x * NWAVES + wv; Fr.ngw = gridDim.x * NWAVES; return Fr;
}
__device__ __forceinline__ const Params& getP() { const Params* kp = (const Params*)__builtin_amdgcn_kernarg_segment_ptr(); asm volatile("" : "+s"(kp)); return *kp; }
#define PP getP()
#define WSP(off) (getP().ws + (off))
#define F mkframe(lds_raw, wv0)
#define GRID_SYNC() do { XcdBarrier bb; bb.bar = (unsigned*)WSP(WS_CTL); bb.x = xb_xcc_id(); bb.st = (volatile LAS unsigned*)((LAS unsigned char*)lds_raw + LDS_CTL_OFF); xcd_barrier(bb, F.tid); } while (0)


#ifndef DIAG_TIME
#define DIAG_TIME 0
#endif
#define TSTAMP(k) do { if (DIAG_TIME) { const Frame Ft = F; if (blockIdx.x == 0 && Ft.tid == 0) ((unsigned long long*)(WSP(WS_CTL) + 32768))[k] = __builtin_amdgcn_s_memrealtime(); } } while (0)
#ifndef DIAG_REPEAT
#define DIAG_REPEAT 0
#endif
#ifndef DIAG_STOP
#define DIAG_STOP 0
#endif
__device__ __forceinline__ void diag_dump(const Frame& Fr, const Params& P, const bf16* src, int ld, int ncols) {
    for (size_t i = (size_t)Fr.gw * 64 + Fr.lane; i < (size_t)MLAT * DM; i += (size_t)Fr.ngw * 64) { const size_t row = i >> 10; const int c = (int)(i & 1023);
        float v = bf2f(src[row * ld + (c % ncols)]); v = (__builtin_fabsf(v) < 1e30f) ? v : 12345.f; P.out[i] = v; }
}

__device__ __forceinline__ void diag_dump3(const Frame& Fr, const Params& P, int mode) {
    const bf16* ypre = (const bf16*)(P.ws + WS_U + OV_YPRE); const bf16* yf = (const bf16*)(P.ws + WS_RES + SZ_256); const bf16* yn = (const bf16*)(P.ws + WS_RES + 2 * SZ_256);
    for (size_t i = (size_t)Fr.gw * 64 + Fr.lane; i < (size_t)MLAT * DM; i += (size_t)Fr.ngw * 64) { const size_t row = i >> 10; const int c = (int)(i & 1023);
        float v = 0.f;
        if (c < 256) { if (mode & 1) v = bf2f(ypre[row * 256 + c]); } else if (c < 512) { if (mode & 2) v = bf2f(yf[row * 256 + c - 256]); } else { if (mode & 4) v = bf2f(yn[row * 512 + c - 512]); }
        v = (__builtin_fabsf(v) < 1e30f) ? v : 12345.f; P.out[i] = v; }
}
#define DIAG_AT(n, src, ld, ncols) do { if (DIAG_STOP == (n)) { GRID_SYNC(); diag_dump(F, PP, (const bf16*)(src), ld, ncols); return true; } } while (0)
template <int l>
__device__ __forceinline__ bool layer_body(unsigned char* lds_raw, const int wv0) {
    constexpr bool last = (l == DEPTH - 1);

        const int Mx = last ? MLAT : MT;
        run_gemm(F, (const bf16*)WSP(WS_U), (const bf16*)WSP(WS_WA + WA_GU), MT, 2 * DFF, DM, EpiGU{(bf16*)WSP(WS_Z)});
        if (l == 0 && DIAG_REPEAT == 6) run_gemm(F, (const bf16*)WSP(WS_U), (const bf16*)WSP(WS_WA + WA_GU), MT, 2 * DFF, DM, EpiGU{(bf16*)WSP(WS_Z)});
        if (l == 0) DIAG_AT(2, WSP(WS_Z), DFF, 1024);
        GRID_SYNC();
        run_gemm(F, (const bf16*)WSP(WS_Z), (const bf16*)WSP(WS_WA + WA_DN), MT, DM, DFF, EpiStore{(bf16*)WSP(WS_RES), DM});
        if (l == 0) DIAG_AT(3, WSP(WS_RES), DM, 1024);
        GRID_SYNC();
        rowwise_phase<1>(F, PP, l, 2, 0.5f, 0, l, 3, true, l == 0, MT, 1);
        GRID_SYNC();
        run_gemm(F, (const bf16*)WSP(WS_U), (const bf16*)WSP(WS_WB + WB_IN), MT, WIN, DM, EpiWin{WSP(WS_Z), (const float*)WSP(WS_TBL + T_ROPE)});
        if (l == 0) DIAG_AT(5, WSP(WS_Z + Z_K), 512, 512);
        if (l == 0) DIAG_AT(6, WSP(WS_Z + Z_G), 3072, 1024);
        GRID_SYNC();
        if (l == 0) TSTAMP(1);
        {
            const Frame Fl = F;
            LAS float* rpb = (LAS float*)(Fl.lds + 8 * 16384);
            for (int i = Fl.tid; i < 8 * 15 * 32; i += NTHREADS) rpb[i] = ((i & 31) < 31) ? PP.in[22][l * 8 * 15 * 31 + (i >> 5) * 31 + (i & 31)] * 1.4426950408889634f : -1e30f;
            LAS unsigned* qc = (LAS unsigned*)(Fl.lds + LDS_CTL_OFF) + 8;
            if (Fl.tid < 4) qc[Fl.tid] = 0u;
            __syncthreads();
            const int n_fa = 4096, n_fac = last ? 0 : 128, n_s5a = 4 * 16 * NCHUNK * 2;
            const int e0 = n_fa, e1 = e0 + n_fac, e2 = e1 + n_s5a;
            for (int it = q_next_lds(qc, Fl.lane); it < e1; it = q_next_lds(qc, Fl.lane)) { if (it < e0) fnet_a<64, 128>(PP, it, Fl.lane); else fnet_a<16, 16>(PP, it - e0, Fl.lane); }
            for (int it = q_next_lds(qc + 1, Fl.lane); it < n_s5a / 4; it = q_next_lds(qc + 1, Fl.lane)) s5_pass_a<4>(PP, it, Fl.lane);
        }
        GRID_SYNC();
        if (l == 0) TSTAMP(2);
        {
            const Frame Fl = F;
            LAS float* rpb = (LAS float*)(Fl.lds + 8 * 16384);
            const int n_b = 128, n_att = 16384, n_attc = last ? 0 : 512, n_fc = 2048, n_fcc = last ? 0 : 512;
            const int e0 = n_b, e1 = e0 + n_att, e2 = e1 + n_attc, e3 = e2 + n_fc, e4 = e3 + n_fcc;
            LAS unsigned* qc = (LAS unsigned*)(Fl.lds + LDS_CTL_OFF) + 8;
            for (int it = q_next_lds(qc + 2, Fl.lane); it < e4; it = q_next_lds(qc + 2, Fl.lane)) {
                if (it < e0) s5_pass_b(PP, it, Fl.lane);
                else if (it < e1) attn_item<false>(PP, rpb, it - e0, Fl.lane);
                else if (it < e2) attn_item<true>(PP, rpb, it - e1, Fl.lane);
                else if (it < e3) fnet_c<64, 128>(PP, it - e2, Fl.lane);
                else fnet_c<16, 16>(PP, it - e3, Fl.lane);
            }
        }
        GRID_SYNC();
        if (l == 0) TSTAMP(3);
        {
            const Frame Fl = F;
            const int nck = last ? 128 : NCHUNK, ck0 = last ? 4 : 0, n_c = 64 * nck;
            LAS unsigned* qc = (LAS unsigned*)(Fl.lds + LDS_CTL_OFF) + 8;
            const int n_lat = 64 * 64, n_ctx = last ? 0 : 64 * 4;
            for (int it = q_next_lds(qc + 3, Fl.lane); it < n_lat + n_ctx; it = q_next_lds(qc + 3, Fl.lane)) {
                if (it < n_lat) s5_pass_c<2>(PP, l, it, 128, 4, Fl.lane); else s5_pass_c<1>(PP, l, it - n_lat, 4, 0, Fl.lane); }
        }
        GRID_SYNC();
        if (l == 0) TSTAMP(4);
        {
            const int nun = Mx / 256;
            if ((int)blockIdx.x >= nun && (int)gridDim.x > nun) { Frame Fc = F; Fc.gw = ((int)blockIdx.x - nun) * NWAVES + Fc.wave; Fc.ngw = ((int)gridDim.x - nun) * NWAVES; convert_ffn(Fc, PP, l, 1); }
            else if ((int)gridDim.x <= nun) convert_ffn(F, PP, l, 1);
        }
        run_gemm(F, (const bf16*)WSP(WS_U + OV_YPRE), (const bf16*)WSP(WS_WB + WB_GLU), Mx, 256, 256, EpiGLU{(const bf16*)WSP(WS_U + OV_YPRE), PP.in[21] + l * 256, (bf16*)WSP(WS_RES)});
        GRID_SYNC();
        run_gemm(F, (const bf16*)WSP(WS_RES), (const bf16*)WSP(WS_WB + WB_BRS), Mx, DM, DM, EpiMergeK{(const bf16*)WSP(WS_Z + Z_G), (bf16*)WSP(WS_Z + Z_K)});
        GRID_SYNC();
        run_gemm(F, (const bf16*)WSP(WS_Z + Z_K), (const bf16*)WSP(WS_WB + WB_OUT), Mx, DM, DM, EpiStore{(bf16*)WSP(WS_RES), DM});
        if (l == 0) DIAG_AT(22, WSP(WS_RES), DM, 1024);
        GRID_SYNC();
        rowwise_phase<1>(F, PP, l, 5, 1.0f, 1, l, 6, true, false, Mx, 1);
        if (l == 0) DIAG_AT(23, WSP(WS_U), DM, 1024);
        GRID_SYNC();
        run_gemm(F, (const bf16*)WSP(WS_U), (const bf16*)WSP(WS_WA + WA_GU), Mx, 2 * DFF, DM, EpiGU{(bf16*)WSP(WS_Z)});
        GRID_SYNC();
        run_gemm(F, (const bf16*)WSP(WS_Z), (const bf16*)WSP(WS_WA + WA_DN), Mx, DM, DFF, EpiStore{(bf16*)WSP(WS_RES), DM});
        if (l == 0) DIAG_AT(24, WSP(WS_RES), DM, 1024);
        GRID_SYNC();
        rowwise_phase<1>(F, PP, l, 8, 0.5f, 2, last ? l : l + 1, 0, !last, false, Mx, 1);
        if (!last) { convert_ffn(F, PP, l + 1, 0); convert_mixer(F, PP, l + 1); make_s5_tables(F, PP, l + 1); GRID_SYNC(); }
        return false;
}
__global__ void __launch_bounds__(NTHREADS, 2) hybrid_fwd(Params Parg) {
    extern __shared__ __attribute__((aligned(16))) unsigned char lds_raw[];
    cg::grid_group grid = cg::this_grid();
    const int wv0 = __builtin_amdgcn_readfirstlane((int)threadIdx.x >> 6);
    {
        const int t0 = threadIdx.x;
        if (t0 < 32) ((LAS unsigned*)(lds_raw))[LDS_CTL_OFF / 4 + t0] = 0u;
        if (blockIdx.x == 0) { unsigned* ctlw = (unsigned*)(getP().ws + WS_CTL); for (int i = t0; i < (int)(CTL_BYTES / 4); i += NTHREADS) __hip_atomic_store(ctlw + i, 0u, __ATOMIC_RELAXED, __HIP_MEMORY_SCOPE_AGENT); }
        __threadfence();
        __syncthreads();
        grid.sync();
    }
    XcdBarrier bar = xcd_barrier_post((unsigned*)WSP(WS_CTL), (volatile LAS unsigned*)((LAS unsigned char*)lds_raw + LDS_CTL_OFF), F.tid);
    (void)bar;
    TSTAMP(0);
#if defined(DIAG_BARTEST)
    {
        unsigned* slots = (unsigned*)(WSP(WS_Z));
        unsigned* errs = (unsigned*)(WSP(WS_CTL)) + 12288;
        unsigned bad = 0;
        for (int rnd = 1; rnd <= 64; ++rnd) {
            const Frame Fb = F;
            if ((blockIdx.x + rnd) % 7 == 0) { for (int d = 0; d < 2000; ++d) __builtin_amdgcn_s_sleep(20); }
            for (int i = Fb.tid; i < 4096; i += NTHREADS) slots[(size_t)blockIdx.x * 4096 + i] = (unsigned)(rnd * 65536 + blockIdx.x * 16 + (i & 15));
            GRID_SYNC();
            for (int j = 0; j < 8; ++j) { const int ob = (blockIdx.x * 37 + j * 31 + rnd) % (int)gridDim.x;
                for (int i = Fb.tid; i < 4096; i += NTHREADS) { const unsigned v = slots[(size_t)ob * 4096 + i]; if (v != (unsigned)(rnd * 65536 + ob * 16 + (i & 15))) ++bad; } }
            GRID_SYNC();
        }
        if (bad) atomicAdd(errs, bad);
        GRID_SYNC();
        const Frame Fd = F; const unsigned e = __hip_atomic_load(errs, __ATOMIC_RELAXED, __HIP_MEMORY_SCOPE_AGENT);
        float* o = getP().out;
        for (size_t i = (size_t)Fd.gw * 64 + Fd.lane; i < (size_t)MLAT * DM; i += (size_t)Fd.ngw * 64) o[i] = (i == 0 && e) ? 4096.f : 0.f;
        return;
    }
#endif
    mod_phase(F, PP);
    convert_ffn(F, PP, 0, 0); convert_mixer(F, PP, 0); make_s5_tables(F, PP, 0); make_static_tables(F, PP);
    if (DIAG_REPEAT == 8) { convert_ffn(F, PP, 0, 0); convert_mixer(F, PP, 0); }
    if (DIAG_REPEAT == 7) { for (int k = 0; k < 10; ++k) GRID_SYNC(); }
    if (DIAG_REPEAT == 9) { mod_phase(F, PP); make_s5_tables(F, PP, 0); make_static_tables(F, PP); }
    GRID_SYNC();
    rowwise_phase<0>(F, PP, 0, 0, 0.f, 0, 0, 0, true, true, MT, 1);
    GRID_SYNC();
    if (DIAG_STOP == 1) { GRID_SYNC(); diag_dump(F, PP, (const bf16*)WSP(WS_U), DM, 1024); return; }

    if (layer_body<0>(lds_raw, wv0)) return;
    if (layer_body<1>(lds_raw, wv0)) return;
    if (DIAG_TIME) {
        TSTAMP(5); GRID_SYNC();
        const Frame Fd = F; const unsigned long long* ts = (const unsigned long long*)(WSP(WS_CTL) + 32768);
        const float X = exp2f(floorf(log2f((float)(ts[DIAG_TX1] - ts[DIAG_TX0]) * 0.01f)));
        const float C = floorf(2.f * log2f((float)(ts[DIAG_TC1] - ts[DIAG_TC0]) * 0.01f));
        float* o = getP().out;
        for (size_t i = (size_t)Fd.gw * 64 + Fd.lane; i < (size_t)MLAT * DM; i += (size_t)Fd.ngw * 64) o[i] = (i == 0) ? X : C;
    }
}

extern "C" void kernel_launch(void* const* d_in, const int* in_sizes, int n_in, void* d_out, int out_size, void* d_ws, size_t ws_size, hipStream_t stream) {
    static int grid_blocks = 0;
    if (grid_blocks == 0) {
        if (n_in != 27 || ws_size < WS_END) { fprintf(stderr, "kernel_launch: unexpected n_in %d or ws_size %zu (< %zu)\n", n_in, ws_size, (size_t)WS_END); grid_blocks = -1; return; }
        int dev = 0, cus = 0, per_cu = 0;
        hipGetDevice(&dev); hipDeviceGetAttribute(&cus, hipDeviceAttributeMultiprocessorCount, dev);
        hipFuncSetAttribute((const void*)hybrid_fwd, hipFuncAttributeMaxDynamicSharedMemorySize, LDS_BYTES);
        if (hipOccupancyMaxActiveBlocksPerMultiprocessor(&per_cu, (const void*)hybrid_fwd, NTHREADS, LDS_BYTES) != hipSuccess || per_cu < 1) per_cu = 1;
        (void)hipGetLastError();
        grid_blocks = cus * 1;
    }
    if (grid_blocks < 0) return;
    hipMemsetAsync((char*)d_ws + WS_CTL, 0, CTL_BYTES, stream);
    Params p{};
    for (int i = 0; i < 27; ++i) p.in[i] = (const float*)d_in[i];
    p.out = (float*)d_out; p.ws = (unsigned char*)d_ws;
    void* args[] = {&p};
    hipError_t e = hipLaunchCooperativeKernel((const void*)hybrid_fwd, dim3(grid_blocks), dim3(NTHREADS), args, LDS_BYTES, stream);
    if (e != hipSuccess) fprintf(stderr, "cooperative launch failed: %s (grid %d)\n", hipGetErrorString(e), grid_blocks);
}
```
